# Optimizing an MI355X kernel written in HIP

```python
import jax, jax.numpy as jnp
from jax import lax
import numpy as np

D_MODEL = 1024
BATCH = 16
SEQ = 2048
DEPTH = 2
DEC_BATCH = 16
DEC_SEQ = 4096
PAST_LEN = 128

D_MIX = D_MODEL
HG_HEADS = 4
HG_DK = 128
HG_DV = (D_MIX // 2) // HG_HEADS
HG_WIDTH = HG_HEADS * HG_DV
GLA_HEADS = 4
GLA_DK = 64
GLA_DV = (D_MIX // 2) // GLA_HEADS
GLA_WIDTH = GLA_HEADS * GLA_DV
GATE_RANK = 16
GATE_NORMALIZER = 16.0
D_FF = 2816
CHUNK = 128
SUB = 16
N_SUB = CHUNK // SUB
EPS = 1e-6
LB_FLOOR = 1e-30
IN_SPLITS = (HG_HEADS * HG_DK,
             HG_HEADS * HG_DK,
             HG_HEADS * HG_DK,
             HG_WIDTH,
             HG_WIDTH,
             GLA_HEADS * GLA_DK,
             GLA_HEADS * GLA_DK,
             GLA_WIDTH,
             GATE_RANK,
             GATE_RANK,
             GLA_WIDTH)
D_IN = sum(IN_SPLITS)

kernel_name = "hymba_style_hgrn2_gla_macaron_encoder"


def rmsnorm(x, g):
    xf = x.astype(jnp.float32)
    y = xf * lax.rsqrt(jnp.mean(xf * xf, axis=-1, keepdims=True) + EPS)
    return (y * g.astype(jnp.float32)).astype(x.dtype)


def head_rmsnorm(o, g):
    B, T, H, d = o.shape
    y = o * lax.rsqrt(jnp.mean(o * o, axis=-1, keepdims=True) + EPS)
    return (y * g.astype(jnp.float32).reshape(H, d)).reshape(B, T, H * d)


def swiglu(x, w_in, w_out):
    a, b = jnp.split(x @ w_in, 2, axis=-1)
    return (jax.nn.silu(a) * b) @ w_out


def masked_exp(mask, e):
    return jnp.where(mask, jnp.exp(jnp.where(mask, e, 0.0)), 0.0)


def gated_linear_scan(q, k, v, g):
    f32 = jnp.float32
    q, k, v, g = (a.astype(f32) for a in (q, k, v, g))
    B, T, H, DK = q.shape
    DV = v.shape[-1]
    N = T // CHUNK

    def to_chunks(a):
        return jnp.moveaxis(a.reshape(B, N, CHUNK, H, a.shape[-1]), 1, 0)

    pos = jnp.arange(CHUNK)
    off_mask = pos[None, :] < (jnp.arange(N_SUB) * SUB)[:, None]
    diag_mask = jnp.tril(jnp.ones((SUB, SUB), dtype=bool))

    def step(S, inp):
        qi, ki, vi, gi = inp
        b = jnp.cumsum(gi, axis=1)
        b_last = b[:, -1]
        o_state = jnp.einsum('bchk,bhkv->bchv', qi * jnp.exp(b), S)
        S_new = jnp.exp(b_last)[..., None] * S + jnp.einsum(
            'bchk,bchv->bhkv', ki * jnp.exp(b_last[:, None] - b), vi)
        qs = qi.reshape(B, N_SUB, SUB, H, DK)
        ks = ki.reshape(B, N_SUB, SUB, H, DK)
        vs = vi.reshape(B, N_SUB, SUB, H, DV)
        bs = b.reshape(B, N_SUB, SUB, H, DK)
        ref = jnp.concatenate([jnp.zeros((B, 1, H, DK), f32), b[:, SUB - 1:CHUNK - 1:SUB]], axis=1)
        q_off = qs * jnp.exp(bs - ref[:, :, None])
        k_off = ki[:, None] * masked_exp(off_mask[None, :, :, None, None],
                                         ref[:, :, None] - b[:, None])
        a_off = jnp.einsum('bnlhk,bnchk->bnhlc', q_off, k_off)
        o_off = jnp.einsum('bnhlc,bchv->bnlhv', a_off, vi)
        d_dec = masked_exp(diag_mask[None, None, :, :, None, None],
                           bs[:, :, :, None] - bs[:, :, None, :])
        a_diag = jnp.einsum('bnthk,bnshk,bntshk->bnhts', qs, ks, d_dec)
        o_diag = jnp.einsum('bnhts,bnshv->bnthv', a_diag, vs)
        o = o_state + (o_off + o_diag).reshape(B, CHUNK, H, DV)
        return S_new, o

    S0 = jnp.zeros((B, H, DK, DV), f32)
    _, outs = lax.scan(step, S0, tuple(to_chunks(a) for a in (q, k, v, g)))
    return jnp.moveaxis(outs, 0, 1).reshape(B, T, H, DV)


def bidirectional_scan(q, k_fwd, k_bwd, v, g_fwd, g_bwd):
    flip = lambda a: jnp.flip(a, axis=1)
    fwd = gated_linear_scan(q, k_fwd, v, g_fwd)
    bwd = flip(gated_linear_scan(flip(q), flip(k_bwd), flip(v), flip(g_bwd)))
    return fwd + bwd


def hgrn_log_forget(z, lb):
    return jnp.logaddexp(jnp.log(jnp.maximum(lb, LB_FLOOR)), jnp.log1p(-lb) + jax.nn.log_sigmoid(z))


def encoder_layer(x, lb, n1, w1i, w1o, nm, wi, wg, bg, hgn, glan, wo, n2, w2i, w2o):
    B, T, _ = x.shape
    x = x + 0.5 * swiglu(rmsnorm(x, n1), w1i, w1o)
    h = rmsnorm(x, nm)
    p = (h @ wi).astype(jnp.float32)
    bounds = np.cumsum(IN_SPLITS)[:-1].tolist()
    hq, hf_f, hf_b, hi, hg, gq, gk, gv, ga_f, ga_b, gr = jnp.split(p, bounds, axis=-1)
    heads = lambda a, n: a.reshape(B, T, n, -1)
    hd = HG_HEADS * HG_DK
    logf_f = hgrn_log_forget(hf_f, lb[:hd])
    logf_b = hgrn_log_forget(hf_b, lb[hd:])
    o_hg = bidirectional_scan(heads(hq, HG_HEADS),
                              heads(-jnp.expm1(logf_f), HG_HEADS), heads(-jnp.expm1(logf_b), HG_HEADS),
                              heads(hi, HG_HEADS),
                              heads(logf_f, HG_HEADS), heads(logf_b, HG_HEADS))
    o_hg = head_rmsnorm(o_hg, hgn) * jax.nn.sigmoid(hg)
    la_f = jax.nn.log_sigmoid(ga_f @ wg[0].astype(jnp.float32) + bg[0].astype(jnp.float32)) / GATE_NORMALIZER
    la_b = jax.nn.log_sigmoid(ga_b @ wg[1].astype(jnp.float32) + bg[1].astype(jnp.float32)) / GATE_NORMALIZER
    k_gla = heads(gk, GLA_HEADS)
    o_gla = bidirectional_scan(heads(gq * GLA_DK ** -0.5, GLA_HEADS), k_gla, k_gla,
                               heads(gv, GLA_HEADS),
                               heads(la_f, GLA_HEADS), heads(la_b, GLA_HEADS))
    o_gla = head_rmsnorm(o_gla, glan) * jax.nn.silu(gr)
    x = x + jnp.concatenate([o_hg, o_gla], axis=-1).astype(x.dtype) @ wo
    x = x + 0.5 * swiglu(rmsnorm(x, n2), w2i, w2o)
    return x


def setup_inputs(seed: int = 0) -> dict:
    key = jax.random.key(seed)
    ks = jax.random.split(key, 18)
    nrm = lambda k, shape, scale: jax.random.normal(k, shape, jnp.float32) * scale
    gain = lambda k, shape: 1.0 + 0.02 * jax.random.normal(k, shape, jnp.float32)
    return {
        "x_prompt": nrm(ks[0], (BATCH, SEQ, D_MODEL), 1.0),
        "x_sample": nrm(ks[1], (DEC_BATCH, DEC_SEQ, D_MODEL), 1.0),
        "lower_bounds": nrm(ks[2], (DEPTH, 2 * HG_HEADS * HG_DK), 0.1),
        "ffn1_norm": gain(ks[3], (DEPTH, D_MODEL)),
        "ffn1_w_in": nrm(ks[4], (DEPTH, D_MODEL, 2 * D_FF), D_MODEL ** -0.5),
        "ffn1_w_out": nrm(ks[5], (DEPTH, D_FF, D_MODEL), D_FF ** -0.5),
        "mix_norm": gain(ks[6], (DEPTH, D_MODEL)),
        "w_in": nrm(ks[7], (DEPTH, D_MODEL, D_IN), D_MODEL ** -0.5),
        "gla_w_gate": nrm(ks[8], (DEPTH, 2, GATE_RANK, GLA_HEADS * GLA_DK), GATE_RANK ** -0.5),
        "gla_b_gate": nrm(ks[9], (DEPTH, 2, GLA_HEADS * GLA_DK), 0.01),
        "hg_head_norm": gain(ks[10], (DEPTH, HG_WIDTH)),
        "gla_head_norm": gain(ks[11], (DEPTH, GLA_WIDTH)),
        "w_out": nrm(ks[12], (DEPTH, D_MIX, D_MODEL), D_MIX ** -0.5),
        "ffn2_norm": gain(ks[13], (DEPTH, D_MODEL)),
        "ffn2_w_in": nrm(ks[14], (DEPTH, D_MODEL, 2 * D_FF), D_MODEL ** -0.5),
        "ffn2_w_out": nrm(ks[15], (DEPTH, D_FF, D_MODEL), D_FF ** -0.5),
        "final_norm": gain(ks[16], (D_MODEL,)),
    }


def reference(x_prompt, x_sample, lower_bounds, ffn1_norm, ffn1_w_in, ffn1_w_out, mix_norm, w_in,
              gla_w_gate, gla_b_gate, hg_head_norm, gla_head_norm, w_out, ffn2_norm, ffn2_w_in,
              ffn2_w_out, final_norm):
    probs = jax.nn.softmax(lower_bounds.astype(jnp.float32), axis=0)
    lbs = jnp.cumsum(probs, axis=0) - probs[0]

    def trunk(x):
        for l in range(DEPTH):
            x = encoder_layer(x, lbs[l], ffn1_norm[l], ffn1_w_in[l], ffn1_w_out[l], mix_norm[l], w_in[l],
                              gla_w_gate[l], gla_b_gate[l], hg_head_norm[l], gla_head_norm[l], w_out[l],
                              ffn2_norm[l], ffn2_w_in[l], ffn2_w_out[l])
        return rmsnorm(x, final_norm)

    y_prompt = trunk(x_prompt)
    y_sample = trunk(x_sample)
    return (y_prompt, y_sample)
```

```cpp
#include <hip/hip_runtime.h>
#include <hip/hip_cooperative_groups.h>
#include <cstdio>
namespace cg = cooperative_groups;

#define LAS __attribute__((address_space(3)))
typedef unsigned short bf16_t;
typedef short bf16x8 __attribute__((ext_vector_type(8)));
typedef short s16x4 __attribute__((ext_vector_type(4)));
typedef float f32x2 __attribute__((ext_vector_type(2)));
typedef float f32x4 __attribute__((ext_vector_type(4)));
typedef float f32x16 __attribute__((ext_vector_type(16)));
typedef unsigned u32x2 __attribute__((ext_vector_type(2)));
typedef unsigned u32x4 __attribute__((ext_vector_type(4)));

constexpr int DM = 1024, DFF = 2816, NFF = 5632, DINSRC = 4128, NP_ = 4608;
constexpr int MTOT = 98304, MG = 49152, NGRP = 2;
constexpr int TPROMPT = 2048, TSAMPLE = 4096;
constexpr float EPS = 1e-6f;
constexpr int NTHREADS = 512;

constexpr size_t SZ_W1I = (size_t)NFF * DM * 2, SZ_W1O = (size_t)DM * DFF * 2, SZ_WIN = (size_t)NP_ * DM * 2, SZ_WO = (size_t)DM * DM * 2;
constexpr size_t SZ_LAYER = 2 * SZ_W1I + 2 * SZ_W1O + SZ_WIN + SZ_WO;
constexpr size_t OFF_W = 0;
constexpr size_t OFF_LBT = OFF_W + 2 * SZ_LAYER;
constexpr size_t OFF_SSQ = OFF_LBT + 2 * 2 * 1024 * 4;
constexpr size_t OFF_XB = OFF_SSQ + (size_t)7 * MTOT * 4;
constexpr size_t OFF_OBF = OFF_XB + (size_t)MG * DM * 2;
constexpr size_t OFF_RAW = OFF_OBF + (size_t)MG * DM * 2;
constexpr size_t OFF_PH = OFF_RAW + (size_t)MG * DM * 4;
constexpr size_t OFF_BAR = OFF_PH + (size_t)MG * NP_ * 2;
constexpr size_t WS_END = OFF_BAR + 256;

__device__ __forceinline__ unsigned pk2(float lo, float hi) {
    typedef __bf16 bf2 __attribute__((ext_vector_type(2)));
    f32x2 v = {lo, hi};
    return __builtin_bit_cast(unsigned, __builtin_convertvector(v, bf2));
}
__device__ __forceinline__ float bflo(unsigned u) { return __uint_as_float(u << 16); }
__device__ __forceinline__ float bfhi(unsigned u) { return __uint_as_float(u & 0xffff0000u); }
__device__ __forceinline__ int grow_tile(int g, int pm) { return pm < 64 ? g * 16384 + pm * 256 : 32768 + g * 32768 + (pm - 64) * 256; }
__device__ __forceinline__ int grow(int g, int r) { return r < 16384 ? g * 16384 + r : 32768 + g * 32768 + (r - 16384); }
__device__ __forceinline__ float sigmoid_f(float x) { return __builtin_amdgcn_rcpf(1.f + __expf(-x)); }
__device__ __forceinline__ float logsig_f(float z) { return fminf(z, 0.f) - __logf(1.f + __expf(-fabsf(z))); }

namespace pg8 {
constexpr int BM = 256, BK = 64, HALF = 128, HTB = HALF * BK * 2, STAGE_BYTES = 8 * HTB, NXCD = 8, WGM = 8;
__device__ __forceinline__ int lds_byte(int r, int c) { const int st = (r >> 4) * 2 + (c >> 5), rr = r & 15, cc = c & 31, ob = rr * 64 + cc * 2; return st * 1024 + (ob ^ (((ob >> 9) & 1) << 5)); }
__device__ __forceinline__ void stage_rc(int b, int& R, int& C) { const int st = b / 1024, sb = b % 1024, swz = sb ^ (((sb >> 9) & 1) << 5); R = (st >> 1) * 16 + swz / 64; C = (st & 1) * 32 + (swz % 64) / 2; }
__device__ __forceinline__ int perm32(int rho) { const int n = rho >> 4, i = rho & 15; return 8 * (i >> 2) + 4 * n + (i & 3); }
struct Unit { int pm, pn; };
struct Gemm { const bf16_t* A; const bf16_t* Bt; int M, N, K; };
struct StaticOrder {
    int nM, nN, nwg, G, c;
    __device__ void init(int M, int N, int G_, int c_) { nM = M / BM; nN = N / BM; nwg = nM * nN; G = G_; c = c_; }
    __device__ bool next(int i, Unit& u) const {
        const long L = (long)i * G + c; if (L >= nwg) return false;
        int wgid = (int)L; { const int q = nwg / NXCD, r = nwg % NXCD, xcd = wgid % NXCD, off = wgid / NXCD; wgid = (xcd < r ? xcd * (q + 1) : r * (q + 1) + (xcd - r) * q) + off; }
        const int nig = WGM * nN, gid = wgid / nig, fm = gid * WGM, gsz = (nM - fm) < WGM ? (nM - fm) : WGM;
        u.pm = fm + ((wgid % nig) % gsz); u.pn = (wgid % nig) / gsz; return true;
    }
};

template <class Epi>
__device__ __forceinline__ void gemm_phase(LAS unsigned char* lds, const Gemm g, const StaticOrder& S, const Epi& E) {
    int tid_ = threadIdx.x; asm volatile("" : "+v"(tid_));
    const int tid = tid_, wid = __builtin_amdgcn_readfirstlane(tid >> 6), lane = tid & 63, wr = wid >> 2, wc = wid & 3, fr = lane & 15, fq = lane >> 4;
    const int K = g.K, nt = K / BK;
    unsigned voffA[2], voffB[2];
#pragma unroll
    for (int i = 0; i < 2; ++i) { int R, C; stage_rc(tid * 16 + i * 8192, R, C); const int Rb = Epi::PERM ? ((R & ~31) + perm32(R & 31)) : R;
        voffA[i] = (unsigned)(R * K + C) * 2u; voffB[i] = (unsigned)(Rb * K + C) * 2u; }
    const size_t kstep = (size_t)(BK * 2);
    const size_t hstep = (size_t)HALF * K * 2;
    const size_t tstep = 2 * hstep;
    const unsigned ldsw = (unsigned)wid * 1024u;
    const int aoff = lds_byte(wr * 64 + fr, fq * 8), boff = lds_byte(wc * 32 + fr, fq * 8);
#define PG8_SA(b, h) (((b) * 2 + (h)) * HTB)
#define PG8_SB(b, h) ((4 + (b) * 2 + (h)) * HTB)
#define PG8_STAGE(bufoff, gbase, voff) do { _Pragma("unroll") for (int _i = 0; _i < 2; ++_i) \
        __builtin_amdgcn_global_load_lds((const unsigned*)((const char*)(gbase) + (voff)[_i]), (LAS unsigned*)(lds + (bufoff) + ldsw + _i * 8192), 16, 0, 0); } while (0)
#define PG8_LDA(dst, b, h) do { _Pragma("unroll") for (int m = 0; m < 4; ++m) _Pragma("unroll") for (int k = 0; k < 2; ++k) dst[m][k] = *(const LAS bf16x8*)(lds + PG8_SA(b, h) + aoff + m * 2048 + k * 1024); } while (0)
#define PG8_LDB(dst, b, h) do { _Pragma("unroll") for (int n = 0; n < 2; ++n) _Pragma("unroll") for (int k = 0; k < 2; ++k) dst[n][k] = *(const LAS bf16x8*)(lds + PG8_SB(b, h) + boff + n * 2048 + k * 1024); } while (0)
#define PG8_MMA(ai, bj, At, Bt) do { __builtin_amdgcn_s_setprio(1); _Pragma("unroll") for (int m = 0; m < 4; ++m) _Pragma("unroll") for (int n = 0; n < 2; ++n) _Pragma("unroll") for (int k = 0; k < 2; ++k) \
        acc[ai][bj][m][n] = __builtin_amdgcn_mfma_f32_16x16x32_bf16(Bt[n][k], At[m][k], acc[ai][bj][m][n], 0, 0, 0); __builtin_amdgcn_s_setprio(0); } while (0)
#define PG8_WAIT_V(n) asm volatile("s_waitcnt vmcnt(" #n ")" ::: "memory")
#define PG8_WAIT_L(n) asm volatile("s_waitcnt lgkmcnt(" #n ")" ::: "memory")
#define PG8_BAR __builtin_amdgcn_s_barrier()
#define PG8_SCHED __builtin_amdgcn_sched_barrier(0)
    Unit cur, nxt; int ui = 0;
    if (!S.next(0, cur)) return;
    f32x4 acc[2][2][4][2];
#pragma unroll
    for (int a = 0; a < 2; ++a)
#pragma unroll
        for (int b = 0; b < 2; ++b)
#pragma unroll
            for (int m = 0; m < 4; ++m)
#pragma unroll
                for (int n = 0; n < 2; ++n) acc[a][b][m][n] = (f32x4){0.f, 0.f, 0.f, 0.f};
    bf16x8 At[4][2], B0[2][2], B1[2][2];
    const char* cA = (const char*)g.A + (size_t)cur.pm * tstep; const char* cB = (const char*)g.Bt + (size_t)cur.pn * tstep;
    PG8_STAGE(PG8_SB(0, 0), cB, voffB); PG8_STAGE(PG8_SA(0, 0), cA, voffA); PG8_STAGE(PG8_SB(0, 1), cB + hstep, voffB); PG8_STAGE(PG8_SA(0, 1), cA + hstep, voffA);
    if (wr == 1) PG8_BAR;
    PG8_WAIT_V(4); PG8_BAR;
    PG8_STAGE(PG8_SB(1, 0), cB + kstep, voffB); PG8_STAGE(PG8_SA(1, 0), cA + kstep, voffA); PG8_STAGE(PG8_SB(1, 1), cB + hstep + kstep, voffB);
    PG8_WAIT_V(6); PG8_BAR;
    for (;;) {
        const bool has_next = S.next(ui + 1, nxt);
        const char* nA = has_next ? (const char*)g.A + (size_t)nxt.pm * tstep : cA; const char* nB = has_next ? (const char*)g.Bt + (size_t)nxt.pn * tstep : cB;
        for (int t = 0; t < nt; t += 2) {
            const bool last = (t == nt - 2);
            const char* a1 = cA + (size_t)(t + 1) * kstep;
            const char* a2 = last ? nA : cA + (size_t)(t + 2) * kstep; const char* b2 = last ? nB : cB + (size_t)(t + 2) * kstep;
            const char* a3 = a2 + kstep; const char* b3 = b2 + kstep;
            PG8_LDB(B0, 0, 0); PG8_SCHED; PG8_LDA(At, 0, 0); PG8_STAGE(PG8_SA(1, 1), a1 + hstep, voffA);
            PG8_WAIT_L(8); PG8_BAR; PG8_WAIT_L(0); PG8_MMA(0, 0, At, B0); PG8_BAR; PG8_SCHED;
            PG8_LDB(B1, 0, 1); PG8_STAGE(PG8_SB(0, 0), b2, voffB);
            PG8_BAR; PG8_WAIT_L(0); PG8_MMA(0, 1, At, B1); PG8_BAR;
            PG8_LDA(At, 0, 1); PG8_STAGE(PG8_SA(0, 0), a2, voffA);
            PG8_BAR; PG8_WAIT_L(0); PG8_MMA(1, 0, At, B0); PG8_BAR; PG8_SCHED;
            PG8_STAGE(PG8_SB(0, 1), b2 + hstep, voffB);
            PG8_WAIT_V(6); PG8_BAR; PG8_MMA(1, 1, At, B1); PG8_BAR;
            PG8_LDB(B0, 1, 0); PG8_SCHED; PG8_LDA(At, 1, 0); PG8_STAGE(PG8_SA(0, 1), a2 + hstep, voffA);
            PG8_WAIT_L(8); PG8_BAR; PG8_WAIT_L(0); PG8_MMA(0, 0, At, B0); PG8_BAR; PG8_SCHED;
            PG8_LDB(B1, 1, 1); PG8_STAGE(PG8_SB(1, 0), b3, voffB);
            PG8_BAR; PG8_WAIT_L(0); PG8_MMA(0, 1, At, B1); PG8_BAR;
            PG8_LDA(At, 1, 1); PG8_STAGE(PG8_SA(1, 0), a3, voffA);
            PG8_BAR; PG8_WAIT_L(0); PG8_MMA(1, 0, At, B0); PG8_BAR; PG8_SCHED;
            PG8_STAGE(PG8_SB(1, 1), b3 + hstep, voffB);
            PG8_WAIT_V(6); PG8_BAR; PG8_MMA(1, 1, At, B1); PG8_BAR;
        }
        E(acc, cur, wr, wc, fr, fq);
        if (!has_next) break;
#pragma unroll
        for (int a = 0; a < 2; ++a)
#pragma unroll
            for (int b = 0; b < 2; ++b)
#pragma unroll
                for (int m = 0; m < 4; ++m)
#pragma unroll
                    for (int n = 0; n < 2; ++n) acc[a][b][m][n] = (f32x4){0.f, 0.f, 0.f, 0.f};
        cur = nxt; cA = nA; cB = nB; ++ui;
    }
    PG8_WAIT_V(0);
    if (wr == 0) PG8_BAR;
    PG8_BAR;
#undef PG8_SA
#undef PG8_SB
#undef PG8_STAGE
#undef PG8_LDA
#undef PG8_LDB
#undef PG8_MMA
#undef PG8_WAIT_V
#undef PG8_WAIT_L
#undef PG8_BAR
#undef PG8_SCHED
}
}

struct EpiFfnIn {
    static constexpr bool PERM = true;
    bf16_t* H; const float* ssq; int g;
    __device__ __forceinline__ void operator()(const f32x4 (&acc)[2][2][4][2], const pg8::Unit& u, int wr, int wc, int fr, int fq) const {
        const int R0 = grow_tile(g, u.pm);
        const int col0 = u.pn * 128 + wc * 32 + 8 * fq;
#pragma unroll
        for (int ai = 0; ai < 2; ++ai)
#pragma unroll
            for (int m = 0; m < 4; ++m) {
                const int rt = ai * 128 + wr * 64 + m * 16 + fr;
                const float rs = rsqrtf(ssq[R0 + rt] * (1.f / 1024.f) + EPS);
                float hv[8];
#pragma unroll
                for (int n = 0; n < 2; ++n)
#pragma unroll
                    for (int j = 0; j < 4; ++j) { const float a = acc[ai][0][m][n][j] * rs, b = acc[ai][1][m][n][j] * rs; hv[n * 4 + j] = a * sigmoid_f(a) * b; }
                u32x4 w; w.x = pk2(hv[0], hv[1]); w.y = pk2(hv[2], hv[3]); w.z = pk2(hv[4], hv[5]); w.w = pk2(hv[6], hv[7]);
                *(u32x4*)(H + (size_t)(u.pm * 256 + rt) * DFF + col0) = w;
            }
    }
};
struct EpiRes {
    static constexpr bool PERM = true;
    const float* xp; const float* xs; float* out; bf16_t* XB; float* ssq; float scale; int g; int from_input;
    __device__ __forceinline__ void operator()(const f32x4 (&acc)[2][2][4][2], const pg8::Unit& u, int wr, int wc, int fr, int fq) const {
        const int R0 = grow_tile(g, u.pm);
#pragma unroll
        for (int ai = 0; ai < 2; ++ai)
#pragma unroll
            for (int m = 0; m < 4; ++m) {
                const int rt = ai * 128 + wr * 64 + m * 16 + fr; const int R = R0 + rt;
                const float* xo = from_input ? (R < 32768 ? xp + (size_t)R * DM : xs + (size_t)(R - 32768) * DM) : out + (size_t)R * DM;
                float* xw = out + (size_t)R * DM;
                bf16_t* xb = XB + (size_t)(u.pm * 256 + rt) * DM;
                float part = 0.f;
#pragma unroll
                for (int bj = 0; bj < 2; ++bj) {
                    const int c0 = u.pn * 256 + bj * 128 + wc * 32 + 8 * fq;
                    const f32x4 o0 = *(const f32x4*)(xo + c0), o1 = *(const f32x4*)(xo + c0 + 4);
                    const f32x4 n0 = o0 + acc[ai][bj][m][0] * scale, n1 = o1 + acc[ai][bj][m][1] * scale;
                    *(f32x4*)(xw + c0) = n0; *(f32x4*)(xw + c0 + 4) = n1;
                    u32x4 w; w.x = pk2(n0[0], n0[1]); w.y = pk2(n0[2], n0[3]); w.z = pk2(n1[0], n1[1]); w.w = pk2(n1[2], n1[3]);
                    *(u32x4*)(xb + c0) = w;
                    part += (n0[0] * n0[0] + n0[1] * n0[1]) + (n0[2] * n0[2] + n0[3] * n0[3]) + (n1[0] * n1[0] + n1[1] * n1[1]) + (n1[2] * n1[2] + n1[3] * n1[3]);
                }
                part += __shfl_xor(part, 16); part += __shfl_xor(part, 32);
                if (fq == 0) atomicAdd(ssq + R, part);
                asm volatile("" ::: "memory");
            }
    }
};
struct EpiWin {
    static constexpr bool PERM = true;
    bf16_t* P; const float* ssq; const float* lbA; const float* lbB; const float* bg; int g;
    __device__ __forceinline__ void operator()(const f32x4 (&acc)[2][2][4][2], const pg8::Unit& u, int wr, int wc, int fr, int fq) const {
        const int R0 = grow_tile(g, u.pm);
        const int pn = u.pn;
        const int mode = (pn >= 2 && pn <= 5) ? 1 : (pn == 8 || pn == 9) ? 2 : (pn == 14 || pn == 15) ? 4 : (pn >= 16) ? 5 : 0;
#pragma unroll
        for (int bj = 0; bj < 2; ++bj) {
            const int cin = bj * 128 + wc * 32 + 8 * fq;
            float ca[8], cb[8];
            if (mode == 1) { const int lc = 256 * (pn - 2) + cin;
#pragma unroll
                for (int j = 0; j < 8; ++j) { ca[j] = lbA[lc + j]; cb[j] = lbB[lc + j]; } }
            else if (mode == 4) { const int lc = 256 * (pn - 14) + cin;
#pragma unroll
                for (int j = 0; j < 8; ++j) { ca[j] = bg[lc + j]; cb[j] = 0.f; } }
            else {
#pragma unroll
                for (int j = 0; j < 8; ++j) { ca[j] = 0.f; cb[j] = 0.f; } }
#pragma unroll
            for (int ai = 0; ai < 2; ++ai)
#pragma unroll
                for (int m = 0; m < 4; ++m) {
                    const int rt = ai * 128 + wr * 64 + m * 16 + fr;
                    const float rs = rsqrtf(ssq[R0 + rt] * (1.f / 1024.f) + EPS);
                    float v[8];
#pragma unroll
                    for (int n = 0; n < 2; ++n)
#pragma unroll
                        for (int j = 0; j < 4; ++j) v[n * 4 + j] = acc[ai][bj][m][n][j] * rs;
                    if (mode == 1) {
#pragma unroll
                        for (int j = 0; j < 8; ++j) { const float bb = cb[j] + logsig_f(v[j]), aa = ca[j]; v[j] = fmaxf(aa, bb) + __logf(1.f + __expf(-fabsf(aa - bb))); }
                    } else if (mode == 2) {
#pragma unroll
                        for (int j = 0; j < 8; ++j) v[j] = sigmoid_f(v[j]);
                    } else if (mode == 4) {
#pragma unroll
                        for (int j = 0; j < 8; ++j) v[j] = logsig_f(v[j] + ca[j]) * (1.f / 16.f);
                    } else if (mode == 5) {
#pragma unroll
                        for (int j = 0; j < 8; ++j) v[j] = v[j] * sigmoid_f(v[j]);
                    }
                    u32x4 w; w.x = pk2(v[0], v[1]); w.y = pk2(v[2], v[3]); w.z = pk2(v[4], v[5]); w.w = pk2(v[6], v[7]);
                    *(u32x4*)(P + (size_t)(u.pm * 256 + rt) * NP_ + pn * 256 + cin) = w;
                }
        }
    }
};

struct Args {
    const float* xp; const float* xs; const float* lower_bounds; const float* n1; const float* w1i; const float* w1o; const float* nm; const float* wi;
    const float* wg; const float* bg; const float* hgn; const float* glan; const float* wo; const float* n2; const float* w2i; const float* w2o; const float* nf;
    float* out; unsigned char* ws;
};

__device__ __forceinline__ void p0_convert(const Args& A) {
    const long nth = (long)gridDim.x * NTHREADS, gt = (long)blockIdx.x * NTHREADS + threadIdx.x;
    unsigned char* ws = A.ws;
    const long cnt[6] = {(long)NFF * 128, (long)DM * 352, (long)NP_ * 128, (long)DM * 128, (long)NFF * 128, (long)DM * 352};
    const long per_layer = cnt[0] + cnt[1] + cnt[2] + cnt[3] + cnt[4] + cnt[5];
    for (long it = gt; it < 2 * per_layer; it += nth) {
        const int l = it >= per_layer ? 1 : 0; long i = it - (long)l * per_layer;
        int job = 0;
#pragma unroll
        for (int j = 0; j < 5; ++j) if (job == j && i >= cnt[j]) { i -= cnt[j]; job = j + 1; }
        unsigned char* wl = ws + OFF_W + (size_t)l * SZ_LAYER;
        float v[8];
        bf16_t* dst;
        if (job == 0 || job == 4) {
            const int np = (int)(i % NFF), k0 = (int)(i / NFF) * 8;
            const float* W = (job == 0 ? A.w1i : A.w2i) + (size_t)l * DM * NFF; const float* gn = (job == 0 ? A.n1 : A.n2) + l * DM;
            const int n = ((np & 128) ? DFF : 0) + (np >> 8) * 128 + (np & 127);
#pragma unroll
            for (int e = 0; e < 8; ++e) v[e] = W[(size_t)(k0 + e) * NFF + n] * gn[k0 + e];
            dst = (bf16_t*)(wl + (job == 0 ? 0 : SZ_W1I + SZ_W1O + SZ_WIN + SZ_WO)) + (size_t)np * DM + k0;
        } else if (job == 1 || job == 5) {
            const int np = (int)(i % DM), k0 = (int)(i / DM) * 8;
            const float* W = (job == 1 ? A.w1o : A.w2o) + (size_t)l * DFF * DM;
#pragma unroll
            for (int e = 0; e < 8; ++e) v[e] = W[(size_t)(k0 + e) * DM + np];
            dst = (bf16_t*)(wl + (job == 1 ? SZ_W1I : 2 * SZ_W1I + SZ_W1O + SZ_WIN + SZ_WO)) + (size_t)np * DFF + k0;
        } else if (job == 3) {
            const int np = (int)(i % DM), k0 = (int)(i / DM) * 8;
            const float* W = A.wo + (size_t)l * DM * DM;
#pragma unroll
            for (int e = 0; e < 8; ++e) v[e] = W[(size_t)(k0 + e) * DM + np];
            dst = (bf16_t*)(wl + SZ_W1I + SZ_W1O + SZ_WIN) + (size_t)np * DM + k0;
        } else {
            const int np = (int)(i % NP_), k0 = (int)(i / NP_) * 8;
            const float* W = A.wi + (size_t)l * DM * DINSRC; const float* gn = A.nm + l * DM;
            if (np >= 3584 && np < 4096) {
                const int d = np >= 3840 ? 1 : 0, c = np - 3584 - 256 * d;
                const float* G = A.wg + ((size_t)l * 2 + d) * 16 * 256;
                float gc[16];
#pragma unroll
                for (int r = 0; r < 16; ++r) gc[r] = G[r * 256 + c];
#pragma unroll
                for (int e = 0; e < 8; ++e) { const float* wr_ = W + (size_t)(k0 + e) * DINSRC + 3584 + 16 * d; float s = 0.f;
#pragma unroll
                    for (int r = 0; r < 16; ++r) s += wr_[r] * gc[r];
                    v[e] = s * gn[k0 + e]; }
            } else {
                const int n = np < 3584 ? np : 3616 + (np - 4096);
                const float sc = (np >= 2560 && np < 2816) ? 0.125f : 1.f;
#pragma unroll
                for (int e = 0; e < 8; ++e) v[e] = W[(size_t)(k0 + e) * DINSRC + n] * gn[k0 + e] * sc;
            }
            dst = (bf16_t*)(wl + SZ_W1I + SZ_W1O) + (size_t)np * DM + k0;
        }
        u32x4 w; w.x = pk2(v[0], v[1]); w.y = pk2(v[2], v[3]); w.z = pk2(v[4], v[5]); w.w = pk2(v[6], v[7]);
        *(u32x4*)dst = w;
    }
    float* lbt = (float*)(ws + OFF_LBT);
    for (long i = gt; i < 2048; i += nth) {
        const int l = (int)(i >> 10), c = (int)(i & 1023);
        const float a = A.lower_bounds[c], b = A.lower_bounds[1024 + c], mx = fmaxf(a, b);
        const float ea = __expf(a - mx), eb = __expf(b - mx);
        const float lb = l == 0 ? 0.f : eb / (ea + eb);
        lbt[l * 2048 + c] = logf(fmaxf(lb, 1e-30f));
        lbt[l * 2048 + 1024 + c] = log1pf(-lb);
    }
    float* ssq = (float*)(ws + OFF_SSQ);
    for (long i = gt; i < (long)6 * MTOT; i += nth) ssq[MTOT + i] = 0.f;
}

__device__ __forceinline__ void g0_prologue(const float* xp, const float* xs, unsigned char* ws, int g) {
    int tid_ = threadIdx.x; asm volatile("" : "+v"(tid_));
    const int lane = tid_ & 63, wv = blockIdx.x * 8 + (tid_ >> 6), nwv = gridDim.x * 8;
    bf16_t* XB = (bf16_t*)(ws + OFF_XB); float* ssq = (float*)(ws + OFF_SSQ);
    for (int r = wv; r < MG; r += nwv) {
        const int R = grow(g, r);
        const float* x = R < 32768 ? xp + (size_t)R * DM : xs + (size_t)(R - 32768) * DM;
        float s = 0.f;
#pragma unroll
        for (int i = 0; i < 4; ++i) { const f32x4 v = *(const f32x4*)(x + i * 256 + lane * 4);
            s += (v[0] * v[0] + v[1] * v[1]) + (v[2] * v[2] + v[3] * v[3]);
            u32x2 w; w.x = pk2(v[0], v[1]); w.y = pk2(v[2], v[3]); *(u32x2*)(XB + (size_t)r * DM + i * 256 + lane * 4) = w; }
#pragma unroll
        for (int o = 32; o >= 1; o >>= 1) s += __shfl_xor(s, o);
        if (lane == 0) ssq[R] = s;
    }
}
__device__ __forceinline__ void final_norm(float* outp, const float* nf, unsigned char* ws, int g) {
    int tid_ = threadIdx.x; asm volatile("" : "+v"(tid_));
    const int lane = tid_ & 63, wv = blockIdx.x * 8 + (tid_ >> 6), nwv = gridDim.x * 8;
    const float* ssq = (const float*)(ws + OFF_SSQ) + (size_t)6 * MTOT;
    for (int r = wv; r < MG; r += nwv) {
        const int R = grow(g, r);
        float* x = outp + (size_t)R * DM;
        const float rs = rsqrtf(ssq[R] * (1.f / 1024.f) + EPS);
#pragma unroll
        for (int i = 0; i < 4; ++i) { const int c = i * 256 + lane * 4; f32x4 v = *(const f32x4*)(x + c); const f32x4 gn = *(const f32x4*)(nf + c); v = v * rs * gn; *(f32x4*)(x + c) = v; }
    }
}

#define MFMA32(a, b, c) __builtin_amdgcn_mfma_f32_32x32x16_bf16((a), (b), (c), 0, 0, 0)
constexpr int SC_QT = 0, SC_KT = 34816, SC_VT = 69632, SC_ST = 104448, SC_TOT = 139264, SC_VEC = 143360, SC_RED = 144896, SC_END = 145920;
constexpr int TSTR = 272;

template <int DK>
__device__ __forceinline__ void scan_half(LAS unsigned char* L, const bf16_t* __restrict__ P, float* RAW, bf16_t* OBF, const float* __restrict__ gain,
                                          int seqbase, int T, int dir, int qcol, int kcol, int gcol, int vcol, int gatecol, int ocol,
                                          int j0, int j1, bool second, f32x16& S0, f32x16& S1) {
    constexpr bool GLA = (DK == 64);
    constexpr int NPAIR = DK / 2, NSEG = NTHREADS / NPAIR, SL = 128 / NSEG, QSTR = (DK + 8) * 2, NKS = DK / 16;
    int tid_ = threadIdx.x; asm volatile("" : "+v"(tid_));
    const int tid = tid_, lane = tid & 63, w = __builtin_amdgcn_readfirstlane(tid >> 6);
    const int r = lane & 31, h = lane >> 5;
    const int cp = tid % NPAIR, seg = tid / NPAIR, vp = tid & 63, vseg = tid >> 6;
    const int tb = w >> 1, dh = w & 1, dvb_s = w & 3, kq = w >> 2;
    unsigned g2[SL], q2[SL], k2[SL], v2[16];

#define ROWOF(j, i) (seqbase + (dir ? (T - 1 - ((j) * 128 + (i))) : ((j) * 128 + (i))))
#define LOAD_CHUNK(j) do { \
        _Pragma("unroll") for (int i_ = 0; i_ < SL; ++i_) { const unsigned* pr_ = (const unsigned*)(P + (size_t)ROWOF(j, seg * SL + i_) * NP_); \
            g2[i_] = pr_[(gcol >> 1) + cp]; q2[i_] = pr_[(qcol >> 1) + cp]; if (GLA) k2[i_] = pr_[(kcol >> 1) + cp]; else k2[i_] = 0u; } \
        _Pragma("unroll") for (int i_ = 0; i_ < 16; ++i_) { const unsigned* pr_ = (const unsigned*)(P + (size_t)ROWOF(j, vseg * 16 + i_) * NP_); v2[i_] = pr_[(vcol >> 1) + vp]; } \
    } while (0)

    LOAD_CHUNK(j0);
    for (int j = j0; j < j1; ++j) {
        float c0[SL], c1[SL];
        { float s0 = 0.f, s1 = 0.f;
#pragma unroll
          for (int i = 0; i < SL; ++i) { s0 += bflo(g2[i]); s1 += bfhi(g2[i]); c0[i] = s0; c1[i] = s1; }
          *(LAS f32x2*)(L + SC_TOT + (seg * DK + 2 * cp) * 4) = (f32x2){s0, s1}; }
        __syncthreads();
        float off0 = 0.f, off1 = 0.f, m0 = 0.f, m1 = 0.f, bl0 = 0.f, bl1 = 0.f;
#pragma unroll
        for (int s = 0; s < NSEG; ++s) { const f32x2 t = *(const LAS f32x2*)(L + SC_TOT + (s * DK + 2 * cp) * 4);
            if (s < seg) { off0 += t.x; off1 += t.y; }
            if (s < NSEG / 2) { m0 += t.x; m1 += t.y; }
            bl0 += t.x; bl1 += t.y; }
        unsigned kk[SL];
#pragma unroll
        for (int i = 0; i < SL; ++i) {
            const float e0 = fminf(fmaxf(off0 + c0[i] - m0, -80.f), 80.f), e1 = fminf(fmaxf(off1 + c1[i] - m1, -80.f), 80.f);
            const float x0 = __expf(e0), x1 = __expf(e1), y0 = __expf(-e0), y1 = __expf(-e1);
            float ka, kb;
            if (GLA) { ka = bflo(k2[i]); kb = bfhi(k2[i]); } else { ka = 1.f - __expf(bflo(g2[i])); kb = 1.f - __expf(bfhi(g2[i])); }
            const unsigned qq = pk2(bflo(q2[i]) * x0, bfhi(q2[i]) * x1);
            kk[i] = pk2(ka * y0, kb * y1);
            *(LAS unsigned*)(L + SC_QT + (seg * SL + i) * QSTR + 4 * cp) = qq;
            *(LAS unsigned*)(L + SC_KT + (seg * SL + i) * QSTR + 4 * cp) = kk[i];
        }
        {
            u32x4 a0, a1, b0, b1;
            a0.x = (v2[0] & 0xffffu) | (v2[1] << 16); a0.y = (v2[2] & 0xffffu) | (v2[3] << 16); a0.z = (v2[4] & 0xffffu) | (v2[5] << 16); a0.w = (v2[6] & 0xffffu) | (v2[7] << 16);
            a1.x = (v2[8] & 0xffffu) | (v2[9] << 16); a1.y = (v2[10] & 0xffffu) | (v2[11] << 16); a1.z = (v2[12] & 0xffffu) | (v2[13] << 16); a1.w = (v2[14] & 0xffffu) | (v2[15] << 16);
            b0.x = (v2[0] >> 16) | (v2[1] & 0xffff0000u); b0.y = (v2[2] >> 16) | (v2[3] & 0xffff0000u); b0.z = (v2[4] >> 16) | (v2[5] & 0xffff0000u); b0.w = (v2[6] >> 16) | (v2[7] & 0xffff0000u);
            b1.x = (v2[8] >> 16) | (v2[9] & 0xffff0000u); b1.y = (v2[10] >> 16) | (v2[11] & 0xffff0000u); b1.z = (v2[12] >> 16) | (v2[13] & 0xffff0000u); b1.w = (v2[14] >> 16) | (v2[15] & 0xffff0000u);
            LAS unsigned char* pv = L + SC_VT + (2 * vp) * TSTR + vseg * 32;
            *(LAS u32x4*)(pv) = a0; *(LAS u32x4*)(pv + 16) = a1; *(LAS u32x4*)(pv + TSTR) = b0; *(LAS u32x4*)(pv + TSTR + 16) = b1;
        }
        if (seg == 0) {
            *(LAS f32x2*)(L + SC_VEC + (2 * cp) * 4) = (f32x2){__expf(m0), __expf(m1)};
            *(LAS f32x2*)(L + SC_VEC + 512 + (2 * cp) * 4) = (f32x2){__expf(bl0), __expf(bl1)};
            *(LAS f32x2*)(L + SC_VEC + 1024 + (2 * cp) * 4) = (f32x2){__expf(bl0 - m0), __expf(bl1 - m1)};
        }
        if (j + 1 < j1) LOAD_CHUNK(j + 1);
        __syncthreads();
#pragma unroll
        for (int ti = 0; ti < (GLA ? 1 : 2); ++ti) {
            const int kb_ = GLA ? kq : 2 * kq + ti;
            const f32x16& Sx = ti == 0 ? S0 : S1;
#pragma unroll
            for (int gq = 0; gq < 4; ++gq) {
                const int k = 32 * kb_ + 8 * gq + 4 * h;
                const f32x4 em = *(const LAS f32x4*)(L + SC_VEC + k * 4);
                u32x2 wv; wv.x = pk2(Sx[4 * gq] * em[0], Sx[4 * gq + 1] * em[1]); wv.y = pk2(Sx[4 * gq + 2] * em[2], Sx[4 * gq + 3] * em[3]);
                *(LAS u32x2*)(L + SC_ST + (32 * dvb_s + r) * QSTR + k * 2) = wv;
            }
        }
        bf16x8 qf[NKS];
#pragma unroll
        for (int ks = 0; ks < NKS; ++ks) qf[ks] = *(const LAS bf16x8*)(L + SC_QT + (32 * tb + r) * QSTR + (16 * ks + 8 * h) * 2);
        bf16x8 ps[4][2];
#pragma unroll
        for (int sb = 0; sb < 4; ++sb) {
            if (sb <= tb) {
                f32x16 x;
#pragma unroll
                for (int i = 0; i < 16; ++i) x[i] = 0.f;
#pragma unroll
                for (int ks = 0; ks < NKS; ++ks) { const bf16x8 a = *(const LAS bf16x8*)(L + SC_KT + (32 * sb + r) * QSTR + (16 * ks + 8 * h) * 2); x = MFMA32(a, qf[ks], x); }
                if (sb == tb) {
#pragma unroll
                    for (int i = 0; i < 16; ++i) { const int cr = (i & 3) + 8 * (i >> 2) + 4 * h; x[i] = cr <= r ? x[i] : 0.f; }
                }
#pragma unroll
                for (int ss = 0; ss < 2; ++ss) { u32x4 pw; pw.x = pk2(x[8 * ss], x[8 * ss + 1]); pw.y = pk2(x[8 * ss + 2], x[8 * ss + 3]); pw.z = pk2(x[8 * ss + 4], x[8 * ss + 5]); pw.w = pk2(x[8 * ss + 6], x[8 * ss + 7]);
                    ps[sb][ss] = __builtin_bit_cast(bf16x8, pw); }
            } else { ps[sb][0] = (bf16x8){0, 0, 0, 0, 0, 0, 0, 0}; ps[sb][1] = (bf16x8){0, 0, 0, 0, 0, 0, 0, 0}; }
        }
        __syncthreads();
        {
            LAS unsigned char* pk_ = L + SC_KT + (2 * cp) * TSTR + seg * SL * 2;
            if (SL == 16) {
                u32x4 a0, a1, b0, b1;
                a0.x = (kk[0] & 0xffffu) | (kk[1] << 16); a0.y = (kk[2] & 0xffffu) | (kk[3] << 16); a0.z = (kk[4] & 0xffffu) | (kk[5] << 16); a0.w = (kk[6] & 0xffffu) | (kk[7] << 16);
                a1.x = (kk[8 % SL] & 0xffffu) | (kk[9 % SL] << 16); a1.y = (kk[10 % SL] & 0xffffu) | (kk[11 % SL] << 16); a1.z = (kk[12 % SL] & 0xffffu) | (kk[13 % SL] << 16); a1.w = (kk[14 % SL] & 0xffffu) | (kk[15 % SL] << 16);
                b0.x = (kk[0] >> 16) | (kk[1] & 0xffff0000u); b0.y = (kk[2] >> 16) | (kk[3] & 0xffff0000u); b0.z = (kk[4] >> 16) | (kk[5] & 0xffff0000u); b0.w = (kk[6] >> 16) | (kk[7] & 0xffff0000u);
                b1.x = (kk[8 % SL] >> 16) | (kk[9 % SL] & 0xffff0000u); b1.y = (kk[10 % SL] >> 16) | (kk[11 % SL] & 0xffff0000u); b1.z = (kk[12 % SL] >> 16) | (kk[13 % SL] & 0xffff0000u); b1.w = (kk[14 % SL] >> 16) | (kk[15 % SL] & 0xffff0000u);
                *(LAS u32x4*)(pk_) = a0; *(LAS u32x4*)(pk_ + 16) = a1; *(LAS u32x4*)(pk_ + TSTR) = b0; *(LAS u32x4*)(pk_ + TSTR + 16) = b1;
            } else {
                u32x4 a0, b0;
                a0.x = (kk[0] & 0xffffu) | (kk[1] << 16); a0.y = (kk[2] & 0xffffu) | (kk[3] << 16); a0.z = (kk[4] & 0xffffu) | (kk[5] << 16); a0.w = (kk[6] & 0xffffu) | (kk[7] << 16);
                b0.x = (kk[0] >> 16) | (kk[1] & 0xffff0000u); b0.y = (kk[2] >> 16) | (kk[3] & 0xffff0000u); b0.z = (kk[4] >> 16) | (kk[5] & 0xffff0000u); b0.w = (kk[6] >> 16) | (kk[7] & 0xffff0000u);
                *(LAS u32x4*)(pk_) = a0; *(LAS u32x4*)(pk_ + TSTR) = b0;
            }
        }
        f32x16 O[2];
#pragma unroll
        for (int dvi = 0; dvi < 2; ++dvi) {
            const int dvb = 2 * dh + dvi;
            f32x16 o;
#pragma unroll
            for (int i = 0; i < 16; ++i) o[i] = 0.f;
#pragma unroll
            for (int ks = 0; ks < NKS; ++ks) { const bf16x8 a = *(const LAS bf16x8*)(L + SC_ST + (32 * dvb + r) * QSTR + (16 * ks + 8 * h) * 2); o = MFMA32(a, qf[ks], o); }
#pragma unroll
            for (int sb = 0; sb < 4; ++sb) {
                if (sb <= tb) {
#pragma unroll
                    for (int ss = 0; ss < 2; ++ss) {
                        const LAS unsigned char* pa = L + SC_VT + (32 * dvb + r) * TSTR + (32 * sb + 16 * ss + 4 * h) * 2;
                        const s16x4 lo = *(const LAS s16x4*)(pa), hi = *(const LAS s16x4*)(pa + 16);
                        const bf16x8 a = __builtin_shufflevector(lo, hi, 0, 1, 2, 3, 4, 5, 6, 7);
                        o = MFMA32(a, ps[sb][ss], o);
                    }
                }
            }
            O[dvi] = o;
        }
        const int orow = ROWOF(j, 32 * tb + r);
        if (!second) {
#pragma unroll
            for (int dvi = 0; dvi < 2; ++dvi)
#pragma unroll
                for (int gq = 0; gq < 4; ++gq) {
                    const int dv = 32 * (2 * dh + dvi) + 8 * gq + 4 * h;
                    *(f32x4*)(RAW + (size_t)orow * DM + ocol + dv) = (f32x4){O[dvi][4 * gq], O[dvi][4 * gq + 1], O[dvi][4 * gq + 2], O[dvi][4 * gq + 3]};
                }
        } else {
            float ssum = 0.f;
#pragma unroll
            for (int dvi = 0; dvi < 2; ++dvi)
#pragma unroll
                for (int gq = 0; gq < 4; ++gq) {
                    const int dv = 32 * (2 * dh + dvi) + 8 * gq + 4 * h;
                    const f32x4 pr = *(const f32x4*)(RAW + (size_t)orow * DM + ocol + dv);
#pragma unroll
                    for (int e = 0; e < 4; ++e) { const float t = O[dvi][4 * gq + e] + pr[e]; O[dvi][4 * gq + e] = t; ssum += t * t; }
                }
            ssum += __shfl_xor(ssum, 32);
            if (h == 0) *(LAS float*)(L + SC_RED + (w * 32 + r) * 4) = ssum;
        }
        __syncthreads();
        if (second) {
            const float tot = *(const LAS float*)(L + SC_RED + (w * 32 + r) * 4) + *(const LAS float*)(L + SC_RED + ((w ^ 1) * 32 + r) * 4);
            const float rs = rsqrtf(tot * (1.f / 128.f) + EPS);
#pragma unroll
            for (int dvi = 0; dvi < 2; ++dvi)
#pragma unroll
                for (int gq = 0; gq < 4; ++gq) {
                    const int dv = 32 * (2 * dh + dvi) + 8 * gq + 4 * h;
                    const f32x4 gn = *(const f32x4*)(gain + dv);
                    const u32x2 gt = *(const u32x2*)(P + (size_t)orow * NP_ + gatecol + dv);
                    u32x2 wv; wv.x = pk2(O[dvi][4 * gq] * rs * gn[0] * bflo(gt.x), O[dvi][4 * gq + 1] * rs * gn[1] * bfhi(gt.x));
                    wv.y = pk2(O[dvi][4 * gq + 2] * rs * gn[2] * bflo(gt.y), O[dvi][4 * gq + 3] * rs * gn[3] * bfhi(gt.y));
                    *(u32x2*)(OBF + (size_t)orow * DM + ocol + dv) = wv;
                }
        }
#pragma unroll
        for (int ti = 0; ti < (GLA ? 1 : 2); ++ti) {
            const int kb_ = GLA ? kq : 2 * kq + ti;
            f32x16 pkv;
#pragma unroll
            for (int i = 0; i < 16; ++i) pkv[i] = 0.f;
#pragma unroll
            for (int ks = 0; ks < 8; ++ks) {
                const bf16x8 a = *(const LAS bf16x8*)(L + SC_KT + (32 * kb_ + r) * TSTR + (16 * ks + 8 * h) * 2);
                const bf16x8 b = *(const LAS bf16x8*)(L + SC_VT + (32 * dvb_s + r) * TSTR + (16 * ks + 8 * h) * 2);
                pkv = MFMA32(a, b, pkv);
            }
            f32x16& Sx = ti == 0 ? S0 : S1;
#pragma unroll
            for (int gq = 0; gq < 4; ++gq) {
                const int k = 32 * kb_ + 8 * gq + 4 * h;
                const f32x4 eb = *(const LAS f32x4*)(L + SC_VEC + 512 + k * 4), ebm = *(const LAS f32x4*)(L + SC_VEC + 1024 + k * 4);
#pragma unroll
                for (int e = 0; e < 4; ++e) Sx[4 * gq + e] = eb[e] * Sx[4 * gq + e] + ebm[e] * pkv[4 * gq + e];
            }
        }
    }
    __syncthreads();
#undef ROWOF
#undef LOAD_CHUNK
}


template <class T> __device__ __forceinline__ T* opaque_ptr(T* p) { asm volatile("" : "+s"(p)); return p; }
__device__ __forceinline__ unsigned opaque_zero() { unsigned z; asm volatile("s_mov_b32 %0, 0" : "=s"(z)); return z; }
__device__ __forceinline__ void gbar(unsigned* ctr, unsigned target) {
    asm volatile("s_waitcnt vmcnt(0)" ::: "memory");
    __syncthreads();
    if (threadIdx.x == 0) {
        __builtin_amdgcn_fence(__ATOMIC_RELEASE, "agent");
        asm volatile("s_waitcnt vmcnt(0)" ::: "memory");
        __hip_atomic_fetch_add(ctr, 1u, __ATOMIC_RELAXED, __HIP_MEMORY_SCOPE_AGENT);
        while (__hip_atomic_load(ctr, __ATOMIC_RELAXED, __HIP_MEMORY_SCOPE_AGENT) < target) __builtin_amdgcn_s_sleep(2);
        __builtin_amdgcn_fence(__ATOMIC_ACQUIRE, "agent");
        asm volatile("s_waitcnt vmcnt(0)" ::: "memory");
    }
    __syncthreads();
}

__global__ void __launch_bounds__(NTHREADS) hymba_fwd(Args A) {
    extern __shared__ __attribute__((aligned(16))) unsigned char lds_raw[];
    cg::grid_group grid = cg::this_grid();
    unsigned nbar = 0;
#define PH_BEGIN() const unsigned zs = opaque_zero(); LAS unsigned char* L = (LAS unsigned char*)lds_raw + zs; unsigned char* ws = opaque_ptr(A.ws); const int G = (int)(gridDim.x + zs), bid = (int)(blockIdx.x + zs); const float* xp = opaque_ptr(A.xp); const float* xs = opaque_ptr(A.xs); float* outp = opaque_ptr(A.out); (void)L; (void)ws; (void)G; (void)bid; (void)xp; (void)xs; (void)outp
#define GBAR() do { nbar += 256u; gbar((unsigned*)(A.ws + OFF_BAR + opaque_zero()), nbar); } while (0)

    { PH_BEGIN(); p0_convert(A); }
    grid.sync();

#pragma unroll 1
    for (int g = 0; g < NGRP; ++g) {
        { PH_BEGIN(); g0_prologue(xp, xs, ws, g); }
        GBAR();
#pragma unroll 1
        for (int l = 0; l < 2; ++l) {
            const size_t wlo = OFF_W + (size_t)l * SZ_LAYER;
            const size_t sq = OFF_SSQ + (size_t)(3 * l) * MTOT * 4;
            { PH_BEGIN(); pg8::Gemm gm{(const bf16_t*)(ws + OFF_XB), (const bf16_t*)(ws + wlo), MG, NFF, DM}; pg8::StaticOrder S; S.init(MG, NFF, G, bid);
              EpiFfnIn E{(bf16_t*)(ws + OFF_PH), (const float*)(ws + sq), g}; pg8::gemm_phase(L, gm, S, E); }
            GBAR();
            { PH_BEGIN(); pg8::Gemm gm{(const bf16_t*)(ws + OFF_PH), (const bf16_t*)(ws + wlo + SZ_W1I), MG, DM, DFF}; pg8::StaticOrder S; S.init(MG, DM, G, bid);
              EpiRes E{xp, xs, outp, (bf16_t*)(ws + OFF_XB), (float*)(ws + sq) + MTOT, 0.5f, g, l == 0 ? 1 : 0}; pg8::gemm_phase(L, gm, S, E); }
            GBAR();
            { PH_BEGIN(); pg8::Gemm gm{(const bf16_t*)(ws + OFF_XB), (const bf16_t*)(ws + wlo + SZ_W1I + SZ_W1O), MG, NP_, DM}; pg8::StaticOrder S; S.init(MG, NP_, G, bid);
              const float* LBT = (const float*)(ws + OFF_LBT) + l * 2048;
              EpiWin E{(bf16_t*)(ws + OFF_PH), (const float*)(ws + sq) + MTOT, LBT, LBT + 1024, A.bg + l * 512, g}; pg8::gemm_phase(L, gm, S, E); }
            GBAR();
            {
                f32x16 S0, S1;
#pragma unroll
                for (int i = 0; i < 16; ++i) { S0[i] = 0.f; S1[i] = 0.f; }
#pragma unroll 1
                for (int half = 0; half < 2; ++half) {
                    { PH_BEGIN();
                      const bf16_t* PH = (const bf16_t*)(ws + OFF_PH); float* RAW = (float*)(ws + OFF_RAW); bf16_t* OBF = (bf16_t*)(ws + OFF_OBF);
                      const int dir = bid & 1, hh = (bid >> 1) & 7, sidx = (bid >> 4) & 15;
                      const int T = sidx < 8 ? TPROMPT : TSAMPLE, seqbase = sidx < 8 ? sidx * TPROMPT : 16384 + (sidx - 8) * TSAMPLE, N = T / 128;
                      const int j0 = half ? N / 2 : 0, j1 = half ? N : N / 2;
                      if (hh < 4) { const int hd = hh;
                          scan_half<128>(L, PH, RAW, OBF, A.hgn + l * 512 + 128 * hd, seqbase, T, dir, 128 * hd, 0, (dir ? 1024 : 512) + 128 * hd, 1536 + 128 * hd, 2048 + 128 * hd, 128 * hd, j0, j1, half != 0, S0, S1);
                      } else { const int hd = hh - 4;
                          scan_half<64>(L, PH, RAW, OBF, A.glan + l * 512 + 128 * hd, seqbase, T, dir, 2560 + 64 * hd, 2816 + 64 * hd, (dir ? 3840 : 3584) + 64 * hd, 3072 + 128 * hd, 4096 + 128 * hd, 512 + 128 * hd, j0, j1, half != 0, S0, S1);
                      } }
                    GBAR();
                }
            }
            { PH_BEGIN(); pg8::Gemm gm{(const bf16_t*)(ws + OFF_OBF), (const bf16_t*)(ws + wlo + SZ_W1I + SZ_W1O + SZ_WIN), MG, DM, DM}; pg8::StaticOrder S; S.init(MG, DM, G, bid);
              EpiRes E{xp, xs, outp, (bf16_t*)(ws + OFF_XB), (float*)(ws + sq) + 2 * MTOT, 1.0f, g, 0}; pg8::gemm_phase(L, gm, S, E); }
            GBAR();
            { PH_BEGIN(); pg8::Gemm gm{(const bf16_t*)(ws + OFF_XB), (const bf16_t*)(ws + wlo + SZ_W1I + SZ_W1O + SZ_WIN + SZ_WO), MG, NFF, DM}; pg8::StaticOrder S; S.init(MG, NFF, G, bid);
              EpiFfnIn E{(bf16_t*)(ws + OFF_PH), (const float*)(ws + sq) + 2 * MTOT, g}; pg8::gemm_phase(L, gm, S, E); }
            GBAR();
            { PH_BEGIN(); pg8::Gemm gm{(const bf16_t*)(ws + OFF_PH), (const bf16_t*)(ws + wlo + 2 * SZ_W1I + SZ_W1O + SZ_WIN + SZ_WO), MG, DM, DFF}; pg8::StaticOrder S; S.init(MG, DM, G, bid);
              EpiRes E{xp, xs, outp, (bf16_t*)(ws + OFF_XB), (float*)(ws + sq) + 3 * MTOT, 0.5f, g, 0}; pg8::gemm_phase(L, gm, S, E); }
            GBAR();
        }
        { PH_BEGIN(); final_norm(outp, opaque_ptr(A.nf), ws, g); }
    }
#undef PH_BEGIN
#undef GBAR
}

constexpr int LDS_BYTES = 146432;
extern "C" void kernel_launch(void* const* d_in, const int* in_sizes, int n_in, void* d_out, int out_size, void* d_ws, size_t ws_size, hipStream_t stream) {
    static int ready = 0;
    if (!ready) {
        if (n_in != 17 || out_size != MTOT * DM || ws_size < WS_END) { fprintf(stderr, "kernel_launch: unexpected shapes (n_in %d out %d ws %zu need %zu)\n", n_in, out_size, ws_size, (size_t)WS_END); ready = -1; return; }
        if (hipFuncSetAttribute((const void*)hymba_fwd, hipFuncAttributeMaxDynamicSharedMemorySize, LDS_BYTES) != hipSuccess) { fprintf(stderr, "kernel_launch: hipFuncSetAttribute failed\n"); ready = -1; return; }
        int per_cu = 0; (void)hipOccupancyMaxActiveBlocksPerMultiprocessor(&per_cu, (const void*)hymba_fwd, NTHREADS, LDS_BYTES); (void)hipGetLastError();
        ready = 1;
    }
    if (ready < 0) return;
    if (hipMemsetAsync((char*)d_ws + OFF_BAR, 0, 256, stream) != hipSuccess) { fprintf(stderr, "kernel_launch: memset failed\n"); return; }
    Args a{};
    a.xp = (const float*)d_in[0]; a.xs = (const float*)d_in[1]; a.lower_bounds = (const float*)d_in[2]; a.n1 = (const float*)d_in[3]; a.w1i = (const float*)d_in[4]; a.w1o = (const float*)d_in[5];
    a.nm = (const float*)d_in[6]; a.wi = (const float*)d_in[7]; a.wg = (const float*)d_in[8]; a.bg = (const float*)d_in[9]; a.hgn = (const float*)d_in[10]; a.glan = (const float*)d_in[11];
    a.wo = (const float*)d_in[12]; a.n2 = (const float*)d_in[13]; a.w2i = (const float*)d_in[14]; a.w2o = (const float*)d_in[15]; a.nf = (const float*)d_in[16];
    a.out = (float*)d_out; a.ws = (unsigned char*)d_ws;
    void* args[] = {&a};
    hipError_t e = hipLaunchCooperativeKernel((const void*)hymba_fwd, dim3(256), dim3(NTHREADS), args, LDS_BYTES, stream);
    if (e != hipSuccess) fprintf(stderr, "cooperative launch failed: %s\n", hipGetErrorString(e));
}
```

```cpp
#include <hip/hip_runtime.h>
#include <hip/hip_cooperative_groups.h>
#include <cstdio>
namespace cg = cooperative_groups;

#define LAS __attribute__((address_space(3)))
typedef unsigned short bf16_t;
typedef short bf16x8 __attribute__((ext_vector_type(8)));
typedef short s16x4 __attribute__((ext_vector_type(4)));
typedef float f32x2 __attribute__((ext_vector_type(2)));
typedef float f32x4 __attribute__((ext_vector_type(4)));
typedef float f32x16 __attribute__((ext_vector_type(16)));
typedef unsigned u32x2 __attribute__((ext_vector_type(2)));
typedef unsigned u32x4 __attribute__((ext_vector_type(4)));

constexpr int DM = 1024, DFF = 2816, NFF = 5632, DINSRC = 4128, NP_ = 4608;
constexpr int MTOT = 98304, MG = 49152, NGRP = 2;
constexpr int TPROMPT = 2048, TSAMPLE = 4096;
constexpr float EPS = 1e-6f;
constexpr int NTHREADS = 512;
#ifndef PROBE_SCAN
#define PROBE_SCAN 1
#endif
#ifndef PROBE_FFNIN
#define PROBE_FFNIN 1
#endif
#ifndef PROBE_P0
#define PROBE_P0 1
#endif
#ifndef PROBE_WIN
#define PROBE_WIN 1
#endif
#ifndef PROBE_FFNOUT_NULL
#define PROBE_FFNOUT_NULL 0
#endif
#ifndef PROBE_BAR
#define PROBE_BAR 1
#endif

constexpr size_t SZ_W1I = (size_t)NFF * DM * 2, SZ_W1O = (size_t)DM * DFF * 2, SZ_WIN = (size_t)NP_ * DM * 2, SZ_WO = (size_t)DM * DM * 2;
constexpr size_t SZ_LAYER = 2 * SZ_W1I + 2 * SZ_W1O + SZ_WIN + SZ_WO;
constexpr size_t OFF_W = 0;
constexpr size_t OFF_LBT = OFF_W + 2 * SZ_LAYER;
constexpr size_t OFF_SSQ = OFF_LBT + 2 * 2 * 1024 * 4;
constexpr size_t SSQ_SITE = (size_t)MTOT * 16;
constexpr size_t OFF_XB = OFF_SSQ + 7 * SSQ_SITE * 4;
constexpr size_t OFF_OBF = OFF_XB + (size_t)MG * DM * 2;
constexpr size_t OFF_RAW = OFF_OBF + (size_t)MG * DM * 2;
constexpr size_t OFF_PH = OFF_RAW + (size_t)MG * DM * 4;
constexpr size_t OFF_BAR = OFF_PH + (size_t)MG * NP_ * 2;
constexpr size_t WS_END = OFF_BAR + 256;

__device__ __forceinline__ unsigned pk2(float lo, float hi) {
    typedef __bf16 bf2 __attribute__((ext_vector_type(2)));
    f32x2 v = {lo, hi};
    return __builtin_bit_cast(unsigned, __builtin_convertvector(v, bf2));
}
__device__ __forceinline__ float bflo(unsigned u) { return __uint_as_float(u << 16); }
__device__ __forceinline__ float bfhi(unsigned u) { return __uint_as_float(u & 0xffff0000u); }
__device__ __forceinline__ int grow_tile(int g, int pm) { return pm < 64 ? g * 16384 + pm * 256 : 32768 + g * 32768 + (pm - 64) * 256; }
__device__ __forceinline__ int grow(int g, int r) { return r < 16384 ? g * 16384 + r : 32768 + g * 32768 + (r - 16384); }
__device__ __forceinline__ float sigmoid_f(float x) { return __builtin_amdgcn_rcpf(1.f + __expf(-x)); }
__device__ __forceinline__ float logsig_f(float z) { return fminf(z, 0.f) - __logf(1.f + __expf(-fabsf(z))); }

__device__ __forceinline__ float row_rstd(const float* ssq16, int R, int fq) {
    const f32x4 v = *(const f32x4*)(ssq16 + (size_t)R * 16 + 4 * fq);
    float s = (v[0] + v[1]) + (v[2] + v[3]);
    s += __shfl_xor(s, 16); s += __shfl_xor(s, 32);
    return rsqrtf(s * (1.f / 1024.f) + EPS);
}

namespace pg8 {
constexpr int BM = 256, BK = 64, HALF = 128, HTB = HALF * BK * 2, STAGE_BYTES = 8 * HTB, NXCD = 8, WGM = 8;
__device__ __forceinline__ int lds_byte(int r, int c) { const int st = (r >> 4) * 2 + (c >> 5), rr = r & 15, cc = c & 31, ob = rr * 64 + cc * 2; return st * 1024 + (ob ^ (((ob >> 9) & 1) << 5)); }
__device__ __forceinline__ void stage_rc(int b, int& R, int& C) { const int st = b / 1024, sb = b % 1024, swz = sb ^ (((sb >> 9) & 1) << 5); R = (st >> 1) * 16 + swz / 64; C = (st & 1) * 32 + (swz % 64) / 2; }
__device__ __forceinline__ int perm32(int rho) { const int n = rho >> 4, i = rho & 15; return 8 * (i >> 2) + 4 * n + (i & 3); }
struct Unit { int pm, pn; };
struct Gemm { const bf16_t* A; const bf16_t* Bt; int M, N, K; };
struct StaticOrder {
    int nM, nN, nwg, G, c;
    __device__ void init(int M, int N, int G_, int c_) { nM = M / BM; nN = N / BM; nwg = nM * nN; G = G_; c = c_; }
    __device__ bool next(int i, Unit& u) const {
        const long L = (long)i * G + c; if (L >= nwg) return false;
        int wgid = (int)L; { const int q = nwg / NXCD, r = nwg % NXCD, xcd = wgid % NXCD, off = wgid / NXCD; wgid = (xcd < r ? xcd * (q + 1) : r * (q + 1) + (xcd - r) * q) + off; }
        const int nig = WGM * nN, gid = wgid / nig, fm = gid * WGM, gsz = (nM - fm) < WGM ? (nM - fm) : WGM;
        u.pm = fm + ((wgid % nig) % gsz); u.pn = (wgid % nig) / gsz; return true;
    }
};

template <class Epi>
__device__ __forceinline__ void gemm_phase(LAS unsigned char* lds, const Gemm g, const StaticOrder& S, const Epi& E) {
    int tid_ = threadIdx.x; asm volatile("" : "+v"(tid_));
    const int tid = tid_, wid = __builtin_amdgcn_readfirstlane(tid >> 6), lane = tid & 63, wr = wid >> 2, wc = wid & 3, fr = lane & 15, fq = lane >> 4;
    const int K = g.K, nt = K / BK;
    unsigned voffA[2], voffB[2];
#pragma unroll
    for (int i = 0; i < 2; ++i) { int R, C; stage_rc(tid * 16 + i * 8192, R, C); const int Rb = Epi::PERM ? ((R & ~31) + perm32(R & 31)) : R;
        voffA[i] = (unsigned)(R * K + C) * 2u; voffB[i] = (unsigned)(Rb * K + C) * 2u; }
    const size_t kstep = (size_t)(BK * 2);
    const size_t hstep = (size_t)HALF * K * 2;
    const size_t tstep = 2 * hstep;
    const unsigned ldsw = (unsigned)wid * 1024u;
    const int aoff = lds_byte(wr * 64 + fr, fq * 8), boff = lds_byte(wc * 32 + fr, fq * 8);
#define PG8_SA(b, h) (((b) * 2 + (h)) * HTB)
#define PG8_SB(b, h) ((4 + (b) * 2 + (h)) * HTB)
#define PG8_STAGE(bufoff, gbase, voff) do { _Pragma("unroll") for (int _i = 0; _i < 2; ++_i) \
        __builtin_amdgcn_global_load_lds((const unsigned*)((const char*)(gbase) + (voff)[_i]), (LAS unsigned*)(lds + (bufoff) + ldsw + _i * 8192), 16, 0, 0); } while (0)
#define PG8_LDA(dst, b, h) do { _Pragma("unroll") for (int m = 0; m < 4; ++m) _Pragma("unroll") for (int k = 0; k < 2; ++k) dst[m][k] = *(const LAS bf16x8*)(lds + PG8_SA(b, h) + aoff + m * 2048 + k * 1024); } while (0)
#define PG8_LDB(dst, b, h) do { _Pragma("unroll") for (int n = 0; n < 2; ++n) _Pragma("unroll") for (int k = 0; k < 2; ++k) dst[n][k] = *(const LAS bf16x8*)(lds + PG8_SB(b, h) + boff + n * 2048 + k * 1024); } while (0)
#define PG8_MMA(ai, bj, At, Bt) do { __builtin_amdgcn_s_setprio(1); _Pragma("unroll") for (int m = 0; m < 4; ++m) _Pragma("unroll") for (int n = 0; n < 2; ++n) _Pragma("unroll") for (int k = 0; k < 2; ++k) \
        acc[ai][bj][m][n] = __builtin_amdgcn_mfma_f32_16x16x32_bf16(Bt[n][k], At[m][k], acc[ai][bj][m][n], 0, 0, 0); __builtin_amdgcn_s_setprio(0); } while (0)
#define PG8_WAIT_V(n) asm volatile("s_waitcnt vmcnt(" #n ")" ::: "memory")
#define PG8_WAIT_L(n) asm volatile("s_waitcnt lgkmcnt(" #n ")" ::: "memory")
#define PG8_BAR __builtin_amdgcn_s_barrier()
#define PG8_SCHED __builtin_amdgcn_sched_barrier(0)
    Unit cur, nxt; int ui = 0;
    if (!S.next(0, cur)) return;
    f32x4 acc[2][2][4][2];
#pragma unroll
    for (int a = 0; a < 2; ++a)
#pragma unroll
        for (int b = 0; b < 2; ++b)
#pragma unroll
            for (int m = 0; m < 4; ++m)
#pragma unroll
                for (int n = 0; n < 2; ++n) acc[a][b][m][n] = (f32x4){0.f, 0.f, 0.f, 0.f};
    bf16x8 At[4][2], B0[2][2], B1[2][2];
    const char* cA = (const char*)g.A + (size_t)cur.pm * tstep; const char* cB = (const char*)g.Bt + (size_t)cur.pn * tstep;
    PG8_STAGE(PG8_SB(0, 0), cB, voffB); PG8_STAGE(PG8_SA(0, 0), cA, voffA); PG8_STAGE(PG8_SB(0, 1), cB + hstep, voffB); PG8_STAGE(PG8_SA(0, 1), cA + hstep, voffA);
    if (wr == 1) PG8_BAR;
    PG8_WAIT_V(4); PG8_BAR;
    PG8_STAGE(PG8_SB(1, 0), cB + kstep, voffB); PG8_STAGE(PG8_SA(1, 0), cA + kstep, voffA); PG8_STAGE(PG8_SB(1, 1), cB + hstep + kstep, voffB);
    PG8_WAIT_V(6); PG8_BAR;
    for (;;) {
        const bool has_next = S.next(ui + 1, nxt);
        const char* nA = has_next ? (const char*)g.A + (size_t)nxt.pm * tstep : cA; const char* nB = has_next ? (const char*)g.Bt + (size_t)nxt.pn * tstep : cB;
        for (int t = 0; t < nt; t += 2) {
            const bool last = (t == nt - 2);
            const char* a1 = cA + (size_t)(t + 1) * kstep;
            const char* a2 = last ? nA : cA + (size_t)(t + 2) * kstep; const char* b2 = last ? nB : cB + (size_t)(t + 2) * kstep;
            const char* a3 = a2 + kstep; const char* b3 = b2 + kstep;
            PG8_LDB(B0, 0, 0); PG8_SCHED; PG8_LDA(At, 0, 0); PG8_STAGE(PG8_SA(1, 1), a1 + hstep, voffA);
            PG8_WAIT_L(8); PG8_BAR; PG8_WAIT_L(0); PG8_MMA(0, 0, At, B0); PG8_BAR; PG8_SCHED;
            PG8_LDB(B1, 0, 1); PG8_STAGE(PG8_SB(0, 0), b2, voffB);
            PG8_BAR; PG8_WAIT_L(0); PG8_MMA(0, 1, At, B1); PG8_BAR;
            PG8_LDA(At, 0, 1); PG8_STAGE(PG8_SA(0, 0), a2, voffA);
            PG8_BAR; PG8_WAIT_L(0); PG8_MMA(1, 0, At, B0); PG8_BAR; PG8_SCHED;
            PG8_STAGE(PG8_SB(0, 1), b2 + hstep, voffB);
            PG8_WAIT_V(6); PG8_BAR; PG8_MMA(1, 1, At, B1); PG8_BAR;
            PG8_LDB(B0, 1, 0); PG8_SCHED; PG8_LDA(At, 1, 0); PG8_STAGE(PG8_SA(0, 1), a2 + hstep, voffA);
            PG8_WAIT_L(8); PG8_BAR; PG8_WAIT_L(0); PG8_MMA(0, 0, At, B0); PG8_BAR; PG8_SCHED;
            PG8_LDB(B1, 1, 1); PG8_STAGE(PG8_SB(1, 0), b3, voffB);
            PG8_BAR; PG8_WAIT_L(0); PG8_MMA(0, 1, At, B1); PG8_BAR;
            PG8_LDA(At, 1, 1); PG8_STAGE(PG8_SA(1, 0), a3, voffA);
            PG8_BAR; PG8_WAIT_L(0); PG8_MMA(1, 0, At, B0); PG8_BAR; PG8_SCHED;
            PG8_STAGE(PG8_SB(1, 1), b3 + hstep, voffB);
            PG8_WAIT_V(6); PG8_BAR; PG8_MMA(1, 1, At, B1); PG8_BAR;
        }
        E(acc, cur, wr, wc, fr, fq);
        if (!has_next) break;
#pragma unroll
        for (int a = 0; a < 2; ++a)
#pragma unroll
            for (int b = 0; b < 2; ++b)
#pragma unroll
                for (int m = 0; m < 4; ++m)
#pragma unroll
                    for (int n = 0; n < 2; ++n) acc[a][b][m][n] = (f32x4){0.f, 0.f, 0.f, 0.f};
        cur = nxt; cA = nA; cB = nB; ++ui;
    }
    PG8_WAIT_V(0);
    if (wr == 0) PG8_BAR;
    PG8_BAR;
#undef PG8_SA
#undef PG8_SB
#undef PG8_STAGE
#undef PG8_LDA
#undef PG8_LDB
#undef PG8_MMA
#undef PG8_WAIT_V
#undef PG8_WAIT_L
#undef PG8_BAR
#undef PG8_SCHED
}
}

struct EpiFfnIn {
    static constexpr bool PERM = true;
    bf16_t* H; const float* ssq; int g;
    __device__ __forceinline__ void operator()(const f32x4 (&acc)[2][2][4][2], const pg8::Unit& u, int wr, int wc, int fr_in, int fq) const {
        int fr = fr_in; asm volatile("" : "+v"(fr));
        const int R0 = grow_tile(g, u.pm);
        const int col0 = u.pn * 128 + wc * 32 + 8 * fq;
#pragma unroll
        for (int ai = 0; ai < 2; ++ai)
#pragma unroll
            for (int m = 0; m < 4; ++m) {
                const int rt = ai * 128 + wr * 64 + m * 16 + fr;
                const float rs = row_rstd(ssq, R0 + rt, fq);
                float hv[8];
#pragma unroll
                for (int n = 0; n < 2; ++n)
#pragma unroll
                    for (int j = 0; j < 4; ++j) { const float a = acc[ai][0][m][n][j] * rs, b = acc[ai][1][m][n][j] * rs; hv[n * 4 + j] = a * sigmoid_f(a) * b; }
                u32x4 w; w.x = pk2(hv[0], hv[1]); w.y = pk2(hv[2], hv[3]); w.z = pk2(hv[4], hv[5]); w.w = pk2(hv[6], hv[7]);
                *(u32x4*)(H + (size_t)(u.pm * 256 + rt) * DFF + col0) = w;
            }
    }
};
struct EpiNull { static constexpr bool PERM = true; float* sink; __device__ __forceinline__ void operator()(const f32x4 (&acc)[2][2][4][2], const pg8::Unit& u, int wr, int wc, int fr, int fq) const { if (acc[0][0][0][0][0] == 123.456f) sink[0] = 1.f; } };
struct EpiRes {
    static constexpr bool PERM = true;
    bf16_t* XB; float* ssq; float scale; int g;
    __device__ __forceinline__ void operator()(const f32x4 (&acc)[2][2][4][2], const pg8::Unit& u, int wr, int wc, int fr_in, int fq) const {
        int fr = fr_in; asm volatile("" : "+v"(fr));
        const int R0 = grow_tile(g, u.pm);
#pragma unroll
        for (int am = 0; am < 4; ++am) {
            const int ai = am >> 1;
            u32x4 old[2][2];
#pragma unroll
            for (int mm = 0; mm < 2; ++mm)
#pragma unroll
                for (int bj = 0; bj < 2; ++bj)
                    old[mm][bj] = *(const u32x4*)(XB + (size_t)(u.pm * 256 + ai * 128 + wr * 64 + ((am & 1) * 2 + mm) * 16 + fr) * DM + u.pn * 256 + bj * 128 + wc * 32 + 8 * fq);
#pragma unroll
            for (int mm = 0; mm < 2; ++mm) {
                const int m = (am & 1) * 2 + mm;
                const int rt = ai * 128 + wr * 64 + m * 16 + fr;
                bf16_t* xb = XB + (size_t)(u.pm * 256 + rt) * DM;
                float part = 0.f;
#pragma unroll
                for (int bj = 0; bj < 2; ++bj) {
                    const int c0 = u.pn * 256 + bj * 128 + wc * 32 + 8 * fq;
                    const u32x4 o = old[mm][bj];
                    const f32x4 a0 = acc[ai][bj][m][0], a1 = acc[ai][bj][m][1];
                    float n[8];
                    n[0] = bflo(o.x) + a0[0] * scale; n[1] = bfhi(o.x) + a0[1] * scale; n[2] = bflo(o.y) + a0[2] * scale; n[3] = bfhi(o.y) + a0[3] * scale;
                    n[4] = bflo(o.z) + a1[0] * scale; n[5] = bfhi(o.z) + a1[1] * scale; n[6] = bflo(o.w) + a1[2] * scale; n[7] = bfhi(o.w) + a1[3] * scale;
                    u32x4 w; w.x = pk2(n[0], n[1]); w.y = pk2(n[2], n[3]); w.z = pk2(n[4], n[5]); w.w = pk2(n[6], n[7]);
                    *(u32x4*)(xb + c0) = w;
                    part += (n[0] * n[0] + n[1] * n[1]) + (n[2] * n[2] + n[3] * n[3]) + (n[4] * n[4] + n[5] * n[5]) + (n[6] * n[6] + n[7] * n[7]);
                }
                part += __shfl_xor(part, 16); part += __shfl_xor(part, 32);
                if (fq == 0) ssq[(size_t)(R0 + rt) * 16 + u.pn * 4 + wc] = part;
            }
            asm volatile("" ::: "memory");
        }
    }
};
struct EpiWin {
    static constexpr bool PERM = true;
    bf16_t* P; const float* ssq; const float* lbA; const float* lbB; const float* bg; int g;
    __device__ __forceinline__ void operator()(const f32x4 (&acc)[2][2][4][2], const pg8::Unit& u, int wr, int wc, int fr_in, int fq) const {
        int fr = fr_in; asm volatile("" : "+v"(fr));
        const int R0 = grow_tile(g, u.pm);
        const int pn = u.pn;
        const int mode = (pn >= 2 && pn <= 5) ? 1 : (pn == 8 || pn == 9) ? 2 : (pn == 14 || pn == 15) ? 4 : (pn >= 16) ? 5 : 0;
#pragma unroll
        for (int bj = 0; bj < 2; ++bj) {
            const int cin = bj * 128 + wc * 32 + 8 * fq;
            float ca[8], cb[8];
            if (mode == 1) { const int lc = 256 * (pn - 2) + cin;
#pragma unroll
                for (int j = 0; j < 8; ++j) { ca[j] = lbA[lc + j]; cb[j] = lbB[lc + j]; } }
            else if (mode == 4) { const int lc = 256 * (pn - 14) + cin;
#pragma unroll
                for (int j = 0; j < 8; ++j) { ca[j] = bg[lc + j]; cb[j] = 0.f; } }
            else {
#pragma unroll
                for (int j = 0; j < 8; ++j) { ca[j] = 0.f; cb[j] = 0.f; } }
#pragma unroll
            for (int ai = 0; ai < 2; ++ai)
#pragma unroll
                for (int m = 0; m < 4; ++m) {
                    const int rt = ai * 128 + wr * 64 + m * 16 + fr;
                    const float rs = row_rstd(ssq, R0 + rt, fq);
                    float v[8];
#pragma unroll
                    for (int n = 0; n < 2; ++n)
#pragma unroll
                        for (int j = 0; j < 4; ++j) v[n * 4 + j] = acc[ai][bj][m][n][j] * rs;
                    if (mode == 1) {
#pragma unroll
                        for (int j = 0; j < 8; ++j) v[j] = __logf(ca[j] + cb[j] * sigmoid_f(v[j]));
                    } else if (mode == 2) {
#pragma unroll
                        for (int j = 0; j < 8; ++j) v[j] = sigmoid_f(v[j]);
                    } else if (mode == 4) {
#pragma unroll
                        for (int j = 0; j < 8; ++j) v[j] = logsig_f(v[j] + ca[j]) * (1.f / 16.f);
                    } else if (mode == 5) {
#pragma unroll
                        for (int j = 0; j < 8; ++j) v[j] = v[j] * sigmoid_f(v[j]);
                    }
                    u32x4 w; w.x = pk2(v[0], v[1]); w.y = pk2(v[2], v[3]); w.z = pk2(v[4], v[5]); w.w = pk2(v[6], v[7]);
                    *(u32x4*)(P + (size_t)(u.pm * 256 + rt) * NP_ + pn * 256 + cin) = w;
                }
        }
    }
};

struct Args {
    const float* xp; const float* xs; const float* lower_bounds; const float* n1; const float* w1i; const float* w1o; const float* nm; const float* wi;
    const float* wg; const float* bg; const float* hgn; const float* glan; const float* wo; const float* n2; const float* w2i; const float* w2o; const float* nf;
    float* out; unsigned char* ws;
};

__device__ __forceinline__ void p0_convert(const Args& A) {
    const long nth = (long)gridDim.x * NTHREADS, gt = (long)blockIdx.x * NTHREADS + threadIdx.x;
    unsigned char* ws = A.ws;
    const long cnt[6] = {(long)NFF * 128, (long)DM * 352, (long)NP_ * 128, (long)DM * 128, (long)NFF * 128, (long)DM * 352};
    const long per_layer = cnt[0] + cnt[1] + cnt[2] + cnt[3] + cnt[4] + cnt[5];
    for (long it = gt; it < 2 * per_layer; it += nth) {
        const int l = it >= per_layer ? 1 : 0; long i = it - (long)l * per_layer;
        int job = 0;
#pragma unroll
        for (int j = 0; j < 5; ++j) if (job == j && i >= cnt[j]) { i -= cnt[j]; job = j + 1; }
        unsigned char* wl = ws + OFF_W + (size_t)l * SZ_LAYER;
        float v[8];
        bf16_t* dst;
        if (job == 0 || job == 4) {
            const int np = (int)(i % NFF), k0 = (int)(i / NFF) * 8;
            const float* W = (job == 0 ? A.w1i : A.w2i) + (size_t)l * DM * NFF; const float* gn = (job == 0 ? A.n1 : A.n2) + l * DM;
            const int n = ((np & 128) ? DFF : 0) + (np >> 8) * 128 + (np & 127);
#pragma unroll
            for (int e = 0; e < 8; ++e) v[e] = W[(size_t)(k0 + e) * NFF + n] * gn[k0 + e];
            dst = (bf16_t*)(wl + (job == 0 ? 0 : SZ_W1I + SZ_W1O + SZ_WIN + SZ_WO)) + (size_t)np * DM + k0;
        } else if (job == 1 || job == 5) {
            const int np = (int)(i % DM), k0 = (int)(i / DM) * 8;
            const float* W = (job == 1 ? A.w1o : A.w2o) + (size_t)l * DFF * DM;
#pragma unroll
            for (int e = 0; e < 8; ++e) v[e] = W[(size_t)(k0 + e) * DM + np];
            dst = (bf16_t*)(wl + (job == 1 ? SZ_W1I : 2 * SZ_W1I + SZ_W1O + SZ_WIN + SZ_WO)) + (size_t)np * DFF + k0;
        } else if (job == 3) {
            const int np = (int)(i % DM), k0 = (int)(i / DM) * 8;
            const float* W = A.wo + (size_t)l * DM * DM;
#pragma unroll
            for (int e = 0; e < 8; ++e) v[e] = W[(size_t)(k0 + e) * DM + np];
            dst = (bf16_t*)(wl + SZ_W1I + SZ_W1O + SZ_WIN) + (size_t)np * DM + k0;
        } else {
            const int np = (int)(i % NP_), k0 = (int)(i / NP_) * 8;
            const float* W = A.wi + (size_t)l * DM * DINSRC; const float* gn = A.nm + l * DM;
            if (np >= 3584 && np < 4096) {
                const int d = np >= 3840 ? 1 : 0, c = np - 3584 - 256 * d;
                const float* G = A.wg + ((size_t)l * 2 + d) * 16 * 256;
                float gc[16];
#pragma unroll
                for (int r = 0; r < 16; ++r) gc[r] = G[r * 256 + c];
#pragma unroll
                for (int e = 0; e < 8; ++e) { const float* wr_ = W + (size_t)(k0 + e) * DINSRC + 3584 + 16 * d; float s = 0.f;
#pragma unroll
                    for (int r = 0; r < 16; ++r) s += wr_[r] * gc[r];
                    v[e] = s * gn[k0 + e]; }
            } else {
                const int n = np < 3584 ? np : 3616 + (np - 4096);
                const float sc = (np >= 2560 && np < 2816) ? 0.125f : 1.f;
#pragma unroll
                for (int e = 0; e < 8; ++e) v[e] = W[(size_t)(k0 + e) * DINSRC + n] * gn[k0 + e] * sc;
            }
            dst = (bf16_t*)(wl + SZ_W1I + SZ_W1O) + (size_t)np * DM + k0;
        }
        u32x4 w; w.x = pk2(v[0], v[1]); w.y = pk2(v[2], v[3]); w.z = pk2(v[4], v[5]); w.w = pk2(v[6], v[7]);
        *(u32x4*)dst = w;
    }
    float* lbt = (float*)(ws + OFF_LBT);
    for (long i = gt; i < 2048; i += nth) {
        const int l = (int)(i >> 10), c = (int)(i & 1023);
        const float a = A.lower_bounds[c], b = A.lower_bounds[1024 + c], mx = fmaxf(a, b);
        const float ea = __expf(a - mx), eb = __expf(b - mx);
        const float lb = l == 0 ? 0.f : eb / (ea + eb);
        lbt[l * 2048 + c] = fmaxf(lb, 1e-30f);
        lbt[l * 2048 + 1024 + c] = 1.f - lb;
    }
}

__device__ __forceinline__ void g0_prologue(const float* xp, const float* xs, unsigned char* ws, int g) {
    int tid_ = threadIdx.x; asm volatile("" : "+v"(tid_));
    const int lane = tid_ & 63, wv = blockIdx.x * 8 + (tid_ >> 6), nwv = gridDim.x * 8;
    bf16_t* XB = (bf16_t*)(ws + OFF_XB); float* ssq = (float*)(ws + OFF_SSQ);
    for (int r = wv; r < MG; r += nwv) {
        const int R = grow(g, r);
        const float* x = R < 32768 ? xp + (size_t)R * DM : xs + (size_t)(R - 32768) * DM;
        float s = 0.f;
#pragma unroll
        for (int i = 0; i < 4; ++i) { const f32x4 v = *(const f32x4*)(x + i * 256 + lane * 4);
            s += (v[0] * v[0] + v[1] * v[1]) + (v[2] * v[2] + v[3] * v[3]);
            u32x2 w; w.x = pk2(v[0], v[1]); w.y = pk2(v[2], v[3]); *(u32x2*)(XB + (size_t)r * DM + i * 256 + lane * 4) = w; }
#pragma unroll
        for (int o = 32; o >= 1; o >>= 1) s += __shfl_xor(s, o);
        if (lane < 4) *(f32x4*)(ssq + (size_t)R * 16 + 4 * lane) = (f32x4){lane == 0 ? s : 0.f, 0.f, 0.f, 0.f};
    }
}
__device__ __forceinline__ void final_norm(float* outp, const float* nf, unsigned char* ws, int g) {
    int tid_ = threadIdx.x; asm volatile("" : "+v"(tid_));
    const int lane = tid_ & 63, wv = blockIdx.x * 8 + (tid_ >> 6), nwv = gridDim.x * 8;
    const float* ssq = (const float*)(ws + OFF_SSQ) + 6 * SSQ_SITE; const bf16_t* XB = (const bf16_t*)(ws + OFF_XB);
    for (int r = wv; r < MG; r += nwv) {
        const int R = grow(g, r);
        float* x = outp + (size_t)R * DM;
        const f32x4 q0 = *(const f32x4*)(ssq + (size_t)R * 16), q1 = *(const f32x4*)(ssq + (size_t)R * 16 + 4), q2 = *(const f32x4*)(ssq + (size_t)R * 16 + 8), q3 = *(const f32x4*)(ssq + (size_t)R * 16 + 12);
        const float rs = rsqrtf((((q0[0] + q0[1]) + (q0[2] + q0[3])) + ((q1[0] + q1[1]) + (q1[2] + q1[3])) + (((q2[0] + q2[1]) + (q2[2] + q2[3])) + ((q3[0] + q3[1]) + (q3[2] + q3[3])))) * (1.f / 1024.f) + EPS);
#pragma unroll
        for (int i = 0; i < 4; ++i) { const int c = i * 256 + lane * 4; const u32x2 xv = *(const u32x2*)(XB + (size_t)r * DM + c); const f32x4 gn = *(const f32x4*)(nf + c);
            f32x4 v = {bflo(xv.x) * rs * gn[0], bfhi(xv.x) * rs * gn[1], bflo(xv.y) * rs * gn[2], bfhi(xv.y) * rs * gn[3]}; *(f32x4*)(x + c) = v; }
    }
}

#define MFMA32(a, b, c) __builtin_amdgcn_mfma_f32_32x32x16_bf16((a), (b), (c), 0, 0, 0)
constexpr int SC_QT = 0, SC_KT = 34816, SC_VT = 69632, SC_ST = 104448, SC_TOT = 139264, SC_VEC = 143360, SC_RED = 144896, SC_END = 145920;
constexpr int TSTR = 272;

template <int DK>
__device__ __forceinline__ void scan_half(LAS unsigned char* L, const bf16_t* __restrict__ P, float* RAW, bf16_t* OBF, const float* __restrict__ gain,
                                          int seqbase, int T, int dir, int qcol, int kcol, int gcol, int vcol, int gatecol, int ocol,
                                          int j0, int j1, bool second, f32x16& S0, f32x16& S1) {
    constexpr bool GLA = (DK == 64);
    constexpr int NPAIR = DK / 2, NSEG = NTHREADS / NPAIR, SL = 128 / NSEG, QSTR = (DK + 8) * 2, NKS = DK / 16;
    int tid_ = threadIdx.x; asm volatile("" : "+v"(tid_));
    const int tid = tid_, lane = tid & 63, w = __builtin_amdgcn_readfirstlane(tid >> 6);
    const int r = lane & 31, h = lane >> 5;
    const int cp = tid % NPAIR, seg = tid / NPAIR, vp = tid & 63, vseg = tid >> 6;
    const int tb = w >> 1, dh = w & 1, dvb_s = w & 3, kq = w >> 2;
    unsigned g2[SL], q2[SL], k2[SL], v2[16];

#define ROWOF(j, i) (seqbase + (dir ? (T - 1 - ((j) * 128 + (i))) : ((j) * 128 + (i))))
#define LOAD_CHUNK(j) do { \
        _Pragma("unroll") for (int i_ = 0; i_ < SL; ++i_) { const unsigned* pr_ = (const unsigned*)(P + (size_t)ROWOF(j, seg * SL + i_) * NP_); \
            g2[i_] = pr_[(gcol >> 1) + cp]; q2[i_] = pr_[(qcol >> 1) + cp]; if (GLA) k2[i_] = pr_[(kcol >> 1) + cp]; else k2[i_] = 0u; } \
        _Pragma("unroll") for (int i_ = 0; i_ < 16; ++i_) { const unsigned* pr_ = (const unsigned*)(P + (size_t)ROWOF(j, vseg * 16 + i_) * NP_); v2[i_] = pr_[(vcol >> 1) + vp]; } \
    } while (0)

    LOAD_CHUNK(j0);
    for (int j = j0; j < j1; ++j) {
        float c0[SL], c1[SL];
        { float s0 = 0.f, s1 = 0.f;
#pragma unroll
          for (int i = 0; i < SL; ++i) { s0 += bflo(g2[i]); s1 += bfhi(g2[i]); c0[i] = s0; c1[i] = s1; }
          *(LAS f32x2*)(L + SC_TOT + (seg * DK + 2 * cp) * 4) = (f32x2){s0, s1}; }
        __syncthreads();
        float off0 = 0.f, off1 = 0.f, m0 = 0.f, m1 = 0.f, bl0 = 0.f, bl1 = 0.f;
#pragma unroll
        for (int s = 0; s < NSEG; ++s) { const f32x2 t = *(const LAS f32x2*)(L + SC_TOT + (s * DK + 2 * cp) * 4);
            if (s < seg) { off0 += t.x; off1 += t.y; }
            if (s < NSEG / 2) { m0 += t.x; m1 += t.y; }
            bl0 += t.x; bl1 += t.y; }
        unsigned kk[SL];
#pragma unroll
        for (int i = 0; i < SL; ++i) {
            const float e0 = fminf(fmaxf(off0 + c0[i] - m0, -80.f), 80.f), e1 = fminf(fmaxf(off1 + c1[i] - m1, -80.f), 80.f);
            const float x0 = __expf(e0), x1 = __expf(e1), y0 = __expf(-e0), y1 = __expf(-e1);
            float ka, kb;
            if (GLA) { ka = bflo(k2[i]); kb = bfhi(k2[i]); } else { ka = 1.f - __expf(bflo(g2[i])); kb = 1.f - __expf(bfhi(g2[i])); }
            const unsigned qq = pk2(bflo(q2[i]) * x0, bfhi(q2[i]) * x1);
            kk[i] = pk2(ka * y0, kb * y1);
            *(LAS unsigned*)(L + SC_QT + (seg * SL + i) * QSTR + 4 * cp) = qq;
            *(LAS unsigned*)(L + SC_KT + (seg * SL + i) * QSTR + 4 * cp) = kk[i];
        }
        {
            u32x4 a0, a1, b0, b1;
            a0.x = (v2[0] & 0xffffu) | (v2[1] << 16); a0.y = (v2[2] & 0xffffu) | (v2[3] << 16); a0.z = (v2[4] & 0xffffu) | (v2[5] << 16); a0.w = (v2[6] & 0xffffu) | (v2[7] << 16);
            a1.x = (v2[8] & 0xffffu) | (v2[9] << 16); a1.y = (v2[10] & 0xffffu) | (v2[11] << 16); a1.z = (v2[12] & 0xffffu) | (v2[13] << 16); a1.w = (v2[14] & 0xffffu) | (v2[15] << 16);
            b0.x = (v2[0] >> 16) | (v2[1] & 0xffff0000u); b0.y = (v2[2] >> 16) | (v2[3] & 0xffff0000u); b0.z = (v2[4] >> 16) | (v2[5] & 0xffff0000u); b0.w = (v2[6] >> 16) | (v2[7] & 0xffff0000u);
            b1.x = (v2[8] >> 16) | (v2[9] & 0xffff0000u); b1.y = (v2[10] >> 16) | (v2[11] & 0xffff0000u); b1.z = (v2[12] >> 16) | (v2[13] & 0xffff0000u); b1.w = (v2[14] >> 16) | (v2[15] & 0xffff0000u);
            LAS unsigned char* pv = L + SC_VT + (2 * vp) * TSTR + vseg * 32;
            *(LAS u32x4*)(pv) = a0; *(LAS u32x4*)(pv + 16) = a1; *(LAS u32x4*)(pv + TSTR) = b0; *(LAS u32x4*)(pv + TSTR + 16) = b1;
        }
        if (seg == 0) {
            *(LAS f32x2*)(L + SC_VEC + (2 * cp) * 4) = (f32x2){__expf(m0), __expf(m1)};
            *(LAS f32x2*)(L + SC_VEC + 512 + (2 * cp) * 4) = (f32x2){__expf(bl0), __expf(bl1)};
            *(LAS f32x2*)(L + SC_VEC + 1024 + (2 * cp) * 4) = (f32x2){__expf(bl0 - m0), __expf(bl1 - m1)};
        }
        if (j + 1 < j1) LOAD_CHUNK(j + 1);
        __syncthreads();
#pragma unroll
        for (int ti = 0; ti < (GLA ? 1 : 2); ++ti) {
            const int kb_ = GLA ? kq : 2 * kq + ti;
            const f32x16& Sx = ti == 0 ? S0 : S1;
#pragma unroll
            for (int gq = 0; gq < 4; ++gq) {
                const int k = 32 * kb_ + 8 * gq + 4 * h;
                const f32x4 em = *(const LAS f32x4*)(L + SC_VEC + k * 4);
                u32x2 wv; wv.x = pk2(Sx[4 * gq] * em[0], Sx[4 * gq + 1] * em[1]); wv.y = pk2(Sx[4 * gq + 2] * em[2], Sx[4 * gq + 3] * em[3]);
                *(LAS u32x2*)(L + SC_ST + (32 * dvb_s + r) * QSTR + k * 2) = wv;
            }
        }
        bf16x8 qf[NKS];
#pragma unroll
        for (int ks = 0; ks < NKS; ++ks) qf[ks] = *(const LAS bf16x8*)(L + SC_QT + (32 * tb + r) * QSTR + (16 * ks + 8 * h) * 2);
        bf16x8 ps[4][2];
#pragma unroll
        for (int sb = 0; sb < 4; ++sb) {
            if (sb <= tb) {
                f32x16 x;
#pragma unroll
                for (int i = 0; i < 16; ++i) x[i] = 0.f;
#pragma unroll
                for (int ks = 0; ks < NKS; ++ks) { const bf16x8 a = *(const LAS bf16x8*)(L + SC_KT + (32 * sb + r) * QSTR + (16 * ks + 8 * h) * 2); x = MFMA32(a, qf[ks], x); }
                if (sb == tb) {
#pragma unroll
                    for (int i = 0; i < 16; ++i) { const int cr = (i & 3) + 8 * (i >> 2) + 4 * h; x[i] = cr <= r ? x[i] : 0.f; }
                }
#pragma unroll
                for (int ss = 0; ss < 2; ++ss) { u32x4 pw; pw.x = pk2(x[8 * ss], x[8 * ss + 1]); pw.y = pk2(x[8 * ss + 2], x[8 * ss + 3]); pw.z = pk2(x[8 * ss + 4], x[8 * ss + 5]); pw.w = pk2(x[8 * ss + 6], x[8 * ss + 7]);
                    ps[sb][ss] = __builtin_bit_cast(bf16x8, pw); }
            } else { ps[sb][0] = (bf16x8){0, 0, 0, 0, 0, 0, 0, 0}; ps[sb][1] = (bf16x8){0, 0, 0, 0, 0, 0, 0, 0}; }
        }
        __syncthreads();
        {
            LAS unsigned char* pk_ = L + SC_KT + (2 * cp) * TSTR + seg * SL * 2;
            if (SL == 16) {
                u32x4 a0, a1, b0, b1;
                a0.x = (kk[0] & 0xffffu) | (kk[1] << 16); a0.y = (kk[2] & 0xffffu) | (kk[3] << 16); a0.z = (kk[4] & 0xffffu) | (kk[5] << 16); a0.w = (kk[6] & 0xffffu) | (kk[7] << 16);
                a1.x = (kk[8 % SL] & 0xffffu) | (kk[9 % SL] << 16); a1.y = (kk[10 % SL] & 0xffffu) | (kk[11 % SL] << 16); a1.z = (kk[12 % SL] & 0xffffu) | (kk[13 % SL] << 16); a1.w = (kk[14 % SL] & 0xffffu) | (kk[15 % SL] << 16);
                b0.x = (kk[0] >> 16) | (kk[1] & 0xffff0000u); b0.y = (kk[2] >> 16) | (kk[3] & 0xffff0000u); b0.z = (kk[4] >> 16) | (kk[5] & 0xffff0000u); b0.w = (kk[6] >> 16) | (kk[7] & 0xffff0000u);
                b1.x = (kk[8 % SL] >> 16) | (kk[9 % SL] & 0xffff0000u); b1.y = (kk[10 % SL] >> 16) | (kk[11 % SL] & 0xffff0000u); b1.z = (kk[12 % SL] >> 16) | (kk[13 % SL] & 0xffff0000u); b1.w = (kk[14 % SL] >> 16) | (kk[15 % SL] & 0xffff0000u);
                *(LAS u32x4*)(pk_) = a0; *(LAS u32x4*)(pk_ + 16) = a1; *(LAS u32x4*)(pk_ + TSTR) = b0; *(LAS u32x4*)(pk_ + TSTR + 16) = b1;
            } else {
                u32x4 a0, b0;
                a0.x = (kk[0] & 0xffffu) | (kk[1] << 16); a0.y = (kk[2] & 0xffffu) | (kk[3] << 16); a0.z = (kk[4] & 0xffffu) | (kk[5] << 16); a0.w = (kk[6] & 0xffffu) | (kk[7] << 16);
                b0.x = (kk[0] >> 16) | (kk[1] & 0xffff0000u); b0.y = (kk[2] >> 16) | (kk[3] & 0xffff0000u); b0.z = (kk[4] >> 16) | (kk[5] & 0xffff0000u); b0.w = (kk[6] >> 16) | (kk[7] & 0xffff0000u);
                *(LAS u32x4*)(pk_) = a0; *(LAS u32x4*)(pk_ + TSTR) = b0;
            }
        }
        f32x16 O[2];
#pragma unroll
        for (int dvi = 0; dvi < 2; ++dvi) {
            const int dvb = 2 * dh + dvi;
            f32x16 o;
#pragma unroll
            for (int i = 0; i < 16; ++i) o[i] = 0.f;
#pragma unroll
            for (int ks = 0; ks < NKS; ++ks) { const bf16x8 a = *(const LAS bf16x8*)(L + SC_ST + (32 * dvb + r) * QSTR + (16 * ks + 8 * h) * 2); o = MFMA32(a, qf[ks], o); }
#pragma unroll
            for (int sb = 0; sb < 4; ++sb) {
                if (sb <= tb) {
#pragma unroll
                    for (int ss = 0; ss < 2; ++ss) {
                        const LAS unsigned char* pa = L + SC_VT + (32 * dvb + r) * TSTR + (32 * sb + 16 * ss + 4 * h) * 2;
                        const s16x4 lo = *(const LAS s16x4*)(pa), hi = *(const LAS s16x4*)(pa + 16);
                        const bf16x8 a = __builtin_shufflevector(lo, hi, 0, 1, 2, 3, 4, 5, 6, 7);
                        o = MFMA32(a, ps[sb][ss], o);
                    }
                }
            }
            O[dvi] = o;
        }
        const int orow = ROWOF(j, 32 * tb + r);
        if (!second) {
#pragma unroll
            for (int dvi = 0; dvi < 2; ++dvi)
#pragma unroll
                for (int gq = 0; gq < 4; ++gq) {
                    const int dv = 32 * (2 * dh + dvi) + 8 * gq + 4 * h;
                    *(f32x4*)(RAW + (size_t)orow * DM + ocol + dv) = (f32x4){O[dvi][4 * gq], O[dvi][4 * gq + 1], O[dvi][4 * gq + 2], O[dvi][4 * gq + 3]};
                }
        } else {
            float ssum = 0.f;
#pragma unroll
            for (int dvi = 0; dvi < 2; ++dvi)
#pragma unroll
                for (int gq = 0; gq < 4; ++gq) {
                    const int dv = 32 * (2 * dh + dvi) + 8 * gq + 4 * h;
                    const f32x4 pr = *(const f32x4*)(RAW + (size_t)orow * DM + ocol + dv);
#pragma unroll
                    for (int e = 0; e < 4; ++e) { const float t = O[dvi][4 * gq + e] + pr[e]; O[dvi][4 * gq + e] = t; ssum += t * t; }
                }
            ssum += __shfl_xor(ssum, 32);
            if (h == 0) *(LAS float*)(L + SC_RED + (w * 32 + r) * 4) = ssum;
        }
        __syncthreads();
        if (second) {
            const float tot = *(const LAS float*)(L + SC_RED + (w * 32 + r) * 4) + *(const LAS float*)(L + SC_RED + ((w ^ 1) * 32 + r) * 4);
            const float rs = rsqrtf(tot * (1.f / 128.f) + EPS);
#pragma unroll
            for (int dvi = 0; dvi < 2; ++dvi)
#pragma unroll
                for (int gq = 0; gq < 4; ++gq) {
                    const int dv = 32 * (2 * dh + dvi) + 8 * gq + 4 * h;
                    const f32x4 gn = *(const f32x4*)(gain + dv);
                    const u32x2 gt = *(const u32x2*)(P + (size_t)orow * NP_ + gatecol + dv);
                    u32x2 wv; wv.x = pk2(O[dvi][4 * gq] * rs * gn[0] * bflo(gt.x), O[dvi][4 * gq + 1] * rs * gn[1] * bfhi(gt.x));
                    wv.y = pk2(O[dvi][4 * gq + 2] * rs * gn[2] * bflo(gt.y), O[dvi][4 * gq + 3] * rs * gn[3] * bfhi(gt.y));
                    *(u32x2*)(OBF + (size_t)orow * DM + ocol + dv) = wv;
                }
        }
#pragma unroll
        for (int ti = 0; ti < (GLA ? 1 : 2); ++ti) {
            const int kb_ = GLA ? kq : 2 * kq + ti;
            f32x16 pkv;
#pragma unroll
            for (int i = 0; i < 16; ++i) pkv[i] = 0.f;
#pragma unroll
            for (int ks = 0; ks < 8; ++ks) {
                const bf16x8 a = *(const LAS bf16x8*)(L + SC_KT + (32 * kb_ + r) * TSTR + (16 * ks + 8 * h) * 2);
                const bf16x8 b = *(const LAS bf16x8*)(L + SC_VT + (32 * dvb_s + r) * TSTR + (16 * ks + 8 * h) * 2);
                pkv = MFMA32(a, b, pkv);
            }
            f32x16& Sx = ti == 0 ? S0 : S1;
#pragma unroll
            for (int gq = 0; gq < 4; ++gq) {
                const int k = 32 * kb_ + 8 * gq + 4 * h;
                const f32x4 eb = *(const LAS f32x4*)(L + SC_VEC + 512 + k * 4), ebm = *(const LAS f32x4*)(L + SC_VEC + 1024 + k * 4);
#pragma unroll
                for (int e = 0; e < 4; ++e) Sx[4 * gq + e] = eb[e] * Sx[4 * gq + e] + ebm[e] * pkv[4 * gq + e];
            }
        }
    }
    __syncthreads();
#undef ROWOF
#undef LOAD_CHUNK
}


template <class T> __device__ __forceinline__ T* opaque_ptr(T* p) { __attribute__((address_space(1))) T* gp = (__attribute__((address_space(1))) T*)p; asm volatile("" : "+s"(gp)); return (T*)gp; }
__device__ __forceinline__ unsigned opaque_zero() { unsigned z; asm volatile("s_mov_b32 %0, 0" : "=s"(z)); return z; }
__device__ __forceinline__ void gbar(unsigned* ctr, unsigned target) {
    asm volatile("s_waitcnt vmcnt(0)" ::: "memory");
    __syncthreads();
    if (threadIdx.x == 0) {
        __builtin_amdgcn_fence(__ATOMIC_RELEASE, "agent");
        asm volatile("s_waitcnt vmcnt(0)" ::: "memory");
        __hip_atomic_fetch_add(ctr, 1u, __ATOMIC_RELAXED, __HIP_MEMORY_SCOPE_AGENT);
        while (__hip_atomic_load(ctr, __ATOMIC_RELAXED, __HIP_MEMORY_SCOPE_AGENT) < target) __builtin_amdgcn_s_sleep(2);
        __builtin_amdgcn_fence(__ATOMIC_ACQUIRE, "agent");
        asm volatile("s_waitcnt vmcnt(0)" ::: "memory");
    }
    __syncthreads();
}

__global__ void __launch_bounds__(NTHREADS) hymba_fwd(Args A) {
    extern __shared__ __attribute__((aligned(16))) unsigned char lds_raw[];
    cg::grid_group grid = cg::this_grid();
    unsigned nbar = 0;
#define PH_BEGIN() const unsigned zs = opaque_zero(); LAS unsigned char* L = (LAS unsigned char*)lds_raw + zs; unsigned char* ws = opaque_ptr(A.ws); const int G = (int)(gridDim.x + zs), bid = (int)(blockIdx.x + zs); const float* xp = opaque_ptr(A.xp); const float* xs = opaque_ptr(A.xs); float* outp = opaque_ptr(A.out); (void)L; (void)ws; (void)G; (void)bid; (void)xp; (void)xs; (void)outp
#define GBAR() do { for (int rb_ = 0; rb_ < PROBE_BAR; ++rb_) { nbar += 256u; gbar((unsigned*)(A.ws + OFF_BAR + opaque_zero()), nbar); } } while (0)

    for (int rep = 0; rep < PROBE_P0; ++rep) { PH_BEGIN(); p0_convert(A); }
    grid.sync();

#pragma unroll 1
    for (int g = 0; g < NGRP; ++g) {
        { PH_BEGIN(); g0_prologue(xp, xs, ws, g); }
        GBAR();
#pragma unroll 1
        for (int l = 0; l < 2; ++l) {
            const size_t wlo = OFF_W + (size_t)l * SZ_LAYER;
            const size_t sq = OFF_SSQ + (size_t)(3 * l) * SSQ_SITE * 4;
            for (int rep = 0; rep < PROBE_FFNIN; ++rep) { PH_BEGIN(); pg8::Gemm gm{(const bf16_t*)(ws + OFF_XB), (const bf16_t*)(ws + wlo), MG, NFF, DM}; pg8::StaticOrder S; S.init(MG, NFF, G, bid);
              EpiFfnIn E{(bf16_t*)(ws + OFF_PH), (const float*)(ws + sq), g}; pg8::gemm_phase(L, gm, S, E); }
            GBAR();
            for (int rep = 0; rep < PROBE_FFNOUT_NULL; ++rep) { PH_BEGIN(); pg8::Gemm gm{(const bf16_t*)(ws + OFF_PH), (const bf16_t*)(ws + wlo + SZ_W1I), MG, DM, DFF}; pg8::StaticOrder S; S.init(MG, DM, G, bid); EpiNull E{(float*)(ws + OFF_RAW)}; pg8::gemm_phase(L, gm, S, E); }
            { PH_BEGIN(); pg8::Gemm gm{(const bf16_t*)(ws + OFF_PH), (const bf16_t*)(ws + wlo + SZ_W1I), MG, DM, DFF}; pg8::StaticOrder S; S.init(MG, DM, G, bid);
              EpiRes E{(bf16_t*)(ws + OFF_XB), (float*)(ws + sq) + SSQ_SITE, 0.5f, g}; pg8::gemm_phase(L, gm, S, E); }
            GBAR();
            for (int rep = 0; rep < PROBE_WIN; ++rep) { PH_BEGIN(); pg8::Gemm gm{(const bf16_t*)(ws + OFF_XB), (const bf16_t*)(ws + wlo + SZ_W1I + SZ_W1O), MG, NP_, DM}; pg8::StaticOrder S; S.init(MG, NP_, G, bid);
              const float* LBT = (const float*)(ws + OFF_LBT) + l * 2048;
              EpiWin E{(bf16_t*)(ws + OFF_PH), (const float*)(ws + sq) + SSQ_SITE, LBT, LBT + 1024, A.bg + l * 512, g}; pg8::gemm_phase(L, gm, S, E); }
            GBAR();
            for (int rep = 0; rep < PROBE_SCAN; ++rep) {
                f32x16 S0, S1;
#pragma unroll
                for (int i = 0; i < 16; ++i) { S0[i] = 0.f; S1[i] = 0.f; }
#pragma unroll 1
                for (int half = 0; half < 2; ++half) {
                    { PH_BEGIN();
                      const bf16_t* PH = (const bf16_t*)(ws + OFF_PH); float* RAW = (float*)(ws + OFF_RAW); bf16_t* OBF = (bf16_t*)(ws + OFF_OBF);
                      const int dir = bid & 1, hh = (bid >> 1) & 7, sidx = (bid >> 4) & 15;
                      const int T = sidx < 8 ? TPROMPT : TSAMPLE, seqbase = sidx < 8 ? sidx * TPROMPT : 16384 + (sidx - 8) * TSAMPLE, N = T / 128;
                      const int j0 = half ? N / 2 : 0, j1 = half ? N : N / 2;
                      if (hh < 4) { const int hd = hh;
                          scan_half<128>(L, PH, RAW, OBF, A.hgn + l * 512 + 128 * hd, seqbase, T, dir, 128 * hd, 0, (dir ? 1024 : 512) + 128 * hd, 1536 + 128 * hd, 2048 + 128 * hd, 128 * hd, j0, j1, half != 0, S0, S1);
                      } else { const int hd = hh - 4;
                          scan_half<64>(L, PH, RAW, OBF, A.glan + l * 512 + 128 * hd, seqbase, T, dir, 2560 + 64 * hd, 2816 + 64 * hd, (dir ? 3840 : 3584) + 64 * hd, 3072 + 128 * hd, 4096 + 128 * hd, 512 + 128 * hd, j0, j1, half != 0, S0, S1);
                      } }
                    GBAR();
                }
            }
            { PH_BEGIN(); pg8::Gemm gm{(const bf16_t*)(ws + OFF_OBF), (const bf16_t*)(ws + wlo + SZ_W1I + SZ_W1O + SZ_WIN), MG, DM, DM}; pg8::StaticOrder S; S.init(MG, DM, G, bid);
              EpiRes E{(bf16_t*)(ws + OFF_XB), (float*)(ws + sq) + 2 * SSQ_SITE, 1.0f, g}; pg8::gemm_phase(L, gm, S, E); }
            GBAR();
            for (int rep = 0; rep < PROBE_FFNIN; ++rep) { PH_BEGIN(); pg8::Gemm gm{(const bf16_t*)(ws + OFF_XB), (const bf16_t*)(ws + wlo + SZ_W1I + SZ_W1O + SZ_WIN + SZ_WO), MG, NFF, DM}; pg8::StaticOrder S; S.init(MG, NFF, G, bid);
              EpiFfnIn E{(bf16_t*)(ws + OFF_PH), (const float*)(ws + sq) + 2 * SSQ_SITE, g}; pg8::gemm_phase(L, gm, S, E); }
            GBAR();
            for (int rep = 0; rep < PROBE_FFNOUT_NULL; ++rep) { PH_BEGIN(); pg8::Gemm gm{(const bf16_t*)(ws + OFF_PH), (const bf16_t*)(ws + wlo + 2 * SZ_W1I + SZ_W1O + SZ_WIN + SZ_WO), MG, DM, DFF}; pg8::StaticOrder S; S.init(MG, DM, G, bid); EpiNull E{(float*)(ws + OFF_RAW)}; pg8::gemm_phase(L, gm, S, E); }
            { PH_BEGIN(); pg8::Gemm gm{(const bf16_t*)(ws + OFF_PH), (const bf16_t*)(ws + wlo + 2 * SZ_W1I + SZ_W1O + SZ_WIN + SZ_WO), MG, DM, DFF}; pg8::StaticOrder S; S.init(MG, DM, G, bid);
              EpiRes E{(bf16_t*)(ws + OFF_XB), (float*)(ws + sq) + 3 * SSQ_SITE, 0.5f, g}; pg8::gemm_phase(L, gm, S, E); }
            GBAR();
        }
        { PH_BEGIN(); final_norm(outp, opaque_ptr(A.nf), ws, g); }
    }
#undef PH_BEGIN
#undef GBAR
}

constexpr int LDS_BYTES = 146432;
extern "C" void kernel_launch(void* const* d_in, const int* in_sizes, int n_in, void* d_out, int out_size, void* d_ws, size_t ws_size, hipStream_t stream) {
    static int ready = 0;
    if (!ready) {
        if (n_in != 17 || out_size != MTOT * DM || ws_size < WS_END) { fprintf(stderr, "kernel_launch: unexpected shapes (n_in %d out %d ws %zu need %zu)\n", n_in, out_size, ws_size, (size_t)WS_END); ready = -1; return; }
        if (hipFuncSetAttribute((const void*)hymba_fwd, hipFuncAttributeMaxDynamicSharedMemorySize, LDS_BYTES) != hipSuccess) { fprintf(stderr, "kernel_launch: hipFuncSetAttribute failed\n"); ready = -1; return; }
        int per_cu = 0; (void)hipOccupancyMaxActiveBlocksPerMultiprocessor(&per_cu, (const void*)hymba_fwd, NTHREADS, LDS_BYTES); (void)hipGetLastError();
        ready = 1;
    }
    if (ready < 0) return;
    if (hipMemsetAsync((char*)d_ws + OFF_BAR, 0, 256, stream) != hipSuccess) { fprintf(stderr, "kernel_launch: memset failed\n"); return; }
    Args a{};
    a.xp = (const float*)d_in[0]; a.xs = (const float*)d_in[1]; a.lower_bounds = (const float*)d_in[2]; a.n1 = (const float*)d_in[3]; a.w1i = (const float*)d_in[4]; a.w1o = (const float*)d_in[5];
    a.nm = (const float*)d_in[6]; a.wi = (const float*)d_in[7]; a.wg = (const float*)d_in[8]; a.bg = (const float*)d_in[9]; a.hgn = (const float*)d_in[10]; a.glan = (const float*)d_in[11];
    a.wo = (const float*)d_in[12]; a.n2 = (const float*)d_in[13]; a.w2i = (const float*)d_in[14]; a.w2o = (const float*)d_in[15]; a.nf = (const float*)d_in[16];
    a.out = (float*)d_out; a.ws = (unsigned char*)d_ws;
    void* args[] = {&a};
    hipError_t e = hipLaunchCooperativeKernel((const void*)hymba_fwd, dim3(256), dim3(NTHREADS), args, LDS_BYTES, stream);
    if (e != hipSuccess) fprintf(stderr, "cooperative launch failed: %s\n", hipGetErrorString(e));
}
```

```cpp
#include <hip/hip_runtime.h>
#include <hip/hip_cooperative_groups.h>
#include <cstdio>
namespace cg = cooperative_groups;

#define LAS __attribute__((address_space(3)))
typedef unsigned short bf16_t;
typedef short bf16x8 __attribute__((ext_vector_type(8)));
typedef short s16x4 __attribute__((ext_vector_type(4)));
typedef float f32x2 __attribute__((ext_vector_type(2)));
typedef float f32x4 __attribute__((ext_vector_type(4)));
typedef float f32x16 __attribute__((ext_vector_type(16)));
typedef unsigned u32x2 __attribute__((ext_vector_type(2)));
typedef unsigned u32x4 __attribute__((ext_vector_type(4)));

constexpr int DM = 1024, DFF = 2816, NFF = 5632, DINSRC = 4128, NP_ = 4608;
constexpr int MTOT = 98304, MG = 49152, NGRP = 2;
constexpr int TPROMPT = 2048, TSAMPLE = 4096;
constexpr float EPS = 1e-6f;
constexpr int NTHREADS = 512;
#ifndef PROBE_SCAN
#define PROBE_SCAN 1
#endif
#ifndef PROBE_FFNIN
#define PROBE_FFNIN 1
#endif
#ifndef PROBE_P0
#define PROBE_P0 1
#endif
#ifndef PROBE_WIN
#define PROBE_WIN 1
#endif
#ifndef PROBE_FFNOUT_NULL
#define PROBE_FFNOUT_NULL 0
#endif
#ifndef PROBE_BAR
#define PROBE_BAR 1
#endif

constexpr size_t SZ_W1I = (size_t)NFF * DM * 2, SZ_W1O = (size_t)DM * DFF * 2, SZ_WIN = (size_t)NP_ * DM * 2, SZ_WO = (size_t)DM * DM * 2;
constexpr size_t SZ_LAYER = 2 * SZ_W1I + 2 * SZ_W1O + SZ_WIN + SZ_WO;
constexpr size_t OFF_W = 0;
constexpr size_t OFF_LBT = OFF_W + 2 * SZ_LAYER;
constexpr size_t OFF_SSQ = OFF_LBT + 2 * 2 * 1024 * 4;
constexpr size_t SSQ_SITE = (size_t)MTOT * 16;
constexpr size_t OFF_XB = OFF_SSQ + 7 * SSQ_SITE * 4;
constexpr size_t OFF_OBF = OFF_XB + (size_t)MG * DM * 2;
constexpr size_t OFF_RAW = OFF_OBF + (size_t)MG * DM * 2;
constexpr size_t OFF_PH = OFF_RAW + (size_t)MG * DM * 4;
constexpr size_t OFF_BAR = OFF_PH + (size_t)MG * NP_ * 2;
constexpr size_t WS_END = OFF_BAR + 256;

__device__ __forceinline__ unsigned pk2(float lo, float hi) {
    typedef __bf16 bf2 __attribute__((ext_vector_type(2)));
    f32x2 v = {lo, hi};
    return __builtin_bit_cast(unsigned, __builtin_convertvector(v, bf2));
}
__device__ __forceinline__ float bflo(unsigned u) { return __uint_as_float(u << 16); }
__device__ __forceinline__ float bfhi(unsigned u) { return __uint_as_float(u & 0xffff0000u); }
__device__ __forceinline__ int grow_tile(int g, int pm) { return pm < 64 ? g * 16384 + pm * 256 : 32768 + g * 32768 + (pm - 64) * 256; }
__device__ __forceinline__ int grow(int g, int r) { return r < 16384 ? g * 16384 + r : 32768 + g * 32768 + (r - 16384); }
__device__ __forceinline__ float sigmoid_f(float x) { return __builtin_amdgcn_rcpf(1.f + __expf(-x)); }
__device__ __forceinline__ float logsig_f(float z) { return fminf(z, 0.f) - __logf(1.f + __expf(-fabsf(z))); }

__device__ __forceinline__ float bperm(float x, int byte_idx) { return __int_as_float(__builtin_amdgcn_ds_bpermute(byte_idx, __float_as_int(x))); }
__device__ __forceinline__ float row_rstd(const float* ssq16, int R, int fq, int i16, int i32) {
    const f32x4 v = *(const f32x4*)(ssq16 + (size_t)R * 16 + 4 * fq);
    float s = (v[0] + v[1]) + (v[2] + v[3]);
    s += bperm(s, i16); s += bperm(s, i32);
    return rsqrtf(s * (1.f / 1024.f) + EPS);
}

__device__ __forceinline__ void rows_rstd8(float (&rs)[8], const float* ssq16, int Rbase  , int fq, int i16, int i32) {
    f32x4 v[8];
#pragma unroll
    for (int q = 0; q < 8; ++q) v[q] = *(const f32x4*)(ssq16 + (size_t)(Rbase + (q >> 2) * 128 + (q & 3) * 16) * 16 + 4 * fq);
#pragma unroll
    for (int q = 0; q < 8; ++q) { float s = (v[q][0] + v[q][1]) + (v[q][2] + v[q][3]); s += bperm(s, i16); s += bperm(s, i32); rs[q] = rsqrtf(s * (1.f / 1024.f) + EPS); }
}

namespace pg8 {
constexpr int BM = 256, BK = 64, HALF = 128, HTB = HALF * BK * 2, STAGE_BYTES = 8 * HTB, NXCD = 8, WGM = 8;
__device__ __forceinline__ int lds_byte(int r, int c) { const int st = (r >> 4) * 2 + (c >> 5), rr = r & 15, cc = c & 31, ob = rr * 64 + cc * 2; return st * 1024 + (ob ^ (((ob >> 9) & 1) << 5)); }
__device__ __forceinline__ void stage_rc(int b, int& R, int& C) { const int st = b / 1024, sb = b % 1024, swz = sb ^ (((sb >> 9) & 1) << 5); R = (st >> 1) * 16 + swz / 64; C = (st & 1) * 32 + (swz % 64) / 2; }
__device__ __forceinline__ int perm32(int rho) { const int n = rho >> 4, i = rho & 15; return 8 * (i >> 2) + 4 * n + (i & 3); }
struct Unit { int pm, pn; };
struct Gemm { const bf16_t* A; const bf16_t* Bt; int M, N, K; };
struct StaticOrder {
    int nM, nN, nwg, G, c;
    __device__ void init(int M, int N, int G_, int c_) { nM = M / BM; nN = N / BM; nwg = nM * nN; G = G_; c = c_; }
    __device__ bool next(int i, Unit& u) const {
        const long L = (long)i * G + c; if (L >= nwg) return false;
        int wgid = (int)L; { const int q = nwg / NXCD, r = nwg % NXCD, xcd = wgid % NXCD, off = wgid / NXCD; wgid = (xcd < r ? xcd * (q + 1) : r * (q + 1) + (xcd - r) * q) + off; }
        const int nig = WGM * nN, gid = wgid / nig, fm = gid * WGM, gsz = (nM - fm) < WGM ? (nM - fm) : WGM;
        u.pm = fm + ((wgid % nig) % gsz); u.pn = (wgid % nig) / gsz; return true;
    }
};

template <class Epi>
__device__ __forceinline__ void gemm_phase(LAS unsigned char* lds, const Gemm g, const StaticOrder& S, const Epi& E) {
    int tid_ = threadIdx.x; asm volatile("" : "+v"(tid_));
    const int tid = tid_, wid = __builtin_amdgcn_readfirstlane(tid >> 6), lane = tid & 63, wr = wid >> 2, wc = wid & 3, fr = lane & 15, fq = lane >> 4;
    const int K = g.K, nt = K / BK;
    unsigned voffA[2], voffB[2];
#pragma unroll
    for (int i = 0; i < 2; ++i) { int R, C; stage_rc(tid * 16 + i * 8192, R, C); const int Rb = Epi::PERM ? ((R & ~31) + perm32(R & 31)) : R;
        voffA[i] = (unsigned)(R * K + C) * 2u; voffB[i] = (unsigned)(Rb * K + C) * 2u; }
    const size_t kstep = (size_t)(BK * 2);
    const size_t hstep = (size_t)HALF * K * 2;
    const size_t tstep = 2 * hstep;
    const unsigned ldsw = (unsigned)wid * 1024u;
    const int aoff = lds_byte(wr * 64 + fr, fq * 8), boff = lds_byte(wc * 32 + fr, fq * 8);
#define PG8_SA(b, h) (((b) * 2 + (h)) * HTB)
#define PG8_SB(b, h) ((4 + (b) * 2 + (h)) * HTB)
#define PG8_STAGE(bufoff, gbase, voff) do { _Pragma("unroll") for (int _i = 0; _i < 2; ++_i) \
        __builtin_amdgcn_global_load_lds((const unsigned*)((const char*)(gbase) + (voff)[_i]), (LAS unsigned*)(lds + (bufoff) + ldsw + _i * 8192), 16, 0, 0); } while (0)
#define PG8_LDA(dst, b, h) do { _Pragma("unroll") for (int m = 0; m < 4; ++m) _Pragma("unroll") for (int k = 0; k < 2; ++k) dst[m][k] = *(const LAS bf16x8*)(lds + PG8_SA(b, h) + aoff + m * 2048 + k * 1024); } while (0)
#define PG8_LDB(dst, b, h) do { _Pragma("unroll") for (int n = 0; n < 2; ++n) _Pragma("unroll") for (int k = 0; k < 2; ++k) dst[n][k] = *(const LAS bf16x8*)(lds + PG8_SB(b, h) + boff + n * 2048 + k * 1024); } while (0)
#define PG8_MMA(ai, bj, At, Bt) do { __builtin_amdgcn_s_setprio(1); _Pragma("unroll") for (int m = 0; m < 4; ++m) _Pragma("unroll") for (int n = 0; n < 2; ++n) _Pragma("unroll") for (int k = 0; k < 2; ++k) \
        acc[ai][bj][m][n] = __builtin_amdgcn_mfma_f32_16x16x32_bf16(Bt[n][k], At[m][k], acc[ai][bj][m][n], 0, 0, 0); __builtin_amdgcn_s_setprio(0); } while (0)
#define PG8_WAIT_V(n) asm volatile("s_waitcnt vmcnt(" #n ")" ::: "memory")
#define PG8_WAIT_L(n) asm volatile("s_waitcnt lgkmcnt(" #n ")" ::: "memory")
#define PG8_BAR __builtin_amdgcn_s_barrier()
#define PG8_SCHED __builtin_amdgcn_sched_barrier(0)
    Unit cur, nxt; int ui = 0;
    if (!S.next(0, cur)) return;
    f32x4 acc[2][2][4][2];
#pragma unroll
    for (int a = 0; a < 2; ++a)
#pragma unroll
        for (int b = 0; b < 2; ++b)
#pragma unroll
            for (int m = 0; m < 4; ++m)
#pragma unroll
                for (int n = 0; n < 2; ++n) acc[a][b][m][n] = (f32x4){0.f, 0.f, 0.f, 0.f};
    bf16x8 At[4][2], B0[2][2], B1[2][2];
    const char* cA = (const char*)g.A + (size_t)cur.pm * tstep; const char* cB = (const char*)g.Bt + (size_t)cur.pn * tstep;
    PG8_STAGE(PG8_SB(0, 0), cB, voffB); PG8_STAGE(PG8_SA(0, 0), cA, voffA); PG8_STAGE(PG8_SB(0, 1), cB + hstep, voffB); PG8_STAGE(PG8_SA(0, 1), cA + hstep, voffA);
    if (wr == 1) PG8_BAR;
    PG8_WAIT_V(4); PG8_BAR;
    PG8_STAGE(PG8_SB(1, 0), cB + kstep, voffB); PG8_STAGE(PG8_SA(1, 0), cA + kstep, voffA); PG8_STAGE(PG8_SB(1, 1), cB + hstep + kstep, voffB);
    PG8_WAIT_V(6); PG8_BAR;
    for (;;) {
        const bool has_next = S.next(ui + 1, nxt);
        const char* nA = has_next ? (const char*)g.A + (size_t)nxt.pm * tstep : cA; const char* nB = has_next ? (const char*)g.Bt + (size_t)nxt.pn * tstep : cB;
        for (int t = 0; t < nt; t += 2) {
            const bool last = (t == nt - 2);
            const char* a1 = cA + (size_t)(t + 1) * kstep;
            const char* a2 = last ? nA : cA + (size_t)(t + 2) * kstep; const char* b2 = last ? nB : cB + (size_t)(t + 2) * kstep;
            const char* a3 = a2 + kstep; const char* b3 = b2 + kstep;
            PG8_LDB(B0, 0, 0); PG8_SCHED; PG8_LDA(At, 0, 0); PG8_STAGE(PG8_SA(1, 1), a1 + hstep, voffA);
            PG8_WAIT_L(8); PG8_BAR; PG8_WAIT_L(0); PG8_MMA(0, 0, At, B0); PG8_BAR; PG8_SCHED;
            PG8_LDB(B1, 0, 1); PG8_STAGE(PG8_SB(0, 0), b2, voffB);
            PG8_BAR; PG8_WAIT_L(0); PG8_MMA(0, 1, At, B1); PG8_BAR;
            PG8_LDA(At, 0, 1); PG8_STAGE(PG8_SA(0, 0), a2, voffA);
            PG8_BAR; PG8_WAIT_L(0); PG8_MMA(1, 0, At, B0); PG8_BAR; PG8_SCHED;
            PG8_STAGE(PG8_SB(0, 1), b2 + hstep, voffB);
            PG8_WAIT_V(6); PG8_BAR; PG8_MMA(1, 1, At, B1); PG8_BAR;
            PG8_LDB(B0, 1, 0); PG8_SCHED; PG8_LDA(At, 1, 0); PG8_STAGE(PG8_SA(0, 1), a2 + hstep, voffA);
            PG8_WAIT_L(8); PG8_BAR; PG8_WAIT_L(0); PG8_MMA(0, 0, At, B0); PG8_BAR; PG8_SCHED;
            PG8_LDB(B1, 1, 1); PG8_STAGE(PG8_SB(1, 0), b3, voffB);
            PG8_BAR; PG8_WAIT_L(0); PG8_MMA(0, 1, At, B1); PG8_BAR;
            PG8_LDA(At, 1, 1); PG8_STAGE(PG8_SA(1, 0), a3, voffA);
            PG8_BAR; PG8_WAIT_L(0); PG8_MMA(1, 0, At, B0); PG8_BAR; PG8_SCHED;
            PG8_STAGE(PG8_SB(1, 1), b3 + hstep, voffB);
            PG8_WAIT_V(6); PG8_BAR; PG8_MMA(1, 1, At, B1); PG8_BAR;
        }
        E(acc, cur, wr, wc, fr, fq);
        if (!has_next) break;
#pragma unroll
        for (int a = 0; a < 2; ++a)
#pragma unroll
            for (int b = 0; b < 2; ++b)
#pragma unroll
                for (int m = 0; m < 4; ++m)
#pragma unroll
                    for (int n = 0; n < 2; ++n) acc[a][b][m][n] = (f32x4){0.f, 0.f, 0.f, 0.f};
        cur = nxt; cA = nA; cB = nB; ++ui;
    }
    PG8_WAIT_V(0);
    if (wr == 0) PG8_BAR;
    PG8_BAR;
#undef PG8_SA
#undef PG8_SB
#undef PG8_STAGE
#undef PG8_LDA
#undef PG8_LDB
#undef PG8_MMA
#undef PG8_WAIT_V
#undef PG8_WAIT_L
#undef PG8_BAR
#undef PG8_SCHED
}
}

struct EpiFfnIn {
    static constexpr bool PERM = true;
    bf16_t* H; const float* ssq; int g;
    __device__ __forceinline__ void operator()(const f32x4 (&acc)[2][2][4][2], const pg8::Unit& u, int wr, int wc, int fr_in, int fq) const {
        int fr = fr_in; asm volatile("" : "+v"(fr));
        const int lane_ = fr | (fq << 4), i16 = (lane_ ^ 16) << 2, i32 = (lane_ ^ 32) << 2; (void)i16; (void)i32;
        const int R0 = grow_tile(g, u.pm);
        const int col0 = u.pn * 128 + wc * 32 + 8 * fq;
        float rs8[8]; rows_rstd8(rs8, ssq, R0 + wr * 64 + fr, fq, i16, i32);
#pragma unroll
        for (int ai = 0; ai < 2; ++ai)
#pragma unroll
            for (int m = 0; m < 4; ++m) {
                const int rt = ai * 128 + wr * 64 + m * 16 + fr;
                const float rs = rs8[ai * 4 + m];
                float hv[8];
#pragma unroll
                for (int n = 0; n < 2; ++n)
#pragma unroll
                    for (int j = 0; j < 4; ++j) { const float a = acc[ai][0][m][n][j] * rs, b = acc[ai][1][m][n][j] * rs; hv[n * 4 + j] = a * sigmoid_f(a) * b; }
                u32x4 w; w.x = pk2(hv[0], hv[1]); w.y = pk2(hv[2], hv[3]); w.z = pk2(hv[4], hv[5]); w.w = pk2(hv[6], hv[7]);
                *(u32x4*)(H + (size_t)(u.pm * 256 + rt) * DFF + col0) = w;
            }
    }
};
struct EpiNull { static constexpr bool PERM = true; float* sink; __device__ __forceinline__ void operator()(const f32x4 (&acc)[2][2][4][2], const pg8::Unit& u, int wr, int wc, int fr, int fq) const { if (acc[0][0][0][0][0] == 123.456f) sink[0] = 1.f; } };
struct EpiRes {
    static constexpr bool PERM = true;
    bf16_t* XB; float* ssq; float scale; int g;
    __device__ __forceinline__ void operator()(const f32x4 (&acc)[2][2][4][2], const pg8::Unit& u, int wr, int wc, int fr_in, int fq) const {
        int fr = fr_in; asm volatile("" : "+v"(fr));
        const int lane_ = fr | (fq << 4), i16 = (lane_ ^ 16) << 2, i32 = (lane_ ^ 32) << 2; (void)i16; (void)i32;
        const int R0 = grow_tile(g, u.pm);
#pragma unroll
        for (int ai = 0; ai < 2; ++ai) {
            u32x4 old[4][2];
#pragma unroll
            for (int m = 0; m < 4; ++m)
#pragma unroll
                for (int bj = 0; bj < 2; ++bj)
                    old[m][bj] = *(const u32x4*)(XB + (size_t)(u.pm * 256 + ai * 128 + wr * 64 + m * 16 + fr) * DM + u.pn * 256 + bj * 128 + wc * 32 + 8 * fq);
#pragma unroll
            for (int m = 0; m < 4; ++m) {
                const int rt = ai * 128 + wr * 64 + m * 16 + fr;
                bf16_t* xb = XB + (size_t)(u.pm * 256 + rt) * DM;
                float part = 0.f;
#pragma unroll
                for (int bj = 0; bj < 2; ++bj) {
                    const int c0 = u.pn * 256 + bj * 128 + wc * 32 + 8 * fq;
                    const u32x4 o = old[m][bj];
                    const f32x4 a0 = acc[ai][bj][m][0], a1 = acc[ai][bj][m][1];
                    float n[8];
                    n[0] = bflo(o.x) + a0[0] * scale; n[1] = bfhi(o.x) + a0[1] * scale; n[2] = bflo(o.y) + a0[2] * scale; n[3] = bfhi(o.y) + a0[3] * scale;
                    n[4] = bflo(o.z) + a1[0] * scale; n[5] = bfhi(o.z) + a1[1] * scale; n[6] = bflo(o.w) + a1[2] * scale; n[7] = bfhi(o.w) + a1[3] * scale;
                    u32x4 w; w.x = pk2(n[0], n[1]); w.y = pk2(n[2], n[3]); w.z = pk2(n[4], n[5]); w.w = pk2(n[6], n[7]);
                    *(u32x4*)(xb + c0) = w;
                    part += (n[0] * n[0] + n[1] * n[1]) + (n[2] * n[2] + n[3] * n[3]) + (n[4] * n[4] + n[5] * n[5]) + (n[6] * n[6] + n[7] * n[7]);
                }
                part += bperm(part, i16); part += bperm(part, i32);
                if (fq == 0) ssq[(size_t)(R0 + rt) * 16 + u.pn * 4 + wc] = part;
            }
            asm volatile("" ::: "memory");
        }
    }
};
struct EpiWin {
    static constexpr bool PERM = true;
    bf16_t* P; const float* ssq; const float* lbA; const float* lbB; const float* bg; int g;
    __device__ __forceinline__ void operator()(const f32x4 (&acc)[2][2][4][2], const pg8::Unit& u, int wr, int wc, int fr_in, int fq) const {
        int fr = fr_in; asm volatile("" : "+v"(fr));
        const int lane_ = fr | (fq << 4), i16 = (lane_ ^ 16) << 2, i32 = (lane_ ^ 32) << 2; (void)i16; (void)i32;
        const int R0 = grow_tile(g, u.pm);
        const int pn = u.pn;
        const int mode = (pn >= 2 && pn <= 5) ? 1 : (pn == 8 || pn == 9) ? 2 : (pn == 14 || pn == 15) ? 4 : (pn >= 16) ? 5 : 0;
        float rs8[8]; rows_rstd8(rs8, ssq, R0 + wr * 64 + fr, fq, i16, i32);
#pragma unroll
        for (int bj = 0; bj < 2; ++bj) {
            const int cin = bj * 128 + wc * 32 + 8 * fq;
            float ca[8], cb[8];
            if (mode == 1) { const int lc = 256 * (pn - 2) + cin;
#pragma unroll
                for (int j = 0; j < 8; ++j) { ca[j] = lbA[lc + j]; cb[j] = lbB[lc + j]; } }
            else if (mode == 4) { const int lc = 256 * (pn - 14) + cin;
#pragma unroll
                for (int j = 0; j < 8; ++j) { ca[j] = bg[lc + j]; cb[j] = 0.f; } }
            else {
#pragma unroll
                for (int j = 0; j < 8; ++j) { ca[j] = 0.f; cb[j] = 0.f; } }
#pragma unroll
            for (int ai = 0; ai < 2; ++ai)
#pragma unroll
                for (int m = 0; m < 4; ++m) {
                    const int rt = ai * 128 + wr * 64 + m * 16 + fr;
                    const float rs = rs8[ai * 4 + m];
                    float v[8];
#pragma unroll
                    for (int n = 0; n < 2; ++n)
#pragma unroll
                        for (int j = 0; j < 4; ++j) v[n * 4 + j] = acc[ai][bj][m][n][j] * rs;
                    if (mode == 1) {
#pragma unroll
                        for (int j = 0; j < 8; ++j) v[j] = __logf(ca[j] + cb[j] * sigmoid_f(v[j]));
                    } else if (mode == 2) {
#pragma unroll
                        for (int j = 0; j < 8; ++j) v[j] = sigmoid_f(v[j]);
                    } else if (mode == 4) {
#pragma unroll
                        for (int j = 0; j < 8; ++j) v[j] = logsig_f(v[j] + ca[j]) * (1.f / 16.f);
                    } else if (mode == 5) {
#pragma unroll
                        for (int j = 0; j < 8; ++j) v[j] = v[j] * sigmoid_f(v[j]);
                    }
                    u32x4 w; w.x = pk2(v[0], v[1]); w.y = pk2(v[2], v[3]); w.z = pk2(v[4], v[5]); w.w = pk2(v[6], v[7]);
                    *(u32x4*)(P + (size_t)(u.pm * 256 + rt) * NP_ + pn * 256 + cin) = w;
                }
        }
    }
};

struct Args {
    const float* xp; const float* xs; const float* lower_bounds; const float* n1; const float* w1i; const float* w1o; const float* nm; const float* wi;
    const float* wg; const float* bg; const float* hgn; const float* glan; const float* wo; const float* n2; const float* w2i; const float* w2o; const float* nf;
    float* out; unsigned char* ws;
};

__device__ __forceinline__ void p0_convert(const Args& A) {
    const long nth = (long)gridDim.x * NTHREADS, gt = (long)blockIdx.x * NTHREADS + threadIdx.x;
    unsigned char* ws = A.ws;
    const long cnt[6] = {(long)NFF * 128, (long)DM * 352, (long)NP_ * 128, (long)DM * 128, (long)NFF * 128, (long)DM * 352};
    const long per_layer = cnt[0] + cnt[1] + cnt[2] + cnt[3] + cnt[4] + cnt[5];
    for (long it = gt; it < 2 * per_layer; it += nth) {
        const int l = it >= per_layer ? 1 : 0; long i = it - (long)l * per_layer;
        int job = 0;
#pragma unroll
        for (int j = 0; j < 5; ++j) if (job == j && i >= cnt[j]) { i -= cnt[j]; job = j + 1; }
        unsigned char* wl = ws + OFF_W + (size_t)l * SZ_LAYER;
        float v[8];
        bf16_t* dst;
        if (job == 0 || job == 4) {
            const int np = (int)(i % NFF), k0 = (int)(i / NFF) * 8;
            const float* W = (job == 0 ? A.w1i : A.w2i) + (size_t)l * DM * NFF; const float* gn = (job == 0 ? A.n1 : A.n2) + l * DM;
            const int n = ((np & 128) ? DFF : 0) + (np >> 8) * 128 + (np & 127);
#pragma unroll
            for (int e = 0; e < 8; ++e) v[e] = W[(size_t)(k0 + e) * NFF + n] * gn[k0 + e];
            dst = (bf16_t*)(wl + (job == 0 ? 0 : SZ_W1I + SZ_W1O + SZ_WIN + SZ_WO)) + (size_t)np * DM + k0;
        } else if (job == 1 || job == 5) {
            const int np = (int)(i % DM), k0 = (int)(i / DM) * 8;
            const float* W = (job == 1 ? A.w1o : A.w2o) + (size_t)l * DFF * DM;
#pragma unroll
            for (int e = 0; e < 8; ++e) v[e] = W[(size_t)(k0 + e) * DM + np];
            dst = (bf16_t*)(wl + (job == 1 ? SZ_W1I : 2 * SZ_W1I + SZ_W1O + SZ_WIN + SZ_WO)) + (size_t)np * DFF + k0;
        } else if (job == 3) {
            const int np = (int)(i % DM), k0 = (int)(i / DM) * 8;
            const float* W = A.wo + (size_t)l * DM * DM;
#pragma unroll
            for (int e = 0; e < 8; ++e) v[e] = W[(size_t)(k0 + e) * DM + np];
            dst = (bf16_t*)(wl + SZ_W1I + SZ_W1O + SZ_WIN) + (size_t)np * DM + k0;
        } else {
            const int np = (int)(i % NP_), k0 = (int)(i / NP_) * 8;
            const float* W = A.wi + (size_t)l * DM * DINSRC; const float* gn = A.nm + l * DM;
            if (np >= 3584 && np < 4096) {
                const int d = np >= 3840 ? 1 : 0, c = np - 3584 - 256 * d;
                const float* G = A.wg + ((size_t)l * 2 + d) * 16 * 256;
                float gc[16];
#pragma unroll
                for (int r = 0; r < 16; ++r) gc[r] = G[r * 256 + c];
#pragma unroll
                for (int e = 0; e < 8; ++e) { const float* wr_ = W + (size_t)(k0 + e) * DINSRC + 3584 + 16 * d; float s = 0.f;
#pragma unroll
                    for (int r = 0; r < 16; ++r) s += wr_[r] * gc[r];
                    v[e] = s * gn[k0 + e]; }
            } else {
                const int n = np < 3584 ? np : 3616 + (np - 4096);
                const float sc = (np >= 2560 && np < 2816) ? 0.125f : 1.f;
#pragma unroll
                for (int e = 0; e < 8; ++e) v[e] = W[(size_t)(k0 + e) * DINSRC + n] * gn[k0 + e] * sc;
            }
            dst = (bf16_t*)(wl + SZ_W1I + SZ_W1O) + (size_t)np * DM + k0;
        }
        u32x4 w; w.x = pk2(v[0], v[1]); w.y = pk2(v[2], v[3]); w.z = pk2(v[4], v[5]); w.w = pk2(v[6], v[7]);
        *(u32x4*)dst = w;
    }
    float* lbt = (float*)(ws + OFF_LBT);
    for (long i = gt; i < 2048; i += nth) {
        const int l = (int)(i >> 10), c = (int)(i & 1023);
        const float a = A.lower_bounds[c], b = A.lower_bounds[1024 + c], mx = fmaxf(a, b);
        const float ea = __expf(a - mx), eb = __expf(b - mx);
        const float lb = l == 0 ? 0.f : eb / (ea + eb);
        lbt[l * 2048 + c] = fmaxf(lb, 1e-30f);
        lbt[l * 2048 + 1024 + c] = 1.f - lb;
    }
}

__device__ __forceinline__ void g0_prologue(const float* xp, const float* xs, unsigned char* ws, int g) {
    int tid_ = threadIdx.x; asm volatile("" : "+v"(tid_));
    const int lane = tid_ & 63, wv = blockIdx.x * 8 + (tid_ >> 6), nwv = gridDim.x * 8;
    bf16_t* XB = (bf16_t*)(ws + OFF_XB); float* ssq = (float*)(ws + OFF_SSQ);
    for (int r = wv; r < MG; r += nwv) {
        const int R = grow(g, r);
        const float* x = R < 32768 ? xp + (size_t)R * DM : xs + (size_t)(R - 32768) * DM;
        float s = 0.f;
#pragma unroll
        for (int i = 0; i < 4; ++i) { const f32x4 v = *(const f32x4*)(x + i * 256 + lane * 4);
            s += (v[0] * v[0] + v[1] * v[1]) + (v[2] * v[2] + v[3] * v[3]);
            u32x2 w; w.x = pk2(v[0], v[1]); w.y = pk2(v[2], v[3]); *(u32x2*)(XB + (size_t)r * DM + i * 256 + lane * 4) = w; }
#pragma unroll
        for (int o = 32; o >= 1; o >>= 1) s += bperm(s, (lane ^ o) << 2);
        if (lane < 4) *(f32x4*)(ssq + (size_t)R * 16 + 4 * lane) = (f32x4){lane == 0 ? s : 0.f, 0.f, 0.f, 0.f};
    }
}
__device__ __forceinline__ void final_norm(float* outp, const float* nf, unsigned char* ws, int g) {
    int tid_ = threadIdx.x; asm volatile("" : "+v"(tid_));
    const int lane = tid_ & 63, wv = blockIdx.x * 8 + (tid_ >> 6), nwv = gridDim.x * 8;
    const float* ssq = (const float*)(ws + OFF_SSQ) + 6 * SSQ_SITE; const bf16_t* XB = (const bf16_t*)(ws + OFF_XB);
    for (int r = wv; r < MG; r += nwv) {
        const int R = grow(g, r);
        float* x = outp + (size_t)R * DM;
        const f32x4 q0 = *(const f32x4*)(ssq + (size_t)R * 16), q1 = *(const f32x4*)(ssq + (size_t)R * 16 + 4), q2 = *(const f32x4*)(ssq + (size_t)R * 16 + 8), q3 = *(const f32x4*)(ssq + (size_t)R * 16 + 12);
        const float rs = rsqrtf((((q0[0] + q0[1]) + (q0[2] + q0[3])) + ((q1[0] + q1[1]) + (q1[2] + q1[3])) + (((q2[0] + q2[1]) + (q2[2] + q2[3])) + ((q3[0] + q3[1]) + (q3[2] + q3[3])))) * (1.f / 1024.f) + EPS);
#pragma unroll
        for (int i = 0; i < 4; ++i) { const int c = i * 256 + lane * 4; const u32x2 xv = *(const u32x2*)(XB + (size_t)r * DM + c); const f32x4 gn = *(const f32x4*)(nf + c);
            f32x4 v = {bflo(xv.x) * rs * gn[0], bfhi(xv.x) * rs * gn[1], bflo(xv.y) * rs * gn[2], bfhi(xv.y) * rs * gn[3]}; *(f32x4*)(x + c) = v; }
    }
}

#define MFMA32(a, b, c) __builtin_amdgcn_mfma_f32_32x32x16_bf16((a), (b), (c), 0, 0, 0)
constexpr int SC_QT = 0, SC_KT = 34816, SC_VT = 69632, SC_ST = 104448, SC_TOT = 139264, SC_VEC = 143360, SC_RED = 144896, SC_END = 145920;
constexpr int TSTR = 272;

template <int DK>
__device__ __forceinline__ void scan_half(LAS unsigned char* L, const bf16_t* __restrict__ P, float* RAW, bf16_t* OBF, const float* __restrict__ gain,
                                          int seqbase, int T, int dir, int qcol, int kcol, int gcol, int vcol, int gatecol, int ocol,
                                          int j0, int j1, bool second, f32x16& S0, f32x16& S1) {
    constexpr bool GLA = (DK == 64);
    constexpr int NPAIR = DK / 2, NSEG = NTHREADS / NPAIR, SL = 128 / NSEG, QSTR = (DK + 8) * 2, NKS = DK / 16;
    int tid_ = threadIdx.x; asm volatile("" : "+v"(tid_));
    const int tid = tid_, lane = tid & 63, w = __builtin_amdgcn_readfirstlane(tid >> 6);
    const int r = lane & 31, h = lane >> 5;
    const int cp = tid % NPAIR, seg = tid / NPAIR, vp = tid & 63, vseg = tid >> 6;
    const int tb = w >> 1, dh = w & 1, dvb_s = w & 3, kq = w >> 2;
    unsigned g2[SL], q2[SL], k2[SL], v2[16];

#define ROWOF(j, i) (seqbase + (dir ? (T - 1 - ((j) * 128 + (i))) : ((j) * 128 + (i))))
    const char* Pg = (const char*)P + gcol * 2; const char* Pq = (const char*)P + qcol * 2; const char* Pk = (const char*)P + kcol * 2; const char* Pv = (const char*)P + vcol * 2;
    const int rstep = dir ? -(NP_ * 2) : (NP_ * 2);
#define LOAD_CHUNK(j) do { int jj_ = (j); asm volatile("" : "+s"(jj_)); \
        { const int p0_ = jj_ * 128 + seg * SL; const int off0_ = (seqbase + (dir ? (T - 1 - p0_) : p0_)) * (NP_ * 2) + 4 * cp; \
          _Pragma("unroll") for (int i_ = 0; i_ < SL; ++i_) { const unsigned o_ = (unsigned)(off0_ + i_ * rstep); \
            g2[i_] = *(const unsigned*)(Pg + o_); q2[i_] = *(const unsigned*)(Pq + o_); if (GLA) k2[i_] = *(const unsigned*)(Pk + o_); else k2[i_] = 0u; } } \
        { const int p0_ = jj_ * 128 + vseg * 16; const int off0_ = (seqbase + (dir ? (T - 1 - p0_) : p0_)) * (NP_ * 2) + 4 * vp; \
          _Pragma("unroll") for (int i_ = 0; i_ < 16; ++i_) { const unsigned o_ = (unsigned)(off0_ + i_ * rstep); v2[i_] = *(const unsigned*)(Pv + o_); } } \
    } while (0)

    LOAD_CHUNK(j0);
    for (int j = j0; j < j1; ++j) {
        int rq = r * QSTR + 16 * h, rt = r * TSTR + 16 * h, rq8 = r * QSTR + 8 * h, rt8 = r * TSTR + 8 * h, h16 = 16 * h;
        asm volatile("" : "+v"(rq), "+v"(rt), "+v"(rq8), "+v"(rt8), "+v"(h16));
        float c0[SL], c1[SL];
        { float s0 = 0.f, s1 = 0.f;
#pragma unroll
          for (int i = 0; i < SL; ++i) { s0 += bflo(g2[i]); s1 += bfhi(g2[i]); c0[i] = s0; c1[i] = s1; }
          *(LAS f32x2*)(L + SC_TOT + (seg * DK + 2 * cp) * 4) = (f32x2){s0, s1}; }
        __syncthreads();
        float off0 = 0.f, off1 = 0.f, m0 = 0.f, m1 = 0.f, bl0 = 0.f, bl1 = 0.f;
#pragma unroll
        for (int s = 0; s < NSEG; ++s) { const f32x2 t = *(const LAS f32x2*)(L + SC_TOT + (s * DK + 2 * cp) * 4);
            if (s < seg) { off0 += t.x; off1 += t.y; }
            if (s < NSEG / 2) { m0 += t.x; m1 += t.y; }
            bl0 += t.x; bl1 += t.y; }
        unsigned kk[SL];
#pragma unroll
        for (int i = 0; i < SL; ++i) {
            const float e0 = fminf(fmaxf(off0 + c0[i] - m0, -80.f), 80.f), e1 = fminf(fmaxf(off1 + c1[i] - m1, -80.f), 80.f);
            const float x0 = __expf(e0), x1 = __expf(e1), y0 = __expf(-e0), y1 = __expf(-e1);
            float ka, kb;
            if (GLA) { ka = bflo(k2[i]); kb = bfhi(k2[i]); } else { ka = 1.f - __expf(bflo(g2[i])); kb = 1.f - __expf(bfhi(g2[i])); }
            const unsigned qq = pk2(bflo(q2[i]) * x0, bfhi(q2[i]) * x1);
            kk[i] = pk2(ka * y0, kb * y1);
            *(LAS unsigned*)(L + SC_QT + (seg * SL + i) * QSTR + 4 * cp) = qq;
            *(LAS unsigned*)(L + SC_KT + (seg * SL + i) * QSTR + 4 * cp) = kk[i];
        }
        {
            u32x4 a0, a1, b0, b1;
            a0.x = (v2[0] & 0xffffu) | (v2[1] << 16); a0.y = (v2[2] & 0xffffu) | (v2[3] << 16); a0.z = (v2[4] & 0xffffu) | (v2[5] << 16); a0.w = (v2[6] & 0xffffu) | (v2[7] << 16);
            a1.x = (v2[8] & 0xffffu) | (v2[9] << 16); a1.y = (v2[10] & 0xffffu) | (v2[11] << 16); a1.z = (v2[12] & 0xffffu) | (v2[13] << 16); a1.w = (v2[14] & 0xffffu) | (v2[15] << 16);
            b0.x = (v2[0] >> 16) | (v2[1] & 0xffff0000u); b0.y = (v2[2] >> 16) | (v2[3] & 0xffff0000u); b0.z = (v2[4] >> 16) | (v2[5] & 0xffff0000u); b0.w = (v2[6] >> 16) | (v2[7] & 0xffff0000u);
            b1.x = (v2[8] >> 16) | (v2[9] & 0xffff0000u); b1.y = (v2[10] >> 16) | (v2[11] & 0xffff0000u); b1.z = (v2[12] >> 16) | (v2[13] & 0xffff0000u); b1.w = (v2[14] >> 16) | (v2[15] & 0xffff0000u);
            LAS unsigned char* pv = L + SC_VT + (2 * vp) * TSTR + vseg * 32;
            *(LAS u32x4*)(pv) = a0; *(LAS u32x4*)(pv + 16) = a1; *(LAS u32x4*)(pv + TSTR) = b0; *(LAS u32x4*)(pv + TSTR + 16) = b1;
        }
        if (seg == 0) {
            *(LAS f32x2*)(L + SC_VEC + (2 * cp) * 4) = (f32x2){__expf(m0), __expf(m1)};
            *(LAS f32x2*)(L + SC_VEC + 512 + (2 * cp) * 4) = (f32x2){__expf(bl0), __expf(bl1)};
            *(LAS f32x2*)(L + SC_VEC + 1024 + (2 * cp) * 4) = (f32x2){__expf(bl0 - m0), __expf(bl1 - m1)};
        }
        __syncthreads();
#pragma unroll
        for (int ti = 0; ti < (GLA ? 1 : 2); ++ti) {
            const int kb_ = GLA ? kq : 2 * kq + ti;
            const f32x16& Sx = ti == 0 ? S0 : S1;
#pragma unroll
            for (int gq = 0; gq < 4; ++gq) {
                const int k = 32 * kb_ + 8 * gq + 4 * h;
                const f32x4 em = *(const LAS f32x4*)(L + SC_VEC + (32 * kb_ + 8 * gq) * 4 + h16);
                u32x2 wv; wv.x = pk2(Sx[4 * gq] * em[0], Sx[4 * gq + 1] * em[1]); wv.y = pk2(Sx[4 * gq + 2] * em[2], Sx[4 * gq + 3] * em[3]);
                *(LAS u32x2*)(L + SC_ST + 32 * dvb_s * QSTR + rq8 + (32 * kb_ + 8 * gq) * 2) = wv;
            }
        }
        bf16x8 ps[4][2];
        {
            bf16x8 qf[NKS];
#pragma unroll
            for (int ks = 0; ks < NKS; ++ks) qf[ks] = *(const LAS bf16x8*)(L + SC_QT + 32 * tb * QSTR + rq + 32 * ks);
#pragma unroll
            for (int sb = 0; sb < 4; ++sb) {
                if (sb <= tb) {
                    bf16x8 af[NKS];
#pragma unroll
                    for (int ks = 0; ks < NKS; ++ks) af[ks] = *(const LAS bf16x8*)(L + SC_KT + 32 * sb * QSTR + rq + 32 * ks);
                    f32x16 x;
#pragma unroll
                    for (int i = 0; i < 16; ++i) x[i] = 0.f;
#pragma unroll
                    for (int ks = 0; ks < NKS; ++ks) x = MFMA32(af[ks], qf[ks], x);
                    if (sb == tb) {
#pragma unroll
                        for (int i = 0; i < 16; ++i) { const int cr = (i & 3) + 8 * (i >> 2) + 4 * h; x[i] = cr <= r ? x[i] : 0.f; }
                    }
#pragma unroll
                    for (int ss = 0; ss < 2; ++ss) { u32x4 pw; pw.x = pk2(x[8 * ss], x[8 * ss + 1]); pw.y = pk2(x[8 * ss + 2], x[8 * ss + 3]); pw.z = pk2(x[8 * ss + 4], x[8 * ss + 5]); pw.w = pk2(x[8 * ss + 6], x[8 * ss + 7]);
                        ps[sb][ss] = __builtin_bit_cast(bf16x8, pw); }
                } else { ps[sb][0] = (bf16x8){0, 0, 0, 0, 0, 0, 0, 0}; ps[sb][1] = (bf16x8){0, 0, 0, 0, 0, 0, 0, 0}; }
            }
        }
        __syncthreads();
        {
            LAS unsigned char* pk_ = L + SC_KT + (2 * cp) * TSTR + seg * SL * 2;
            if (SL == 16) {
                u32x4 a0, a1, b0, b1;
                a0.x = (kk[0] & 0xffffu) | (kk[1] << 16); a0.y = (kk[2] & 0xffffu) | (kk[3] << 16); a0.z = (kk[4] & 0xffffu) | (kk[5] << 16); a0.w = (kk[6] & 0xffffu) | (kk[7] << 16);
                a1.x = (kk[8 % SL] & 0xffffu) | (kk[9 % SL] << 16); a1.y = (kk[10 % SL] & 0xffffu) | (kk[11 % SL] << 16); a1.z = (kk[12 % SL] & 0xffffu) | (kk[13 % SL] << 16); a1.w = (kk[14 % SL] & 0xffffu) | (kk[15 % SL] << 16);
                b0.x = (kk[0] >> 16) | (kk[1] & 0xffff0000u); b0.y = (kk[2] >> 16) | (kk[3] & 0xffff0000u); b0.z = (kk[4] >> 16) | (kk[5] & 0xffff0000u); b0.w = (kk[6] >> 16) | (kk[7] & 0xffff0000u);
                b1.x = (kk[8 % SL] >> 16) | (kk[9 % SL] & 0xffff0000u); b1.y = (kk[10 % SL] >> 16) | (kk[11 % SL] & 0xffff0000u); b1.z = (kk[12 % SL] >> 16) | (kk[13 % SL] & 0xffff0000u); b1.w = (kk[14 % SL] >> 16) | (kk[15 % SL] & 0xffff0000u);
                *(LAS u32x4*)(pk_) = a0; *(LAS u32x4*)(pk_ + 16) = a1; *(LAS u32x4*)(pk_ + TSTR) = b0; *(LAS u32x4*)(pk_ + TSTR + 16) = b1;
            } else {
                u32x4 a0, b0;
                a0.x = (kk[0] & 0xffffu) | (kk[1] << 16); a0.y = (kk[2] & 0xffffu) | (kk[3] << 16); a0.z = (kk[4] & 0xffffu) | (kk[5] << 16); a0.w = (kk[6] & 0xffffu) | (kk[7] << 16);
                b0.x = (kk[0] >> 16) | (kk[1] & 0xffff0000u); b0.y = (kk[2] >> 16) | (kk[3] & 0xffff0000u); b0.z = (kk[4] >> 16) | (kk[5] & 0xffff0000u); b0.w = (kk[6] >> 16) | (kk[7] & 0xffff0000u);
                *(LAS u32x4*)(pk_) = a0; *(LAS u32x4*)(pk_ + TSTR) = b0;
            }
        }
        const int orow = ROWOF(j, 32 * tb + r);
        f32x16 O[2];
        {
            bf16x8 qf[NKS];
#pragma unroll
            for (int ks = 0; ks < NKS; ++ks) qf[ks] = *(const LAS bf16x8*)(L + SC_QT + 32 * tb * QSTR + rq + 32 * ks);
#pragma unroll
            for (int dvi = 0; dvi < 2; ++dvi) {
                const int dvb = 2 * dh + dvi;
                bf16x8 sf[NKS];
#pragma unroll
                for (int ks = 0; ks < NKS; ++ks) sf[ks] = *(const LAS bf16x8*)(L + SC_ST + 32 * dvb * QSTR + rq + 32 * ks);
                f32x16 o;
#pragma unroll
                for (int i = 0; i < 16; ++i) o[i] = 0.f;
#pragma unroll
                for (int ks = 0; ks < NKS; ++ks) o = MFMA32(sf[ks], qf[ks], o);
                O[dvi] = o;
            }
        }
        f32x4 praw[2][4];
        if (second) {
#pragma unroll
            for (int dvi = 0; dvi < 2; ++dvi)
#pragma unroll
                for (int gq = 0; gq < 4; ++gq) praw[dvi][gq] = *(const f32x4*)(RAW + (size_t)orow * DM + ocol + 32 * (2 * dh + dvi) + 8 * gq + 4 * h);
        }
#pragma unroll
        for (int dvi = 0; dvi < 2; ++dvi) {
            const int dvb = 2 * dh + dvi;
            f32x16 o = O[dvi];
#pragma unroll
            for (int sb = 0; sb < 4; ++sb) {
                if (sb <= tb) {
                    const LAS unsigned char* pa = L + SC_VT + 32 * dvb * TSTR + rt8 + 64 * sb;
                    const s16x4 l0 = *(const LAS s16x4*)(pa), h0 = *(const LAS s16x4*)(pa + 16), l1 = *(const LAS s16x4*)(pa + 32), h1 = *(const LAS s16x4*)(pa + 48);
                    o = MFMA32(__builtin_shufflevector(l0, h0, 0, 1, 2, 3, 4, 5, 6, 7), ps[sb][0], o);
                    o = MFMA32(__builtin_shufflevector(l1, h1, 0, 1, 2, 3, 4, 5, 6, 7), ps[sb][1], o);
                }
            }
            O[dvi] = o;
        }
        if (!second) {
#pragma unroll
            for (int dvi = 0; dvi < 2; ++dvi)
#pragma unroll
                for (int gq = 0; gq < 4; ++gq) {
                    const int dv = 32 * (2 * dh + dvi) + 8 * gq + 4 * h;
                    *(f32x4*)(RAW + (size_t)orow * DM + ocol + dv) = (f32x4){O[dvi][4 * gq], O[dvi][4 * gq + 1], O[dvi][4 * gq + 2], O[dvi][4 * gq + 3]};
                }
        } else {
            float ssum = 0.f;
#pragma unroll
            for (int dvi = 0; dvi < 2; ++dvi)
#pragma unroll
                for (int gq = 0; gq < 4; ++gq) {
                    const f32x4 pr = praw[dvi][gq];
#pragma unroll
                    for (int e = 0; e < 4; ++e) { const float t = O[dvi][4 * gq + e] + pr[e]; O[dvi][4 * gq + e] = t; ssum += t * t; }
                }
            ssum += bperm(ssum, (lane ^ 32) << 2);
            if (h == 0) *(LAS float*)(L + SC_RED + (w * 32 + r) * 4) = ssum;
        }
        __syncthreads();
        if (second) {
            const float tot = *(const LAS float*)(L + SC_RED + ((w & ~1) * 32 + r) * 4) + *(const LAS float*)(L + SC_RED + ((w | 1) * 32 + r) * 4);
            const float rs = rsqrtf(tot * (1.f / 128.f) + EPS);
#pragma unroll
            for (int dvi = 0; dvi < 2; ++dvi)
#pragma unroll
                for (int gq = 0; gq < 4; ++gq) {
                    const int dv = 32 * (2 * dh + dvi) + 8 * gq + 4 * h;
                    const f32x4 gn = *(const f32x4*)(gain + dv);
                    const u32x2 gt = *(const u32x2*)(P + (size_t)orow * NP_ + gatecol + dv);
                    u32x2 wv; wv.x = pk2(O[dvi][4 * gq] * rs * gn[0] * bflo(gt.x), O[dvi][4 * gq + 1] * rs * gn[1] * bfhi(gt.x));
                    wv.y = pk2(O[dvi][4 * gq + 2] * rs * gn[2] * bflo(gt.y), O[dvi][4 * gq + 3] * rs * gn[3] * bfhi(gt.y));
                    *(u32x2*)(OBF + (size_t)orow * DM + ocol + dv) = wv;
                }
        }
        if (j + 1 < j1) LOAD_CHUNK(j + 1);
        {
            bf16x8 vb[8];
#pragma unroll
            for (int ks = 0; ks < 8; ++ks) vb[ks] = *(const LAS bf16x8*)(L + SC_VT + 32 * dvb_s * TSTR + rt + 32 * ks);
#pragma unroll
            for (int ti = 0; ti < (GLA ? 1 : 2); ++ti) {
                const int kb_ = GLA ? kq : 2 * kq + ti;
                bf16x8 ka[8];
#pragma unroll
                for (int ks = 0; ks < 8; ++ks) ka[ks] = *(const LAS bf16x8*)(L + SC_KT + 32 * kb_ * TSTR + rt + 32 * ks);
                f32x16 pkv;
#pragma unroll
                for (int i = 0; i < 16; ++i) pkv[i] = 0.f;
#pragma unroll
                for (int ks = 0; ks < 8; ++ks) pkv = MFMA32(ka[ks], vb[ks], pkv);
                f32x16& Sx = ti == 0 ? S0 : S1;
#pragma unroll
                for (int gq = 0; gq < 4; ++gq) {
                    const int k = 32 * kb_ + 8 * gq + 4 * h;
                    const f32x4 eb = *(const LAS f32x4*)(L + SC_VEC + 512 + (32 * kb_ + 8 * gq) * 4 + h16), ebm = *(const LAS f32x4*)(L + SC_VEC + 1024 + (32 * kb_ + 8 * gq) * 4 + h16);
#pragma unroll
                    for (int e = 0; e < 4; ++e) Sx[4 * gq + e] = eb[e] * Sx[4 * gq + e] + ebm[e] * pkv[4 * gq + e];
                }
            }
        }
    }
    __syncthreads();
#undef ROWOF
#undef LOAD_CHUNK
}


template <class T> __device__ __forceinline__ T* opaque_ptr(T* p) { __attribute__((address_space(1))) T* gp = (__attribute__((address_space(1))) T*)p; asm volatile("" : "+s"(gp)); return (T*)gp; }
__device__ __forceinline__ unsigned opaque_zero() { unsigned z; asm volatile("s_mov_b32 %0, 0" : "=s"(z)); return z; }
__device__ __forceinline__ void gbar(unsigned* ctr, unsigned target) {
    asm volatile("s_waitcnt vmcnt(0)" ::: "memory");
    __syncthreads();
    if (threadIdx.x == 0) {
        __builtin_amdgcn_fence(__ATOMIC_RELEASE, "agent");
        asm volatile("s_waitcnt vmcnt(0)" ::: "memory");
        __hip_atomic_fetch_add(ctr, 1u, __ATOMIC_RELAXED, __HIP_MEMORY_SCOPE_AGENT);
        while (__hip_atomic_load(ctr, __ATOMIC_RELAXED, __HIP_MEMORY_SCOPE_AGENT) < target) __builtin_amdgcn_s_sleep(2);
        __builtin_amdgcn_fence(__ATOMIC_ACQUIRE, "agent");
        asm volatile("s_waitcnt vmcnt(0)" ::: "memory");
    }
    __syncthreads();
}

__global__ void __launch_bounds__(NTHREADS) hymba_fwd(Args A) {
    extern __shared__ __attribute__((aligned(16))) unsigned char lds_raw[];
    cg::grid_group grid = cg::this_grid();
    unsigned nbar = 0;
#define PH_BEGIN() const unsigned zs = opaque_zero(); LAS unsigned char* L = (LAS unsigned char*)lds_raw + zs; unsigned char* ws = opaque_ptr(A.ws); const int G = (int)(gridDim.x + zs), bid = (int)(blockIdx.x + zs); const float* xp = opaque_ptr(A.xp); const float* xs = opaque_ptr(A.xs); float* outp = opaque_ptr(A.out); (void)L; (void)ws; (void)G; (void)bid; (void)xp; (void)xs; (void)outp
#define GBAR() do { for (int rb_ = 0; rb_ < PROBE_BAR; ++rb_) { nbar += 256u; gbar((unsigned*)(A.ws + OFF_BAR + opaque_zero()), nbar); } } while (0)

    for (int rep = 0; rep < PROBE_P0; ++rep) { PH_BEGIN(); p0_convert(A); }
    grid.sync();

#pragma unroll 1
    for (int g = 0; g < NGRP; ++g) {
        { PH_BEGIN(); g0_prologue(xp, xs, ws, g); }
        GBAR();
#pragma unroll 1
        for (int l = 0; l < 2; ++l) {
            const size_t wlo = OFF_W + (size_t)l * SZ_LAYER;
            const size_t sq = OFF_SSQ + (size_t)(3 * l) * SSQ_SITE * 4;
            for (int rep = 0; rep < PROBE_FFNIN; ++rep) { PH_BEGIN(); pg8::Gemm gm{(const bf16_t*)(ws + OFF_XB), (const bf16_t*)(ws + wlo), MG, NFF, DM}; pg8::StaticOrder S; S.init(MG, NFF, G, bid);
              EpiFfnIn E{(bf16_t*)(ws + OFF_PH), (const float*)(ws + sq), g}; pg8::gemm_phase(L, gm, S, E); }
            GBAR();
            for (int rep = 0; rep < PROBE_FFNOUT_NULL; ++rep) { PH_BEGIN(); pg8::Gemm gm{(const bf16_t*)(ws + OFF_PH), (const bf16_t*)(ws + wlo + SZ_W1I), MG, DM, DFF}; pg8::StaticOrder S; S.init(MG, DM, G, bid); EpiNull E{(float*)(ws + OFF_RAW)}; pg8::gemm_phase(L, gm, S, E); }
            { PH_BEGIN(); pg8::Gemm gm{(const bf16_t*)(ws + OFF_PH), (const bf16_t*)(ws + wlo + SZ_W1I), MG, DM, DFF}; pg8::StaticOrder S; S.init(MG, DM, G, bid);
              EpiRes E{(bf16_t*)(ws + OFF_XB), (float*)(ws + sq) + SSQ_SITE, 0.5f, g}; pg8::gemm_phase(L, gm, S, E); }
            GBAR();
            for (int rep = 0; rep < PROBE_WIN; ++rep) { PH_BEGIN(); pg8::Gemm gm{(const bf16_t*)(ws + OFF_XB), (const bf16_t*)(ws + wlo + SZ_W1I + SZ_W1O), MG, NP_, DM}; pg8::StaticOrder S; S.init(MG, NP_, G, bid);
              const float* LBT = (const float*)(ws + OFF_LBT) + l * 2048;
              EpiWin E{(bf16_t*)(ws + OFF_PH), (const float*)(ws + sq) + SSQ_SITE, LBT, LBT + 1024, A.bg + l * 512, g}; pg8::gemm_phase(L, gm, S, E); }
            GBAR();
            for (int rep = 0; rep < PROBE_SCAN; ++rep) {
                f32x16 S0, S1;
#pragma unroll
                for (int i = 0; i < 16; ++i) { S0[i] = 0.f; S1[i] = 0.f; }
#pragma unroll 1
                for (int half = 0; half < 2; ++half) {
                    { PH_BEGIN();
                      const bf16_t* PH = (const bf16_t*)(ws + OFF_PH); float* RAW = (float*)(ws + OFF_RAW); bf16_t* OBF = (bf16_t*)(ws + OFF_OBF);
                      const int dir = bid & 1, hh = (bid >> 1) & 7, sidx = (bid >> 4) & 15;
                      const int T = sidx < 8 ? TPROMPT : TSAMPLE, seqbase = sidx < 8 ? sidx * TPROMPT : 16384 + (sidx - 8) * TSAMPLE, N = T / 128;
                      const int j0 = half ? N / 2 : 0, j1 = half ? N : N / 2;
                      if (hh < 4) { const int hd = hh;
                          scan_half<128>(L, PH, RAW, OBF, A.hgn + l * 512 + 128 * hd, seqbase, T, dir, 128 * hd, 0, (dir ? 1024 : 512) + 128 * hd, 1536 + 128 * hd, 2048 + 128 * hd, 128 * hd, j0, j1, half != 0, S0, S1);
                      } else { const int hd = hh - 4;
                          scan_half<64>(L, PH, RAW, OBF, A.glan + l * 512 + 128 * hd, seqbase, T, dir, 2560 + 64 * hd, 2816 + 64 * hd, (dir ? 3840 : 3584) + 64 * hd, 3072 + 128 * hd, 4096 + 128 * hd, 512 + 128 * hd, j0, j1, half != 0, S0, S1);
                      } }
                    GBAR();
                }
            }
            { PH_BEGIN(); pg8::Gemm gm{(const bf16_t*)(ws + OFF_OBF), (const bf16_t*)(ws + wlo + SZ_W1I + SZ_W1O + SZ_WIN), MG, DM, DM}; pg8::StaticOrder S; S.init(MG, DM, G, bid);
              EpiRes E{(bf16_t*)(ws + OFF_XB), (float*)(ws + sq) + 2 * SSQ_SITE, 1.0f, g}; pg8::gemm_phase(L, gm, S, E); }
            GBAR();
            for (int rep = 0; rep < PROBE_FFNIN; ++rep) { PH_BEGIN(); pg8::Gemm gm{(const bf16_t*)(ws + OFF_XB), (const bf16_t*)(ws + wlo + SZ_W1I + SZ_W1O + SZ_WIN + SZ_WO), MG, NFF, DM}; pg8::StaticOrder S; S.init(MG, NFF, G, bid);
              EpiFfnIn E{(bf16_t*)(ws + OFF_PH), (const float*)(ws + sq) + 2 * SSQ_SITE, g}; pg8::gemm_phase(L, gm, S, E); }
            GBAR();
            for (int rep = 0; rep < PROBE_FFNOUT_NULL; ++rep) { PH_BEGIN(); pg8::Gemm gm{(const bf16_t*)(ws + OFF_PH), (const bf16_t*)(ws + wlo + 2 * SZ_W1I + SZ_W1O + SZ_WIN + SZ_WO), MG, DM, DFF}; pg8::StaticOrder S; S.init(MG, DM, G, bid); EpiNull E{(float*)(ws + OFF_RAW)}; pg8::gemm_phase(L, gm, S, E); }
            { PH_BEGIN(); pg8::Gemm gm{(const bf16_t*)(ws + OFF_PH), (const bf16_t*)(ws + wlo + 2 * SZ_W1I + SZ_W1O + SZ_WIN + SZ_WO), MG, DM, DFF}; pg8::StaticOrder S; S.init(MG, DM, G, bid);
              EpiRes E{(bf16_t*)(ws + OFF_XB), (float*)(ws + sq) + 3 * SSQ_SITE, 0.5f, g}; pg8::gemm_phase(L, gm, S, E); }
            GBAR();
        }
        { PH_BEGIN(); final_norm(outp, opaque_ptr(A.nf), ws, g); }
    }
#undef PH_BEGIN
#undef GBAR
}

constexpr int LDS_BYTES = 146432;
extern "C" void kernel_launch(void* const* d_in, const int* in_sizes, int n_in, void* d_out, int out_size, void* d_ws, size_t ws_size, hipStream_t stream) {
    static int ready = 0;
    if (!ready) {
        if (n_in != 17 || out_size != MTOT * DM || ws_size < WS_END) { fprintf(stderr, "kernel_launch: unexpected shapes (n_in %d out %d ws %zu need %zu)\n", n_in, out_size, ws_size, (size_t)WS_END); ready = -1; return; }
        if (hipFuncSetAttribute((const void*)hymba_fwd, hipFuncAttributeMaxDynamicSharedMemorySize, LDS_BYTES) != hipSuccess) { fprintf(stderr, "kernel_launch: hipFuncSetAttribute failed\n"); ready = -1; return; }
        int per_cu = 0; (void)hipOccupancyMaxActiveBlocksPerMultiprocessor(&per_cu, (const void*)hymba_fwd, NTHREADS, LDS_BYTES); (void)hipGetLastError();
        ready = 1;
    }
    if (ready < 0) return;
    if (hipMemsetAsync((char*)d_ws + OFF_BAR, 0, 256, stream) != hipSuccess) { fprintf(stderr, "kernel_launch: memset failed\n"); return; }
    Args a{};
    a.xp = (const float*)d_in[0]; a.xs = (const float*)d_in[1]; a.lower_bounds = (const float*)d_in[2]; a.n1 = (const float*)d_in[3]; a.w1i = (const float*)d_in[4]; a.w1o = (const float*)d_in[5];
    a.nm = (const float*)d_in[6]; a.wi = (const float*)d_in[7]; a.wg = (const float*)d_in[8]; a.bg = (const float*)d_in[9]; a.hgn = (const float*)d_in[10]; a.glan = (const float*)d_in[11];
    a.wo = (const float*)d_in[12]; a.n2 = (const float*)d_in[13]; a.w2i = (const float*)d_in[14]; a.w2o = (const float*)d_in[15]; a.nf = (const float*)d_in[16];
    a.out = (float*)d_out; a.ws = (unsigned char*)d_ws;
    void* args[] = {&a};
    hipError_t e = hipLaunchCooperativeKernel((const void*)hymba_fwd, dim3(256), dim3(NTHREADS), args, LDS_BYTES, stream);
    if (e != hipSuccess) fprintf(stderr, "cooperative launch failed: %s\n", hipGetErrorString(e));
}
```

```cpp
#include <hip/hip_runtime.h>
#include <hip/hip_cooperative_groups.h>
#include <cstdio>
namespace cg = cooperative_groups;

#define LAS __attribute__((address_space(3)))
typedef unsigned short bf16_t;
typedef short bf16x8 __attribute__((ext_vector_type(8)));
typedef short s16x4 __attribute__((ext_vector_type(4)));
typedef float f32x2 __attribute__((ext_vector_type(2)));
typedef float f32x4 __attribute__((ext_vector_type(4)));
typedef float f32x16 __attribute__((ext_vector_type(16)));
typedef unsigned u32x2 __attribute__((ext_vector_type(2)));
typedef unsigned u32x4 __attribute__((ext_vector_type(4)));

constexpr int DM = 1024, DFF = 2816, NFF = 5632, DINSRC = 4128, NP_ = 4608;
constexpr int MTOT = 98304, MG = 49152, NGRP = 2;
constexpr int TPROMPT = 2048, TSAMPLE = 4096;
constexpr float EPS = 1e-6f;
constexpr int NTHREADS = 512;
#ifndef PROBE_SCAN
#define PROBE_SCAN 1
#endif
#ifndef PROBE_FFNIN
#define PROBE_FFNIN 1
#endif
#ifndef PROBE_P0
#define PROBE_P0 1
#endif
#ifndef PROBE_WIN
#define PROBE_WIN 1
#endif
#ifndef PROBE_FFNOUT_NULL
#define PROBE_FFNOUT_NULL 0
#endif
#ifndef PROBE_BAR
#define PROBE_BAR 1
#endif

constexpr size_t SZ_W1I = (size_t)NFF * DM * 2, SZ_W1O = (size_t)DM * DFF * 2, SZ_WIN = (size_t)NP_ * DM * 2, SZ_WO = (size_t)DM * DM * 2;
constexpr size_t SZ_LAYER = 2 * SZ_W1I + 2 * SZ_W1O + SZ_WIN + SZ_WO;
constexpr size_t OFF_W = 0;
constexpr size_t OFF_LBT = OFF_W + 2 * SZ_LAYER;
constexpr size_t OFF_SSQ = OFF_LBT + 2 * 2 * 1024 * 4;
constexpr size_t SSQ_SITE = (size_t)MTOT * 16;
constexpr size_t OFF_XB = OFF_SSQ + 7 * SSQ_SITE * 4;
constexpr size_t OFF_OBF = OFF_XB + (size_t)MG * DM * 2;
constexpr size_t OFF_RAW = OFF_OBF + (size_t)MG * DM * 2;
constexpr size_t OFF_PH = OFF_RAW + (size_t)MG * DM * 4;
constexpr size_t OFF_BAR = OFF_PH + (size_t)MG * NP_ * 2;
constexpr size_t WS_END = OFF_BAR + 256;

__device__ __forceinline__ unsigned pk2(float lo, float hi) {
    typedef __bf16 bf2 __attribute__((ext_vector_type(2)));
    f32x2 v = {lo, hi};
    return __builtin_bit_cast(unsigned, __builtin_convertvector(v, bf2));
}
__device__ __forceinline__ float bflo(unsigned u) { return __uint_as_float(u << 16); }
__device__ __forceinline__ float bfhi(unsigned u) { return __uint_as_float(u & 0xffff0000u); }
__device__ __forceinline__ int grow_tile(int g, int pm) { return pm < 64 ? g * 16384 + pm * 256 : 32768 + g * 32768 + (pm - 64) * 256; }
__device__ __forceinline__ int grow(int g, int r) { return r < 16384 ? g * 16384 + r : 32768 + g * 32768 + (r - 16384); }
__device__ __forceinline__ float sigmoid_f(float x) { return __builtin_amdgcn_rcpf(1.f + __builtin_amdgcn_exp2f(x * -1.44269504f)); }
__device__ __forceinline__ float log2sig_f(float z) { return fminf(z, 0.f) * 1.44269504f - __builtin_amdgcn_logf(1.f + __builtin_amdgcn_exp2f(fabsf(z) * -1.44269504f)); }

__device__ __forceinline__ float bperm(float x, int byte_idx) { return __int_as_float(__builtin_amdgcn_ds_bpermute(byte_idx, __float_as_int(x))); }
__device__ __forceinline__ float row_rstd(const float* ssq16, int R, int fq, int i16, int i32) {
    const f32x4 v = *(const f32x4*)(ssq16 + (size_t)R * 16 + 4 * fq);
    float s = (v[0] + v[1]) + (v[2] + v[3]);
    s += bperm(s, i16); s += bperm(s, i32);
    return rsqrtf(s * (1.f / 1024.f) + EPS);
}

__device__ __forceinline__ void rows_rstd8(float (&rs)[8], const float* ssq16, int Rbase  , int fq, int i16, int i32) {
    f32x4 v[8];
#pragma unroll
    for (int q = 0; q < 8; ++q) v[q] = *(const f32x4*)(ssq16 + (size_t)(Rbase + (q >> 2) * 128 + (q & 3) * 16) * 16 + 4 * fq);
#pragma unroll
    for (int q = 0; q < 8; ++q) { float s = (v[q][0] + v[q][1]) + (v[q][2] + v[q][3]); s += bperm(s, i16); s += bperm(s, i32); rs[q] = __builtin_amdgcn_rsqf(s * (1.f / 1024.f) + EPS); }
}

namespace pg8 {
constexpr int BM = 256, BK = 64, HALF = 128, HTB = HALF * BK * 2, STAGE_BYTES = 8 * HTB, NXCD = 8, WGM = 8;
__device__ __forceinline__ int lds_byte(int r, int c) { const int st = (r >> 4) * 2 + (c >> 5), rr = r & 15, cc = c & 31, ob = rr * 64 + cc * 2; return st * 1024 + (ob ^ (((ob >> 9) & 1) << 5)); }
__device__ __forceinline__ void stage_rc(int b, int& R, int& C) { const int st = b / 1024, sb = b % 1024, swz = sb ^ (((sb >> 9) & 1) << 5); R = (st >> 1) * 16 + swz / 64; C = (st & 1) * 32 + (swz % 64) / 2; }
__device__ __forceinline__ int perm32(int rho) { const int n = rho >> 4, i = rho & 15; return 8 * (i >> 2) + 4 * n + (i & 3); }
struct Unit { int pm, pn; };
struct Gemm { const bf16_t* A; const bf16_t* Bt; int M, N, K; };
struct StaticOrder {
    int nM, nN, nwg, G, c;
    __device__ void init(int M, int N, int G_, int c_) { nM = M / BM; nN = N / BM; nwg = nM * nN; G = G_; c = c_; }
    __device__ bool next(int i, Unit& u) const {
        const long L = (long)i * G + c; if (L >= nwg) return false;
        int wgid = (int)L; { const int q = nwg / NXCD, r = nwg % NXCD, xcd = wgid % NXCD, off = wgid / NXCD; wgid = (xcd < r ? xcd * (q + 1) : r * (q + 1) + (xcd - r) * q) + off; }
        const int nig = WGM * nN, gid = wgid / nig, fm = gid * WGM, gsz = (nM - fm) < WGM ? (nM - fm) : WGM;
        u.pm = fm + ((wgid % nig) % gsz); u.pn = (wgid % nig) / gsz; return true;
    }
};

template <class Epi>
__device__ __forceinline__ void gemm_phase(LAS unsigned char* lds, const Gemm g, const StaticOrder& S, const Epi& E) {
    int tid_ = threadIdx.x; asm volatile("" : "+v"(tid_));
    const int tid = tid_, wid = __builtin_amdgcn_readfirstlane(tid >> 6), lane = tid & 63, wr = wid >> 2, wc = wid & 3, fr = lane & 15, fq = lane >> 4;
    const int K = g.K, nt = K / BK;
    unsigned voffA[2], voffB[2];
#pragma unroll
    for (int i = 0; i < 2; ++i) { int R, C; stage_rc(tid * 16 + i * 8192, R, C); const int Rb = Epi::PERM ? ((R & ~31) + perm32(R & 31)) : R;
        voffA[i] = (unsigned)(R * K + C) * 2u; voffB[i] = (unsigned)(Rb * K + C) * 2u; }
    const size_t kstep = (size_t)(BK * 2);
    const size_t hstep = (size_t)HALF * K * 2;
    const size_t tstep = 2 * hstep;
    const unsigned ldsw = (unsigned)wid * 1024u;
    const int aoff = lds_byte(wr * 64 + fr, fq * 8), boff = lds_byte(wc * 32 + fr, fq * 8);
#define PG8_SA(b, h) (((b) * 2 + (h)) * HTB)
#define PG8_SB(b, h) ((4 + (b) * 2 + (h)) * HTB)
#define PG8_STAGE(bufoff, gbase, voff) do { _Pragma("unroll") for (int _i = 0; _i < 2; ++_i) \
        __builtin_amdgcn_global_load_lds((const unsigned*)((const char*)(gbase) + (voff)[_i]), (LAS unsigned*)(lds + (bufoff) + ldsw + _i * 8192), 16, 0, 0); } while (0)
#define PG8_LDA(dst, b, h) do { _Pragma("unroll") for (int m = 0; m < 4; ++m) _Pragma("unroll") for (int k = 0; k < 2; ++k) dst[m][k] = *(const LAS bf16x8*)(lds + PG8_SA(b, h) + aoff + m * 2048 + k * 1024); } while (0)
#define PG8_LDB(dst, b, h) do { _Pragma("unroll") for (int n = 0; n < 2; ++n) _Pragma("unroll") for (int k = 0; k < 2; ++k) dst[n][k] = *(const LAS bf16x8*)(lds + PG8_SB(b, h) + boff + n * 2048 + k * 1024); } while (0)
#define PG8_MMA(ai, bj, At, Bt) do { __builtin_amdgcn_s_setprio(1); _Pragma("unroll") for (int m = 0; m < 4; ++m) _Pragma("unroll") for (int n = 0; n < 2; ++n) _Pragma("unroll") for (int k = 0; k < 2; ++k) \
        acc[ai][bj][m][n] = __builtin_amdgcn_mfma_f32_16x16x32_bf16(Bt[n][k], At[m][k], acc[ai][bj][m][n], 0, 0, 0); __builtin_amdgcn_s_setprio(0); } while (0)
#define PG8_WAIT_V(n) asm volatile("s_waitcnt vmcnt(" #n ")" ::: "memory")
#define PG8_WAIT_L(n) asm volatile("s_waitcnt lgkmcnt(" #n ")" ::: "memory")
#define PG8_BAR __builtin_amdgcn_s_barrier()
#define PG8_SCHED __builtin_amdgcn_sched_barrier(0)
    Unit cur, nxt; int ui = 0;
    if (!S.next(0, cur)) return;
    f32x4 acc[2][2][4][2];
#pragma unroll
    for (int a = 0; a < 2; ++a)
#pragma unroll
        for (int b = 0; b < 2; ++b)
#pragma unroll
            for (int m = 0; m < 4; ++m)
#pragma unroll
                for (int n = 0; n < 2; ++n) acc[a][b][m][n] = (f32x4){0.f, 0.f, 0.f, 0.f};
    bf16x8 At[4][2], B0[2][2], B1[2][2];
    const char* cA = (const char*)g.A + (size_t)cur.pm * tstep; const char* cB = (const char*)g.Bt + (size_t)cur.pn * tstep;
    PG8_STAGE(PG8_SB(0, 0), cB, voffB); PG8_STAGE(PG8_SA(0, 0), cA, voffA); PG8_STAGE(PG8_SB(0, 1), cB + hstep, voffB); PG8_STAGE(PG8_SA(0, 1), cA + hstep, voffA);
    if (wr == 1) PG8_BAR;
    PG8_WAIT_V(4); PG8_BAR;
    PG8_STAGE(PG8_SB(1, 0), cB + kstep, voffB); PG8_STAGE(PG8_SA(1, 0), cA + kstep, voffA); PG8_STAGE(PG8_SB(1, 1), cB + hstep + kstep, voffB);
    PG8_WAIT_V(6); PG8_BAR;
    for (;;) {
        const bool has_next = S.next(ui + 1, nxt);
        const char* nA = has_next ? (const char*)g.A + (size_t)nxt.pm * tstep : cA; const char* nB = has_next ? (const char*)g.Bt + (size_t)nxt.pn * tstep : cB;
        for (int t = 0; t < nt; t += 2) {
            const bool last = (t == nt - 2);
            const char* a1 = cA + (size_t)(t + 1) * kstep;
            const char* a2 = last ? nA : cA + (size_t)(t + 2) * kstep; const char* b2 = last ? nB : cB + (size_t)(t + 2) * kstep;
            const char* a3 = a2 + kstep; const char* b3 = b2 + kstep;
            PG8_LDB(B0, 0, 0); PG8_SCHED; PG8_LDA(At, 0, 0); PG8_STAGE(PG8_SA(1, 1), a1 + hstep, voffA);
            PG8_WAIT_L(8); PG8_BAR; PG8_WAIT_L(0); PG8_MMA(0, 0, At, B0); PG8_BAR; PG8_SCHED;
            PG8_LDB(B1, 0, 1); PG8_STAGE(PG8_SB(0, 0), b2, voffB);
            PG8_BAR; PG8_WAIT_L(0); PG8_MMA(0, 1, At, B1); PG8_BAR;
            PG8_LDA(At, 0, 1); PG8_STAGE(PG8_SA(0, 0), a2, voffA);
            PG8_BAR; PG8_WAIT_L(0); PG8_MMA(1, 0, At, B0); PG8_BAR; PG8_SCHED;
            PG8_STAGE(PG8_SB(0, 1), b2 + hstep, voffB);
            PG8_WAIT_V(6); PG8_BAR; PG8_MMA(1, 1, At, B1); PG8_BAR;
            PG8_LDB(B0, 1, 0); PG8_SCHED; PG8_LDA(At, 1, 0); PG8_STAGE(PG8_SA(0, 1), a2 + hstep, voffA);
            PG8_WAIT_L(8); PG8_BAR; PG8_WAIT_L(0); PG8_MMA(0, 0, At, B0); PG8_BAR; PG8_SCHED;
            PG8_LDB(B1, 1, 1); PG8_STAGE(PG8_SB(1, 0), b3, voffB);
            PG8_BAR; PG8_WAIT_L(0); PG8_MMA(0, 1, At, B1); PG8_BAR;
            PG8_LDA(At, 1, 1); PG8_STAGE(PG8_SA(1, 0), a3, voffA);
            PG8_BAR; PG8_WAIT_L(0); PG8_MMA(1, 0, At, B0); PG8_BAR; PG8_SCHED;
            PG8_STAGE(PG8_SB(1, 1), b3 + hstep, voffB);
            PG8_WAIT_V(6); PG8_BAR; PG8_MMA(1, 1, At, B1); PG8_BAR;
        }
        E(acc, cur, wr, wc, fr, fq);
        if (!has_next) break;
#pragma unroll
        for (int a = 0; a < 2; ++a)
#pragma unroll
            for (int b = 0; b < 2; ++b)
#pragma unroll
                for (int m = 0; m < 4; ++m)
#pragma unroll
                    for (int n = 0; n < 2; ++n) acc[a][b][m][n] = (f32x4){0.f, 0.f, 0.f, 0.f};
        cur = nxt; cA = nA; cB = nB; ++ui;
    }
    PG8_WAIT_V(0);
    if (wr == 0) PG8_BAR;
    PG8_BAR;
#undef PG8_SA
#undef PG8_SB
#undef PG8_STAGE
#undef PG8_LDA
#undef PG8_LDB
#undef PG8_MMA
#undef PG8_WAIT_V
#undef PG8_WAIT_L
#undef PG8_BAR
#undef PG8_SCHED
}
}

struct EpiFfnIn {
    static constexpr bool PERM = true;
    bf16_t* H; const float* ssq; int g;
    __device__ __forceinline__ void operator()(const f32x4 (&acc)[2][2][4][2], const pg8::Unit& u, int wr, int wc, int fr_in, int fq) const {
        int fr = fr_in; asm volatile("" : "+v"(fr));
        const int lane_ = fr | (fq << 4), i16 = (lane_ ^ 16) << 2, i32 = (lane_ ^ 32) << 2; (void)i16; (void)i32;
        const int R0 = grow_tile(g, u.pm);
        const int col0 = u.pn * 128 + wc * 32 + 8 * fq;
        float rs8[8]; rows_rstd8(rs8, ssq, R0 + wr * 64 + fr, fq, i16, i32);
#pragma unroll
        for (int ai = 0; ai < 2; ++ai)
#pragma unroll
            for (int m = 0; m < 4; ++m) {
                const int rt = ai * 128 + wr * 64 + m * 16 + fr;
                const float rs = rs8[ai * 4 + m];
                float hv[8];
                const float nrs = rs * -1.44269504f;
#pragma unroll
                for (int n = 0; n < 2; ++n)
#pragma unroll
                    for (int jp = 0; jp < 2; ++jp) {
                        const f32x2 ra = {acc[ai][0][m][n][2 * jp], acc[ai][0][m][n][2 * jp + 1]}, rb = {acc[ai][1][m][n][2 * jp], acc[ai][1][m][n][2 * jp + 1]};
                        f32x2 na = ra * nrs; na.x = fminf(na.x, 60.f); na.y = fminf(na.y, 60.f);
                        f32x2 d; d.x = __builtin_amdgcn_exp2f(na.x); d.y = __builtin_amdgcn_exp2f(na.y); d = d + 1.0f;
                        const float rinv = __builtin_amdgcn_rcpf(d.x * d.y);
                        const f32x2 ab = (ra * rs) * (rb * rs);
                        const f32x2 sg = {rinv * d.y, rinv * d.x};
                        const f32x2 hh = ab * sg;
                        hv[n * 4 + 2 * jp] = hh.x; hv[n * 4 + 2 * jp + 1] = hh.y;
                    }
                u32x4 w; w.x = pk2(hv[0], hv[1]); w.y = pk2(hv[2], hv[3]); w.z = pk2(hv[4], hv[5]); w.w = pk2(hv[6], hv[7]);
                *(u32x4*)(H + (size_t)(u.pm * 256 + rt) * DFF + col0) = w;
            }
    }
};
struct EpiNull { static constexpr bool PERM = true; float* sink; __device__ __forceinline__ void operator()(const f32x4 (&acc)[2][2][4][2], const pg8::Unit& u, int wr, int wc, int fr, int fq) const {
    float s = 0.f;
#pragma unroll
    for (int a = 0; a < 2; ++a)
#pragma unroll
        for (int b = 0; b < 2; ++b)
#pragma unroll
            for (int m = 0; m < 4; ++m)
#pragma unroll
                for (int n = 0; n < 2; ++n) s += (acc[a][b][m][n][0] + acc[a][b][m][n][1]) + (acc[a][b][m][n][2] + acc[a][b][m][n][3]);
    if (s == 123.456f) sink[0] = 1.f; } };
struct EpiRes {
    static constexpr bool PERM = true;
    bf16_t* XB; float* ssq; float scale; int g;
    __device__ __forceinline__ void operator()(const f32x4 (&acc)[2][2][4][2], const pg8::Unit& u, int wr, int wc, int fr_in, int fq) const {
        int fr = fr_in; asm volatile("" : "+v"(fr));
        const int lane_ = fr | (fq << 4), i16 = (lane_ ^ 16) << 2, i32 = (lane_ ^ 32) << 2; (void)i16; (void)i32;
        const int R0 = grow_tile(g, u.pm);
#pragma unroll
        for (int ai = 0; ai < 2; ++ai) {
            u32x4 old[4][2];
#pragma unroll
            for (int m = 0; m < 4; ++m)
#pragma unroll
                for (int bj = 0; bj < 2; ++bj)
                    old[m][bj] = *(const u32x4*)(XB + (size_t)(u.pm * 256 + ai * 128 + wr * 64 + m * 16 + fr) * DM + u.pn * 256 + bj * 128 + wc * 32 + 8 * fq);
#pragma unroll
            for (int m = 0; m < 4; ++m) {
                const int rt = ai * 128 + wr * 64 + m * 16 + fr;
                bf16_t* xb = XB + (size_t)(u.pm * 256 + rt) * DM;
                float part = 0.f;
#pragma unroll
                for (int bj = 0; bj < 2; ++bj) {
                    const int c0 = u.pn * 256 + bj * 128 + wc * 32 + 8 * fq;
                    const u32x4 o = old[m][bj];
                    const f32x4 a0 = acc[ai][bj][m][0], a1 = acc[ai][bj][m][1];
                    float n[8];
                    n[0] = bflo(o.x) + a0[0] * scale; n[1] = bfhi(o.x) + a0[1] * scale; n[2] = bflo(o.y) + a0[2] * scale; n[3] = bfhi(o.y) + a0[3] * scale;
                    n[4] = bflo(o.z) + a1[0] * scale; n[5] = bfhi(o.z) + a1[1] * scale; n[6] = bflo(o.w) + a1[2] * scale; n[7] = bfhi(o.w) + a1[3] * scale;
                    u32x4 w; w.x = pk2(n[0], n[1]); w.y = pk2(n[2], n[3]); w.z = pk2(n[4], n[5]); w.w = pk2(n[6], n[7]);
                    *(u32x4*)(xb + c0) = w;
                    part += (n[0] * n[0] + n[1] * n[1]) + (n[2] * n[2] + n[3] * n[3]) + (n[4] * n[4] + n[5] * n[5]) + (n[6] * n[6] + n[7] * n[7]);
                }
                part += bperm(part, i16); part += bperm(part, i32);
                if (fq == 0) ssq[(size_t)(R0 + rt) * 16 + u.pn * 4 + wc] = part;
            }
            asm volatile("" ::: "memory");
        }
    }
};
struct EpiWin {
    static constexpr bool PERM = true;
    bf16_t* P; const float* ssq; const float* lbA; const float* lbB; const float* bg; int g;
    __device__ __forceinline__ void operator()(const f32x4 (&acc)[2][2][4][2], const pg8::Unit& u, int wr, int wc, int fr_in, int fq) const {
        int fr = fr_in; asm volatile("" : "+v"(fr));
        const int lane_ = fr | (fq << 4), i16 = (lane_ ^ 16) << 2, i32 = (lane_ ^ 32) << 2; (void)i16; (void)i32;
        const int R0 = grow_tile(g, u.pm);
        const int pn = u.pn;
        const int mode = (pn >= 2 && pn <= 5) ? 1 : (pn == 8 || pn == 9) ? 2 : (pn == 14 || pn == 15) ? 4 : (pn >= 16) ? 5 : 0;
        float rs8[8]; rows_rstd8(rs8, ssq, R0 + wr * 64 + fr, fq, i16, i32);
#pragma unroll
        for (int bj = 0; bj < 2; ++bj) {
            const int cin = bj * 128 + wc * 32 + 8 * fq;
            float ca[8], cb[8];
            if (mode == 1) { const int lc = 256 * (pn - 2) + cin;
#pragma unroll
                for (int j = 0; j < 8; ++j) { ca[j] = lbA[lc + j]; cb[j] = lbB[lc + j]; } }
            else if (mode == 4) { const int lc = 256 * (pn - 14) + cin;
#pragma unroll
                for (int j = 0; j < 8; ++j) { ca[j] = bg[lc + j]; cb[j] = 0.f; } }
            else {
#pragma unroll
                for (int j = 0; j < 8; ++j) { ca[j] = 0.f; cb[j] = 0.f; } }
#pragma unroll
            for (int ai = 0; ai < 2; ++ai)
#pragma unroll
                for (int m = 0; m < 4; ++m) {
                    const int rt = ai * 128 + wr * 64 + m * 16 + fr;
                    const float rs = rs8[ai * 4 + m];
                    float v[8];
#pragma unroll
                    for (int n = 0; n < 2; ++n)
#pragma unroll
                        for (int j = 0; j < 4; ++j) v[n * 4 + j] = acc[ai][bj][m][n][j] * rs;
                    if (mode == 1) {
#pragma unroll
                        for (int j = 0; j < 8; ++j) v[j] = __builtin_amdgcn_logf(ca[j] + cb[j] * sigmoid_f(v[j]));
                    } else if (mode == 2) {
#pragma unroll
                        for (int j = 0; j < 8; ++j) v[j] = sigmoid_f(v[j]);
                    } else if (mode == 4) {
#pragma unroll
                        for (int j = 0; j < 8; ++j) v[j] = log2sig_f(v[j] + ca[j]) * (1.f / 16.f);
                    } else if (mode == 5) {
#pragma unroll
                        for (int j = 0; j < 8; ++j) v[j] = v[j] * sigmoid_f(v[j]);
                    }
                    u32x4 w; w.x = pk2(v[0], v[1]); w.y = pk2(v[2], v[3]); w.z = pk2(v[4], v[5]); w.w = pk2(v[6], v[7]);
                    *(u32x4*)(P + (size_t)(u.pm * 256 + rt) * NP_ + pn * 256 + cin) = w;
                }
        }
    }
};

struct Args {
    const float* xp; const float* xs; const float* lower_bounds; const float* n1; const float* w1i; const float* w1o; const float* nm; const float* wi;
    const float* wg; const float* bg; const float* hgn; const float* glan; const float* wo; const float* n2; const float* w2i; const float* w2o; const float* nf;
    float* out; unsigned char* ws;
};

__device__ __forceinline__ void p0_convert(const Args& A) {
    const long nth = (long)gridDim.x * NTHREADS, gt = (long)blockIdx.x * NTHREADS + threadIdx.x;
    unsigned char* ws = A.ws;
    const long cnt[6] = {(long)NFF * 128, (long)DM * 352, (long)NP_ * 128, (long)DM * 128, (long)NFF * 128, (long)DM * 352};
    const long per_layer = cnt[0] + cnt[1] + cnt[2] + cnt[3] + cnt[4] + cnt[5];
    for (long it = gt; it < 2 * per_layer; it += nth) {
        const int l = it >= per_layer ? 1 : 0; long i = it - (long)l * per_layer;
        int job = 0;
#pragma unroll
        for (int j = 0; j < 5; ++j) if (job == j && i >= cnt[j]) { i -= cnt[j]; job = j + 1; }
        unsigned char* wl = ws + OFF_W + (size_t)l * SZ_LAYER;
        float v[8];
        bf16_t* dst;
        if (job == 0 || job == 4) {
            const int np = (int)(i % NFF), k0 = (int)(i / NFF) * 8;
            const float* W = (job == 0 ? A.w1i : A.w2i) + (size_t)l * DM * NFF; const float* gn = (job == 0 ? A.n1 : A.n2) + l * DM;
            const int n = ((np & 128) ? DFF : 0) + (np >> 8) * 128 + (np & 127);
#pragma unroll
            for (int e = 0; e < 8; ++e) v[e] = W[(size_t)(k0 + e) * NFF + n] * gn[k0 + e];
            dst = (bf16_t*)(wl + (job == 0 ? 0 : SZ_W1I + SZ_W1O + SZ_WIN + SZ_WO)) + (size_t)np * DM + k0;
        } else if (job == 1 || job == 5) {
            const int np = (int)(i % DM), k0 = (int)(i / DM) * 8;
            const float* W = (job == 1 ? A.w1o : A.w2o) + (size_t)l * DFF * DM;
#pragma unroll
            for (int e = 0; e < 8; ++e) v[e] = W[(size_t)(k0 + e) * DM + np];
            dst = (bf16_t*)(wl + (job == 1 ? SZ_W1I : 2 * SZ_W1I + SZ_W1O + SZ_WIN + SZ_WO)) + (size_t)np * DFF + k0;
        } else if (job == 3) {
            const int np = (int)(i % DM), k0 = (int)(i / DM) * 8;
            const float* W = A.wo + (size_t)l * DM * DM;
#pragma unroll
            for (int e = 0; e < 8; ++e) v[e] = W[(size_t)(k0 + e) * DM + np];
            dst = (bf16_t*)(wl + SZ_W1I + SZ_W1O + SZ_WIN) + (size_t)np * DM + k0;
        } else {
            const int np = (int)(i % NP_), k0 = (int)(i / NP_) * 8;
            const float* W = A.wi + (size_t)l * DM * DINSRC; const float* gn = A.nm + l * DM;
            if (np >= 3584 && np < 4096) {
                const int d = np >= 3840 ? 1 : 0, c = np - 3584 - 256 * d;
                const float* G = A.wg + ((size_t)l * 2 + d) * 16 * 256;
                float gc[16];
#pragma unroll
                for (int r = 0; r < 16; ++r) gc[r] = G[r * 256 + c];
#pragma unroll
                for (int e = 0; e < 8; ++e) { const float* wr_ = W + (size_t)(k0 + e) * DINSRC + 3584 + 16 * d; float s = 0.f;
#pragma unroll
                    for (int r = 0; r < 16; ++r) s += wr_[r] * gc[r];
                    v[e] = s * gn[k0 + e]; }
            } else {
                const int n = np < 3584 ? np : 3616 + (np - 4096);
                const float sc = (np >= 2560 && np < 2816) ? 0.125f : 1.f;
#pragma unroll
                for (int e = 0; e < 8; ++e) v[e] = W[(size_t)(k0 + e) * DINSRC + n] * gn[k0 + e] * sc;
            }
            dst = (bf16_t*)(wl + SZ_W1I + SZ_W1O) + (size_t)np * DM + k0;
        }
        u32x4 w; w.x = pk2(v[0], v[1]); w.y = pk2(v[2], v[3]); w.z = pk2(v[4], v[5]); w.w = pk2(v[6], v[7]);
        *(u32x4*)dst = w;
    }
    float* lbt = (float*)(ws + OFF_LBT);
    for (long i = gt; i < 2048; i += nth) {
        const int l = (int)(i >> 10), c = (int)(i & 1023);
        const float a = A.lower_bounds[c], b = A.lower_bounds[1024 + c], mx = fmaxf(a, b);
        const float ea = __expf(a - mx), eb = __expf(b - mx);
        const float lb = l == 0 ? 0.f : eb / (ea + eb);
        lbt[l * 2048 + c] = fmaxf(lb, 1e-30f);
        lbt[l * 2048 + 1024 + c] = 1.f - lb;
    }
}

__device__ __forceinline__ void g0_prologue(const float* xp, const float* xs, unsigned char* ws, int g) {
    int tid_ = threadIdx.x; asm volatile("" : "+v"(tid_));
    const int lane = tid_ & 63, wv = blockIdx.x * 8 + (tid_ >> 6), nwv = gridDim.x * 8;
    bf16_t* XB = (bf16_t*)(ws + OFF_XB); float* ssq = (float*)(ws + OFF_SSQ);
    for (int r = wv; r < MG; r += nwv) {
        const int R = grow(g, r);
        const float* x = R < 32768 ? xp + (size_t)R * DM : xs + (size_t)(R - 32768) * DM;
        float s = 0.f;
#pragma unroll
        for (int i = 0; i < 4; ++i) { const f32x4 v = *(const f32x4*)(x + i * 256 + lane * 4);
            s += (v[0] * v[0] + v[1] * v[1]) + (v[2] * v[2] + v[3] * v[3]);
            u32x2 w; w.x = pk2(v[0], v[1]); w.y = pk2(v[2], v[3]); *(u32x2*)(XB + (size_t)r * DM + i * 256 + lane * 4) = w; }
#pragma unroll
        for (int o = 32; o >= 1; o >>= 1) s += bperm(s, (lane ^ o) << 2);
        if (lane < 4) *(f32x4*)(ssq + (size_t)R * 16 + 4 * lane) = (f32x4){lane == 0 ? s : 0.f, 0.f, 0.f, 0.f};
    }
}
__device__ __forceinline__ void final_norm(float* outp, const float* nf, unsigned char* ws, int g) {
    int tid_ = threadIdx.x; asm volatile("" : "+v"(tid_));
    const int lane = tid_ & 63, wv = blockIdx.x * 8 + (tid_ >> 6), nwv = gridDim.x * 8;
    const float* ssq = (const float*)(ws + OFF_SSQ) + 6 * SSQ_SITE; const bf16_t* XB = (const bf16_t*)(ws + OFF_XB);
    for (int r = wv; r < MG; r += nwv) {
        const int R = grow(g, r);
        float* x = outp + (size_t)R * DM;
        const f32x4 q0 = *(const f32x4*)(ssq + (size_t)R * 16), q1 = *(const f32x4*)(ssq + (size_t)R * 16 + 4), q2 = *(const f32x4*)(ssq + (size_t)R * 16 + 8), q3 = *(const f32x4*)(ssq + (size_t)R * 16 + 12);
        const float rs = rsqrtf((((q0[0] + q0[1]) + (q0[2] + q0[3])) + ((q1[0] + q1[1]) + (q1[2] + q1[3])) + (((q2[0] + q2[1]) + (q2[2] + q2[3])) + ((q3[0] + q3[1]) + (q3[2] + q3[3])))) * (1.f / 1024.f) + EPS);
#pragma unroll
        for (int i = 0; i < 4; ++i) { const int c = i * 256 + lane * 4; const u32x2 xv = *(const u32x2*)(XB + (size_t)r * DM + c); const f32x4 gn = *(const f32x4*)(nf + c);
            f32x4 v = {bflo(xv.x) * rs * gn[0], bfhi(xv.x) * rs * gn[1], bflo(xv.y) * rs * gn[2], bfhi(xv.y) * rs * gn[3]}; *(f32x4*)(x + c) = v; }
    }
}

#define MFMA32(a, b, c) __builtin_amdgcn_mfma_f32_32x32x16_bf16((a), (b), (c), 0, 0, 0)
constexpr int SC_QT = 0, SC_KT = 34816, SC_VT = 69632, SC_ST = 104448, SC_TOT = 139264, SC_VEC = 143360, SC_RED = 144896, SC_END = 145920;
constexpr int TSTR = 272;

template <int DK>
__device__ __forceinline__ void scan_half(LAS unsigned char* L, const bf16_t* __restrict__ P, bf16_t* RAW, bf16_t* OBF, const float* __restrict__ gain,
                                          int seqbase, int T, int dir, int qcol, int kcol, int gcol, int vcol, int gatecol, int ocol,
                                          int j0, int j1, bool second, f32x16& S0, f32x16& S1) {
    constexpr bool GLA = (DK == 64);
    constexpr int NPAIR = DK / 2, NSEG = NTHREADS / NPAIR, SL = 128 / NSEG, QSTR = (DK + 8) * 2, NKS = DK / 16;
    int tid_ = threadIdx.x; asm volatile("" : "+v"(tid_));
    const int tid = tid_, lane = tid & 63, w = __builtin_amdgcn_readfirstlane(tid >> 6);
    const int r = lane & 31, h = lane >> 5;
    const int cp = tid % NPAIR, seg = tid / NPAIR, vp = tid & 63, vseg = tid >> 6;
    const int tb = w >> 1, dh = w & 1, dvb_s = w & 3, kq = w >> 2;
    unsigned g2[SL], q2[SL], k2[SL], v2[16];

#define ROWOF(j, i) (seqbase + (dir ? (T - 1 - ((j) * 128 + (i))) : ((j) * 128 + (i))))
    const char* Pg = (const char*)P + gcol * 2; const char* Pq = (const char*)P + qcol * 2; const char* Pk = (const char*)P + kcol * 2; const char* Pv = (const char*)P + vcol * 2;
    const int rstep = dir ? -(NP_ * 2) : (NP_ * 2);
#define LOAD_CHUNK(j) do { int jj_ = (j); asm volatile("" : "+s"(jj_)); \
        { const int p0_ = jj_ * 128 + seg * SL; const int off0_ = (seqbase + (dir ? (T - 1 - p0_) : p0_)) * (NP_ * 2) + 4 * cp; \
          _Pragma("unroll") for (int i_ = 0; i_ < SL; ++i_) { const unsigned o_ = (unsigned)(off0_ + i_ * rstep); \
            g2[i_] = *(const unsigned*)(Pg + o_); q2[i_] = *(const unsigned*)(Pq + o_); if (GLA) k2[i_] = *(const unsigned*)(Pk + o_); else k2[i_] = 0u; } } \
        { const int p0_ = jj_ * 128 + vseg * 16; const int off0_ = (seqbase + (dir ? (T - 1 - p0_) : p0_)) * (NP_ * 2) + 4 * vp; \
          _Pragma("unroll") for (int i_ = 0; i_ < 16; ++i_) { const unsigned o_ = (unsigned)(off0_ + i_ * rstep); v2[i_] = *(const unsigned*)(Pv + o_); } } \
    } while (0)

    LOAD_CHUNK(j0);
    for (int j = j0; j < j1; ++j) {
        int rq = r * QSTR + 16 * h, rt = r * TSTR + 16 * h, rq8 = r * QSTR + 8 * h, rt8 = r * TSTR + 8 * h, h16 = 16 * h;
        asm volatile("" : "+v"(rq), "+v"(rt), "+v"(rq8), "+v"(rt8), "+v"(h16));
        f32x2 cs[SL];
        { f32x2 run = {0.f, 0.f};
#pragma unroll
          for (int i = 0; i < SL; ++i) { run = run + (f32x2){bflo(g2[i]), bfhi(g2[i])}; cs[i] = run; }
          *(LAS f32x2*)(L + SC_TOT + (seg * DK + 2 * cp) * 4) = run; }
        __syncthreads();
        f32x2 off = {0.f, 0.f}, mm = {0.f, 0.f}, bl = {0.f, 0.f};
#pragma unroll
        for (int s = 0; s < NSEG; ++s) { const f32x2 t = *(const LAS f32x2*)(L + SC_TOT + (s * DK + 2 * cp) * 4);
            if (s < seg) off = off + t;
            if (s < NSEG / 2) mm = mm + t;
            bl = bl + t; }
        unsigned kk[SL];
        const f32x2 dd = off - mm;
#pragma unroll
        for (int i = 0; i < SL; ++i) {
            f32x2 ee = cs[i] + dd;
            ee.x = __builtin_amdgcn_fmed3f(ee.x, -115.f, 115.f); ee.y = __builtin_amdgcn_fmed3f(ee.y, -115.f, 115.f);
            const f32x2 xx = {__builtin_amdgcn_exp2f(ee.x), __builtin_amdgcn_exp2f(ee.y)}, yy = {__builtin_amdgcn_exp2f(-ee.x), __builtin_amdgcn_exp2f(-ee.y)};
            f32x2 kv;
            if (GLA) kv = (f32x2){bflo(k2[i]), bfhi(k2[i])};
            else kv = (f32x2){1.f, 1.f} - (f32x2){__builtin_amdgcn_exp2f(bflo(g2[i])), __builtin_amdgcn_exp2f(bfhi(g2[i]))};
            const f32x2 qv = (f32x2){bflo(q2[i]), bfhi(q2[i])} * xx, kw = kv * yy;
            const unsigned qq = pk2(qv.x, qv.y);
            kk[i] = pk2(kw.x, kw.y);
            *(LAS unsigned*)(L + SC_QT + (seg * SL + i) * QSTR + 4 * cp) = qq;
            *(LAS unsigned*)(L + SC_KT + (seg * SL + i) * QSTR + 4 * cp) = kk[i];
        }
        {
            u32x4 a0, a1, b0, b1;
            a0.x = (v2[0] & 0xffffu) | (v2[1] << 16); a0.y = (v2[2] & 0xffffu) | (v2[3] << 16); a0.z = (v2[4] & 0xffffu) | (v2[5] << 16); a0.w = (v2[6] & 0xffffu) | (v2[7] << 16);
            a1.x = (v2[8] & 0xffffu) | (v2[9] << 16); a1.y = (v2[10] & 0xffffu) | (v2[11] << 16); a1.z = (v2[12] & 0xffffu) | (v2[13] << 16); a1.w = (v2[14] & 0xffffu) | (v2[15] << 16);
            b0.x = (v2[0] >> 16) | (v2[1] & 0xffff0000u); b0.y = (v2[2] >> 16) | (v2[3] & 0xffff0000u); b0.z = (v2[4] >> 16) | (v2[5] & 0xffff0000u); b0.w = (v2[6] >> 16) | (v2[7] & 0xffff0000u);
            b1.x = (v2[8] >> 16) | (v2[9] & 0xffff0000u); b1.y = (v2[10] >> 16) | (v2[11] & 0xffff0000u); b1.z = (v2[12] >> 16) | (v2[13] & 0xffff0000u); b1.w = (v2[14] >> 16) | (v2[15] & 0xffff0000u);
            LAS unsigned char* pv = L + SC_VT + (2 * vp) * TSTR + vseg * 32;
            *(LAS u32x4*)(pv) = a0; *(LAS u32x4*)(pv + 16) = a1; *(LAS u32x4*)(pv + TSTR) = b0; *(LAS u32x4*)(pv + TSTR + 16) = b1;
        }
        if (seg == 0) {
            *(LAS f32x2*)(L + SC_VEC + (2 * cp) * 4) = (f32x2){__builtin_amdgcn_exp2f(mm.x), __builtin_amdgcn_exp2f(mm.y)};
            *(LAS f32x2*)(L + SC_VEC + 512 + (2 * cp) * 4) = (f32x2){__builtin_amdgcn_exp2f(bl.x), __builtin_amdgcn_exp2f(bl.y)};
            *(LAS f32x2*)(L + SC_VEC + 1024 + (2 * cp) * 4) = (f32x2){__builtin_amdgcn_exp2f(bl.x - mm.x), __builtin_amdgcn_exp2f(bl.y - mm.y)};
        }
        __syncthreads();
#pragma unroll
        for (int ti = 0; ti < (GLA ? 1 : 2); ++ti) {
            const int kb_ = GLA ? kq : 2 * kq + ti;
            const f32x16& Sx = ti == 0 ? S0 : S1;
#pragma unroll
            for (int gq = 0; gq < 4; ++gq) {
                const int k = 32 * kb_ + 8 * gq + 4 * h;
                const f32x4 em = *(const LAS f32x4*)(L + SC_VEC + (32 * kb_ + 8 * gq) * 4 + h16);
                u32x2 wv; wv.x = pk2(Sx[4 * gq] * em[0], Sx[4 * gq + 1] * em[1]); wv.y = pk2(Sx[4 * gq + 2] * em[2], Sx[4 * gq + 3] * em[3]);
                *(LAS u32x2*)(L + SC_ST + 32 * dvb_s * QSTR + rq8 + (32 * kb_ + 8 * gq) * 2) = wv;
            }
        }
        bf16x8 ps[4][2];
        {
            bf16x8 qf[NKS];
#pragma unroll
            for (int ks = 0; ks < NKS; ++ks) qf[ks] = *(const LAS bf16x8*)(L + SC_QT + 32 * tb * QSTR + rq + 32 * ks);
#pragma unroll
            for (int sb = 0; sb < 4; ++sb) {
                if (sb <= tb) {
                    bf16x8 af[NKS];
#pragma unroll
                    for (int ks = 0; ks < NKS; ++ks) af[ks] = *(const LAS bf16x8*)(L + SC_KT + 32 * sb * QSTR + rq + 32 * ks);
                    f32x16 x;
#pragma unroll
                    for (int i = 0; i < 16; ++i) x[i] = 0.f;
#pragma unroll
                    for (int ks = 0; ks < NKS; ++ks) x = MFMA32(af[ks], qf[ks], x);
                    if (sb == tb) {
#pragma unroll
                        for (int i = 0; i < 16; ++i) { const int cr = (i & 3) + 8 * (i >> 2) + 4 * h; x[i] = cr <= r ? x[i] : 0.f; }
                    }
#pragma unroll
                    for (int ss = 0; ss < 2; ++ss) { u32x4 pw; pw.x = pk2(x[8 * ss], x[8 * ss + 1]); pw.y = pk2(x[8 * ss + 2], x[8 * ss + 3]); pw.z = pk2(x[8 * ss + 4], x[8 * ss + 5]); pw.w = pk2(x[8 * ss + 6], x[8 * ss + 7]);
                        ps[sb][ss] = __builtin_bit_cast(bf16x8, pw); }
                } else { ps[sb][0] = (bf16x8){0, 0, 0, 0, 0, 0, 0, 0}; ps[sb][1] = (bf16x8){0, 0, 0, 0, 0, 0, 0, 0}; }
            }
        }
        __syncthreads();
        {
            LAS unsigned char* pk_ = L + SC_KT + (2 * cp) * TSTR + seg * SL * 2;
            if (SL == 16) {
                u32x4 a0, a1, b0, b1;
                a0.x = (kk[0] & 0xffffu) | (kk[1] << 16); a0.y = (kk[2] & 0xffffu) | (kk[3] << 16); a0.z = (kk[4] & 0xffffu) | (kk[5] << 16); a0.w = (kk[6] & 0xffffu) | (kk[7] << 16);
                a1.x = (kk[8 % SL] & 0xffffu) | (kk[9 % SL] << 16); a1.y = (kk[10 % SL] & 0xffffu) | (kk[11 % SL] << 16); a1.z = (kk[12 % SL] & 0xffffu) | (kk[13 % SL] << 16); a1.w = (kk[14 % SL] & 0xffffu) | (kk[15 % SL] << 16);
                b0.x = (kk[0] >> 16) | (kk[1] & 0xffff0000u); b0.y = (kk[2] >> 16) | (kk[3] & 0xffff0000u); b0.z = (kk[4] >> 16) | (kk[5] & 0xffff0000u); b0.w = (kk[6] >> 16) | (kk[7] & 0xffff0000u);
                b1.x = (kk[8 % SL] >> 16) | (kk[9 % SL] & 0xffff0000u); b1.y = (kk[10 % SL] >> 16) | (kk[11 % SL] & 0xffff0000u); b1.z = (kk[12 % SL] >> 16) | (kk[13 % SL] & 0xffff0000u); b1.w = (kk[14 % SL] >> 16) | (kk[15 % SL] & 0xffff0000u);
                *(LAS u32x4*)(pk_) = a0; *(LAS u32x4*)(pk_ + 16) = a1; *(LAS u32x4*)(pk_ + TSTR) = b0; *(LAS u32x4*)(pk_ + TSTR + 16) = b1;
            } else {
                u32x4 a0, b0;
                a0.x = (kk[0] & 0xffffu) | (kk[1] << 16); a0.y = (kk[2] & 0xffffu) | (kk[3] << 16); a0.z = (kk[4] & 0xffffu) | (kk[5] << 16); a0.w = (kk[6] & 0xffffu) | (kk[7] << 16);
                b0.x = (kk[0] >> 16) | (kk[1] & 0xffff0000u); b0.y = (kk[2] >> 16) | (kk[3] & 0xffff0000u); b0.z = (kk[4] >> 16) | (kk[5] & 0xffff0000u); b0.w = (kk[6] >> 16) | (kk[7] & 0xffff0000u);
                *(LAS u32x4*)(pk_) = a0; *(LAS u32x4*)(pk_ + TSTR) = b0;
            }
        }
        const int orow = ROWOF(j, 32 * tb + r);
        f32x16 O[2];
        {
            bf16x8 qf[NKS];
#pragma unroll
            for (int ks = 0; ks < NKS; ++ks) qf[ks] = *(const LAS bf16x8*)(L + SC_QT + 32 * tb * QSTR + rq + 32 * ks);
#pragma unroll
            for (int dvi = 0; dvi < 2; ++dvi) {
                const int dvb = 2 * dh + dvi;
                bf16x8 sf[NKS];
#pragma unroll
                for (int ks = 0; ks < NKS; ++ks) sf[ks] = *(const LAS bf16x8*)(L + SC_ST + 32 * dvb * QSTR + rq + 32 * ks);
                f32x16 o;
#pragma unroll
                for (int i = 0; i < 16; ++i) o[i] = 0.f;
#pragma unroll
                for (int ks = 0; ks < NKS; ++ks) o = MFMA32(sf[ks], qf[ks], o);
                O[dvi] = o;
            }
        }
        u32x2 praw[2][4];
        if (second) {
#pragma unroll
            for (int dvi = 0; dvi < 2; ++dvi)
#pragma unroll
                for (int gq = 0; gq < 4; ++gq) praw[dvi][gq] = *(const u32x2*)(RAW + (size_t)orow * DM + ocol + 32 * (2 * dh + dvi) + 8 * gq + 4 * h);
        }
#pragma unroll
        for (int dvi = 0; dvi < 2; ++dvi) {
            const int dvb = 2 * dh + dvi;
            f32x16 o = O[dvi];
#pragma unroll
            for (int sb = 0; sb < 4; ++sb) {
                if (sb <= tb) {
                    const LAS unsigned char* pa = L + SC_VT + 32 * dvb * TSTR + rt8 + 64 * sb;
                    const s16x4 l0 = *(const LAS s16x4*)(pa), h0 = *(const LAS s16x4*)(pa + 16), l1 = *(const LAS s16x4*)(pa + 32), h1 = *(const LAS s16x4*)(pa + 48);
                    o = MFMA32(__builtin_shufflevector(l0, h0, 0, 1, 2, 3, 4, 5, 6, 7), ps[sb][0], o);
                    o = MFMA32(__builtin_shufflevector(l1, h1, 0, 1, 2, 3, 4, 5, 6, 7), ps[sb][1], o);
                }
            }
            O[dvi] = o;
        }
        if (!second) {
#pragma unroll
            for (int dvi = 0; dvi < 2; ++dvi)
#pragma unroll
                for (int gq = 0; gq < 4; ++gq) {
                    const int dv = 32 * (2 * dh + dvi) + 8 * gq + 4 * h;
                    u32x2 wv; wv.x = pk2(O[dvi][4 * gq], O[dvi][4 * gq + 1]); wv.y = pk2(O[dvi][4 * gq + 2], O[dvi][4 * gq + 3]);
                    *(u32x2*)(RAW + (size_t)orow * DM + ocol + dv) = wv;
                }
        } else {
            float ssum = 0.f;
#pragma unroll
            for (int dvi = 0; dvi < 2; ++dvi)
#pragma unroll
                for (int gq = 0; gq < 4; ++gq) {
                    const u32x2 pw_ = praw[dvi][gq]; const f32x4 pr = {bflo(pw_.x), bfhi(pw_.x), bflo(pw_.y), bfhi(pw_.y)};
#pragma unroll
                    for (int e = 0; e < 4; ++e) { const float t = O[dvi][4 * gq + e] + pr[e]; O[dvi][4 * gq + e] = t; ssum += t * t; }
                }
            ssum += bperm(ssum, (lane ^ 32) << 2);
            if (h == 0) *(LAS float*)(L + SC_RED + (w * 32 + r) * 4) = ssum;
        }
        __syncthreads();
        if (second) {
            const float tot = *(const LAS float*)(L + SC_RED + ((w & ~1) * 32 + r) * 4) + *(const LAS float*)(L + SC_RED + ((w | 1) * 32 + r) * 4);
            const float rs = __builtin_amdgcn_rsqf(tot * (1.f / 128.f) + EPS);
#pragma unroll
            for (int dvi = 0; dvi < 2; ++dvi)
#pragma unroll
                for (int gq = 0; gq < 4; ++gq) {
                    const int dv = 32 * (2 * dh + dvi) + 8 * gq + 4 * h;
                    const f32x4 gn = *(const f32x4*)(gain + dv);
                    const u32x2 gt = *(const u32x2*)(P + (size_t)orow * NP_ + gatecol + dv);
                    u32x2 wv; wv.x = pk2(O[dvi][4 * gq] * rs * gn[0] * bflo(gt.x), O[dvi][4 * gq + 1] * rs * gn[1] * bfhi(gt.x));
                    wv.y = pk2(O[dvi][4 * gq + 2] * rs * gn[2] * bflo(gt.y), O[dvi][4 * gq + 3] * rs * gn[3] * bfhi(gt.y));
                    *(u32x2*)(OBF + (size_t)orow * DM + ocol + dv) = wv;
                }
        }
        if (j + 1 < j1) LOAD_CHUNK(j + 1);
        {
            bf16x8 vb[8];
#pragma unroll
            for (int ks = 0; ks < 8; ++ks) vb[ks] = *(const LAS bf16x8*)(L + SC_VT + 32 * dvb_s * TSTR + rt + 32 * ks);
#pragma unroll
            for (int ti = 0; ti < (GLA ? 1 : 2); ++ti) {
                const int kb_ = GLA ? kq : 2 * kq + ti;
                bf16x8 ka[8];
#pragma unroll
                for (int ks = 0; ks < 8; ++ks) ka[ks] = *(const LAS bf16x8*)(L + SC_KT + 32 * kb_ * TSTR + rt + 32 * ks);
                f32x16 pkv;
#pragma unroll
                for (int i = 0; i < 16; ++i) pkv[i] = 0.f;
#pragma unroll
                for (int ks = 0; ks < 8; ++ks) pkv = MFMA32(ka[ks], vb[ks], pkv);
                f32x16& Sx = ti == 0 ? S0 : S1;
#pragma unroll
                for (int gq = 0; gq < 4; ++gq) {
                    const int k = 32 * kb_ + 8 * gq + 4 * h;
                    const f32x4 eb = *(const LAS f32x4*)(L + SC_VEC + 512 + (32 * kb_ + 8 * gq) * 4 + h16), ebm = *(const LAS f32x4*)(L + SC_VEC + 1024 + (32 * kb_ + 8 * gq) * 4 + h16);
                    { const f32x2 s01 = (f32x2){eb[0], eb[1]} * (f32x2){Sx[4 * gq], Sx[4 * gq + 1]} + (f32x2){ebm[0], ebm[1]} * (f32x2){pkv[4 * gq], pkv[4 * gq + 1]};
                      const f32x2 s23 = (f32x2){eb[2], eb[3]} * (f32x2){Sx[4 * gq + 2], Sx[4 * gq + 3]} + (f32x2){ebm[2], ebm[3]} * (f32x2){pkv[4 * gq + 2], pkv[4 * gq + 3]};
                      Sx[4 * gq] = s01.x; Sx[4 * gq + 1] = s01.y; Sx[4 * gq + 2] = s23.x; Sx[4 * gq + 3] = s23.y; }
                }
            }
        }
    }
    __syncthreads();
#undef ROWOF
#undef LOAD_CHUNK
}


template <class T> __device__ __forceinline__ T* opaque_ptr(T* p) { __attribute__((address_space(1))) T* gp = (__attribute__((address_space(1))) T*)p; asm volatile("" : "+s"(gp)); return (T*)gp; }
__device__ __forceinline__ unsigned opaque_zero() { unsigned z; asm volatile("s_mov_b32 %0, 0" : "=s"(z)); return z; }
__device__ __forceinline__ void gbar(unsigned* ctr, unsigned target) {
    asm volatile("s_waitcnt vmcnt(0)" ::: "memory");
    __syncthreads();
    if (threadIdx.x == 0) {
        __builtin_amdgcn_fence(__ATOMIC_RELEASE, "agent");
        asm volatile("s_waitcnt vmcnt(0)" ::: "memory");
        __hip_atomic_fetch_add(ctr, 1u, __ATOMIC_RELAXED, __HIP_MEMORY_SCOPE_AGENT);
        while (__hip_atomic_load(ctr, __ATOMIC_RELAXED, __HIP_MEMORY_SCOPE_AGENT) < target) __builtin_amdgcn_s_sleep(2);
        __builtin_amdgcn_fence(__ATOMIC_ACQUIRE, "agent");
        asm volatile("s_waitcnt vmcnt(0)" ::: "memory");
    }
    __syncthreads();
}

__global__ void __launch_bounds__(NTHREADS) hymba_fwd(Args A) {
    extern __shared__ __attribute__((aligned(16))) unsigned char lds_raw[];
    cg::grid_group grid = cg::this_grid();
    unsigned nbar = 0;
#define PH_BEGIN() const unsigned zs = opaque_zero(); LAS unsigned char* L = (LAS unsigned char*)lds_raw + zs; unsigned char* ws = opaque_ptr(A.ws); const int G = (int)(gridDim.x + zs), bid = (int)(blockIdx.x + zs); const float* xp = opaque_ptr(A.xp); const float* xs = opaque_ptr(A.xs); float* outp = opaque_ptr(A.out); (void)L; (void)ws; (void)G; (void)bid; (void)xp; (void)xs; (void)outp
#define GBAR() do { for (int rb_ = 0; rb_ < PROBE_BAR; ++rb_) { nbar += 256u; gbar((unsigned*)(A.ws + OFF_BAR + opaque_zero()), nbar); } } while (0)

    for (int rep = 0; rep < PROBE_P0; ++rep) { PH_BEGIN(); p0_convert(A); }
    grid.sync();

#pragma unroll 1
    for (int g = 0; g < NGRP; ++g) {
        { PH_BEGIN(); g0_prologue(xp, xs, ws, g); }
        GBAR();
#pragma unroll 1
        for (int l = 0; l < 2; ++l) {
            const size_t wlo = OFF_W + (size_t)l * SZ_LAYER;
            const size_t sq = OFF_SSQ + (size_t)(3 * l) * SSQ_SITE * 4;
            for (int rep = 0; rep < PROBE_FFNIN; ++rep) { PH_BEGIN(); pg8::Gemm gm{(const bf16_t*)(ws + OFF_XB), (const bf16_t*)(ws + wlo), MG, NFF, DM}; pg8::StaticOrder S; S.init(MG, NFF, G, bid);
              EpiFfnIn E{(bf16_t*)(ws + OFF_PH), (const float*)(ws + sq), g}; pg8::gemm_phase(L, gm, S, E); }
            GBAR();
            for (int rep = 0; rep < PROBE_FFNOUT_NULL; ++rep) { PH_BEGIN(); pg8::Gemm gm{(const bf16_t*)(ws + OFF_PH), (const bf16_t*)(ws + wlo + SZ_W1I), MG, DM, DFF}; pg8::StaticOrder S; S.init(MG, DM, G, bid); EpiNull E{(float*)(ws + OFF_RAW)}; pg8::gemm_phase(L, gm, S, E); }
            { PH_BEGIN(); pg8::Gemm gm{(const bf16_t*)(ws + OFF_PH), (const bf16_t*)(ws + wlo + SZ_W1I), MG, DM, DFF}; pg8::StaticOrder S; S.init(MG, DM, G, bid);
              EpiRes E{(bf16_t*)(ws + OFF_XB), (float*)(ws + sq) + SSQ_SITE, 0.5f, g}; pg8::gemm_phase(L, gm, S, E); }
            GBAR();
            for (int rep = 0; rep < PROBE_WIN; ++rep) { PH_BEGIN(); pg8::Gemm gm{(const bf16_t*)(ws + OFF_XB), (const bf16_t*)(ws + wlo + SZ_W1I + SZ_W1O), MG, NP_, DM}; pg8::StaticOrder S; S.init(MG, NP_, G, bid);
              const float* LBT = (const float*)(ws + OFF_LBT) + l * 2048;
              EpiWin E{(bf16_t*)(ws + OFF_PH), (const float*)(ws + sq) + SSQ_SITE, LBT, LBT + 1024, A.bg + l * 512, g}; pg8::gemm_phase(L, gm, S, E); }
            GBAR();
            for (int rep = 0; rep < PROBE_SCAN; ++rep) {
                f32x16 S0, S1;
#pragma unroll
                for (int i = 0; i < 16; ++i) { S0[i] = 0.f; S1[i] = 0.f; }
#pragma unroll 1
                for (int half = 0; half < 2; ++half) {
                    { PH_BEGIN();
                      const bf16_t* PH = (const bf16_t*)(ws + OFF_PH); bf16_t* RAW = (bf16_t*)(ws + OFF_RAW); bf16_t* OBF = (bf16_t*)(ws + OFF_OBF);
                      const int dir = bid & 1, hh = (bid >> 1) & 7, sidx = (bid >> 4) & 15;
                      const int T = sidx < 8 ? TPROMPT : TSAMPLE, seqbase = sidx < 8 ? sidx * TPROMPT : 16384 + (sidx - 8) * TSAMPLE, N = T / 128;
                      const int j0 = half ? N / 2 : 0, j1 = half ? N : N / 2;
                      if (hh < 4) { const int hd = hh;
                          scan_half<128>(L, PH, RAW, OBF, A.hgn + l * 512 + 128 * hd, seqbase, T, dir, 128 * hd, 0, (dir ? 1024 : 512) + 128 * hd, 1536 + 128 * hd, 2048 + 128 * hd, 128 * hd, j0, j1, half != 0, S0, S1);
                      } else { const int hd = hh - 4;
                          scan_half<64>(L, PH, RAW, OBF, A.glan + l * 512 + 128 * hd, seqbase, T, dir, 2560 + 64 * hd, 2816 + 64 * hd, (dir ? 3840 : 3584) + 64 * hd, 3072 + 128 * hd, 4096 + 128 * hd, 512 + 128 * hd, j0, j1, half != 0, S0, S1);
                      } }
                    GBAR();
                }
            }
            { PH_BEGIN(); pg8::Gemm gm{(const bf16_t*)(ws + OFF_OBF), (const bf16_t*)(ws + wlo + SZ_W1I + SZ_W1O + SZ_WIN), MG, DM, DM}; pg8::StaticOrder S; S.init(MG, DM, G, bid);
              EpiRes E{(bf16_t*)(ws + OFF_XB), (float*)(ws + sq) + 2 * SSQ_SITE, 1.0f, g}; pg8::gemm_phase(L, gm, S, E); }
            GBAR();
            for (int rep = 0; rep < PROBE_FFNIN; ++rep) { PH_BEGIN(); pg8::Gemm gm{(const bf16_t*)(ws + OFF_XB), (const bf16_t*)(ws + wlo + SZ_W1I + SZ_W1O + SZ_WIN + SZ_WO), MG, NFF, DM}; pg8::StaticOrder S; S.init(MG, NFF, G, bid);
              EpiFfnIn E{(bf16_t*)(ws + OFF_PH), (const float*)(ws + sq) + 2 * SSQ_SITE, g}; pg8::gemm_phase(L, gm, S, E); }
            GBAR();
            for (int rep = 0; rep < PROBE_FFNOUT_NULL; ++rep) { PH_BEGIN(); pg8::Gemm gm{(const bf16_t*)(ws + OFF_PH), (const bf16_t*)(ws + wlo + 2 * SZ_W1I + SZ_W1O + SZ_WIN + SZ_WO), MG, DM, DFF}; pg8::StaticOrder S; S.init(MG, DM, G, bid); EpiNull E{(float*)(ws + OFF_RAW)}; pg8::gemm_phase(L, gm, S, E); }
            { PH_BEGIN(); pg8::Gemm gm{(const bf16_t*)(ws + OFF_PH), (const bf16_t*)(ws + wlo + 2 * SZ_W1I + SZ_W1O + SZ_WIN + SZ_WO), MG, DM, DFF}; pg8::StaticOrder S; S.init(MG, DM, G, bid);
              EpiRes E{(bf16_t*)(ws + OFF_XB), (float*)(ws + sq) + 3 * SSQ_SITE, 0.5f, g}; pg8::gemm_phase(L, gm, S, E); }
            GBAR();
        }
        { PH_BEGIN(); final_norm(outp, opaque_ptr(A.nf), ws, g); }
    }
#undef PH_BEGIN
#undef GBAR
}

constexpr int LDS_BYTES = 146432;
extern "C" void kernel_launch(void* const* d_in, const int* in_sizes, int n_in, void* d_out, int out_size, void* d_ws, size_t ws_size, hipStream_t stream) {
    static int ready = 0;
    if (!ready) {
        if (n_in != 17 || out_size != MTOT * DM || ws_size < WS_END) { fprintf(stderr, "kernel_launch: unexpected shapes (n_in %d out %d ws %zu need %zu)\n", n_in, out_size, ws_size, (size_t)WS_END); ready = -1; return; }
        if (hipFuncSetAttribute((const void*)hymba_fwd, hipFuncAttributeMaxDynamicSharedMemorySize, LDS_BYTES) != hipSuccess) { fprintf(stderr, "kernel_launch: hipFuncSetAttribute failed\n"); ready = -1; return; }
        int per_cu = 0; (void)hipOccupancyMaxActiveBlocksPerMultiprocessor(&per_cu, (const void*)hymba_fwd, NTHREADS, LDS_BYTES); (void)hipGetLastError();
        ready = 1;
    }
    if (ready < 0) return;
    if (hipMemsetAsync((char*)d_ws + OFF_BAR, 0, 256, stream) != hipSuccess) { fprintf(stderr, "kernel_launch: memset failed\n"); return; }
    Args a{};
    a.xp = (const float*)d_in[0]; a.xs = (const float*)d_in[1]; a.lower_bounds = (const float*)d_in[2]; a.n1 = (const float*)d_in[3]; a.w1i = (const float*)d_in[4]; a.w1o = (const float*)d_in[5];
    a.nm = (const float*)d_in[6]; a.wi = (const float*)d_in[7]; a.wg = (const float*)d_in[8]; a.bg = (const float*)d_in[9]; a.hgn = (const float*)d_in[10]; a.glan = (const float*)d_in[11];
    a.wo = (const float*)d_in[12]; a.n2 = (const float*)d_in[13]; a.w2i = (const float*)d_in[14]; a.w2o = (const float*)d_in[15]; a.nf = (const float*)d_in[16];
    a.out = (float*)d_out; a.ws = (unsigned char*)d_ws;
    void* args[] = {&a};
    hipError_t e = hipLaunchCooperativeKernel((const void*)hymba_fwd, dim3(256), dim3(NTHREADS), args, LDS_BYTES, stream);
    if (e != hipSuccess) fprintf(stderr, "cooperative launch failed: %s\n", hipGetErrorString(e));
}
```

```cpp
#include <hip/hip_runtime.h>
#include <hip/hip_cooperative_groups.h>
#include <cstdio>
namespace cg = cooperative_groups;

#define LAS __attribute__((address_space(3)))
typedef unsigned short bf16_t;
typedef short bf16x8 __attribute__((ext_vector_type(8)));
typedef short s16x4 __attribute__((ext_vector_type(4)));
typedef float f32x2 __attribute__((ext_vector_type(2)));
typedef float f32x4 __attribute__((ext_vector_type(4)));
typedef float f32x16 __attribute__((ext_vector_type(16)));
typedef unsigned u32x2 __attribute__((ext_vector_type(2)));
typedef unsigned u32x4 __attribute__((ext_vector_type(4)));

constexpr int DM = 1024, DFF = 2816, NFF = 5632, DINSRC = 4128, NP_ = 4608;
constexpr int MTOT = 98304, MGMAX = 65536, NGRP = 2;
constexpr int TPROMPT = 2048, TSAMPLE = 4096;
constexpr float EPS = 1e-6f;
constexpr int NTHREADS = 512;
#ifndef PROBE_SCAN
#define PROBE_SCAN 1
#endif
#ifndef PROBE_FFNIN
#define PROBE_FFNIN 1
#endif
#ifndef PROBE_P0
#define PROBE_P0 1
#endif
#ifndef PROBE_WIN
#define PROBE_WIN 1
#endif
#ifndef PROBE_FFNOUT_NULL
#define PROBE_FFNOUT_NULL 0
#endif
#ifndef PROBE_G0F
#define PROBE_G0F 1
#endif
#ifndef PROBE_BAR
#define PROBE_BAR 1
#endif

constexpr size_t SZ_W1I = (size_t)NFF * DM * 2, SZ_W1O = (size_t)DM * DFF * 2, SZ_WIN = (size_t)NP_ * DM * 2, SZ_WO = (size_t)DM * DM * 2;
constexpr size_t SZ_LAYER = 2 * SZ_W1I + 2 * SZ_W1O + SZ_WIN + SZ_WO;
constexpr size_t OFF_W = 0;
constexpr size_t OFF_LBT = OFF_W + 2 * SZ_LAYER;
constexpr size_t OFF_SSQ = OFF_LBT + 2 * 2 * 1024 * 4;
constexpr size_t SSQ_SITE = (size_t)MTOT * 16;
constexpr size_t OFF_XB = OFF_SSQ + 7 * SSQ_SITE * 4;
constexpr size_t OFF_OBF = OFF_XB + (size_t)MGMAX * DM * 2;
constexpr size_t OFF_RAW = OFF_OBF;
constexpr size_t OFF_PH = OFF_OBF + (size_t)MGMAX * DM * 2;
constexpr size_t OFF_BAR = OFF_PH + (size_t)MGMAX * NP_ * 2;
constexpr size_t WS_END = OFF_BAR + 256;

__device__ __forceinline__ unsigned pk2(float lo, float hi) {
    typedef __bf16 bf2 __attribute__((ext_vector_type(2)));
    f32x2 v = {lo, hi};
    return __builtin_bit_cast(unsigned, __builtin_convertvector(v, bf2));
}
__device__ __forceinline__ float bflo(unsigned u) { return __uint_as_float(u << 16); }
__device__ __forceinline__ float bfhi(unsigned u) { return __uint_as_float(u & 0xffff0000u); }
__device__ __forceinline__ int grow_tile(int g, int pm) { return (g == 0 ? 32768 : 0) + pm * 256; }
__device__ __forceinline__ int grow(int g, int r) { return (g == 0 ? 32768 : 0) + r; }
__device__ __forceinline__ float sigmoid_f(float x) { return __builtin_amdgcn_rcpf(1.f + __builtin_amdgcn_exp2f(x * -1.44269504f)); }
__device__ __forceinline__ float log2sig_f(float z) { return fminf(z, 0.f) * 1.44269504f - __builtin_amdgcn_logf(1.f + __builtin_amdgcn_exp2f(fabsf(z) * -1.44269504f)); }

__device__ __forceinline__ float bperm(float x, int byte_idx) { return __int_as_float(__builtin_amdgcn_ds_bpermute(byte_idx, __float_as_int(x))); }
__device__ __forceinline__ float row_rstd(const float* ssq16, int R, int fq, int i16, int i32) {
    const f32x4 v = *(const f32x4*)(ssq16 + (size_t)R * 16 + 4 * fq);
    float s = (v[0] + v[1]) + (v[2] + v[3]);
    s += bperm(s, i16); s += bperm(s, i32);
    return rsqrtf(s * (1.f / 1024.f) + EPS);
}

__device__ __forceinline__ void rows_rstd8(float (&rs)[8], const float* ssq16, int Rbase  , int fq, int i16, int i32) {
    f32x4 v[8];
#pragma unroll
    for (int q = 0; q < 8; ++q) v[q] = *(const f32x4*)(ssq16 + (size_t)(Rbase + (q >> 2) * 128 + (q & 3) * 16) * 16 + 4 * fq);
#pragma unroll
    for (int q = 0; q < 8; ++q) { float s = (v[q][0] + v[q][1]) + (v[q][2] + v[q][3]); s += bperm(s, i16); s += bperm(s, i32); rs[q] = __builtin_amdgcn_rsqf(s * (1.f / 1024.f) + EPS); }
}

namespace pg8 {
constexpr int BM = 256, BK = 64, HALF = 128, HTB = HALF * BK * 2, STAGE_BYTES = 8 * HTB, NXCD = 8, WGM = 8;
__device__ __forceinline__ int lds_byte(int r, int c) { const int st = (r >> 4) * 2 + (c >> 5), rr = r & 15, cc = c & 31, ob = rr * 64 + cc * 2; return st * 1024 + (ob ^ (((ob >> 9) & 1) << 5)); }
__device__ __forceinline__ void stage_rc(int b, int& R, int& C) { const int st = b / 1024, sb = b % 1024, swz = sb ^ (((sb >> 9) & 1) << 5); R = (st >> 1) * 16 + swz / 64; C = (st & 1) * 32 + (swz % 64) / 2; }
__device__ __forceinline__ int perm32(int rho) { const int n = rho >> 4, i = rho & 15; return 8 * (i >> 2) + 4 * n + (i & 3); }
struct Unit { int pm, pn; };
struct Gemm { const bf16_t* A; const bf16_t* Bt; int M, N, K; };
struct StaticOrder {
    int nM, nN, nwg, G, c;
    __device__ void init(int M, int N, int G_, int c_) { nM = M / BM; nN = N / BM; nwg = nM * nN; G = G_; c = c_; }
    __device__ bool next(int i, Unit& u) const {
        const long L = (long)i * G + c; if (L >= nwg) return false;
        int wgid = (int)L; { const int q = nwg / NXCD, r = nwg % NXCD, xcd = wgid % NXCD, off = wgid / NXCD; wgid = (xcd < r ? xcd * (q + 1) : r * (q + 1) + (xcd - r) * q) + off; }
        const int nig = WGM * nN, gid = wgid / nig, fm = gid * WGM, gsz = (nM - fm) < WGM ? (nM - fm) : WGM;
        u.pm = fm + ((wgid % nig) % gsz); u.pn = (wgid % nig) / gsz; return true;
    }
};

template <class Epi>
__device__ __forceinline__ void gemm_phase(LAS unsigned char* lds, const Gemm g, const StaticOrder& S, const Epi& E) {
    int tid_ = threadIdx.x; asm volatile("" : "+v"(tid_));
    const int tid = tid_, wid = __builtin_amdgcn_readfirstlane(tid >> 6), lane = tid & 63, wr = wid >> 2, wc = wid & 3, fr = lane & 15, fq = lane >> 4;
    const int K = g.K, nt = K / BK;
    unsigned voffA[2], voffB[2];
#pragma unroll
    for (int i = 0; i < 2; ++i) { int R, C; stage_rc(tid * 16 + i * 8192, R, C); const int Rb = Epi::PERM ? ((R & ~31) + perm32(R & 31)) : R;
        voffA[i] = (unsigned)(R * K + C) * 2u; voffB[i] = (unsigned)(Rb * K + C) * 2u; }
    const size_t kstep = (size_t)(BK * 2);
    const size_t hstep = (size_t)HALF * K * 2;
    const size_t tstep = 2 * hstep;
    const unsigned ldsw = (unsigned)wid * 1024u;
    const int aoff = lds_byte(wr * 64 + fr, fq * 8), boff = lds_byte(wc * 32 + fr, fq * 8);
#define PG8_SA(b, h) (((b) * 2 + (h)) * HTB)
#define PG8_SB(b, h) ((4 + (b) * 2 + (h)) * HTB)
#define PG8_STAGE(bufoff, gbase, voff) do { _Pragma("unroll") for (int _i = 0; _i < 2; ++_i) \
        __builtin_amdgcn_global_load_lds((const unsigned*)((const char*)(gbase) + (voff)[_i]), (LAS unsigned*)(lds + (bufoff) + ldsw + _i * 8192), 16, 0, 0); } while (0)
#define PG8_LDA(dst, b, h) do { _Pragma("unroll") for (int m = 0; m < 4; ++m) _Pragma("unroll") for (int k = 0; k < 2; ++k) dst[m][k] = *(const LAS bf16x8*)(lds + PG8_SA(b, h) + aoff + m * 2048 + k * 1024); } while (0)
#define PG8_LDB(dst, b, h) do { _Pragma("unroll") for (int n = 0; n < 2; ++n) _Pragma("unroll") for (int k = 0; k < 2; ++k) dst[n][k] = *(const LAS bf16x8*)(lds + PG8_SB(b, h) + boff + n * 2048 + k * 1024); } while (0)
#define PG8_MMA(ai, bj, At, Bt) do { __builtin_amdgcn_s_setprio(1); _Pragma("unroll") for (int m = 0; m < 4; ++m) _Pragma("unroll") for (int n = 0; n < 2; ++n) _Pragma("unroll") for (int k = 0; k < 2; ++k) \
        acc[ai][bj][m][n] = __builtin_amdgcn_mfma_f32_16x16x32_bf16(Bt[n][k], At[m][k], acc[ai][bj][m][n], 0, 0, 0); __builtin_amdgcn_s_setprio(0); } while (0)
#define PG8_WAIT_V(n) asm volatile("s_waitcnt vmcnt(" #n ")" ::: "memory")
#define PG8_WAIT_L(n) asm volatile("s_waitcnt lgkmcnt(" #n ")" ::: "memory")
#define PG8_BAR __builtin_amdgcn_s_barrier()
#define PG8_SCHED __builtin_amdgcn_sched_barrier(0)
    Unit cur, nxt; int ui = 0;
    if (!S.next(0, cur)) return;
    f32x4 acc[2][2][4][2];
#pragma unroll
    for (int a = 0; a < 2; ++a)
#pragma unroll
        for (int b = 0; b < 2; ++b)
#pragma unroll
            for (int m = 0; m < 4; ++m)
#pragma unroll
                for (int n = 0; n < 2; ++n) acc[a][b][m][n] = (f32x4){0.f, 0.f, 0.f, 0.f};
    bf16x8 At[4][2], B0[2][2], B1[2][2];
    const char* cA = (const char*)g.A + (size_t)cur.pm * tstep; const char* cB = (const char*)g.Bt + (size_t)cur.pn * tstep;
    PG8_STAGE(PG8_SB(0, 0), cB, voffB); PG8_STAGE(PG8_SA(0, 0), cA, voffA); PG8_STAGE(PG8_SB(0, 1), cB + hstep, voffB); PG8_STAGE(PG8_SA(0, 1), cA + hstep, voffA);
    if (wr == 1) PG8_BAR;
    PG8_WAIT_V(4); PG8_BAR;
    PG8_STAGE(PG8_SB(1, 0), cB + kstep, voffB); PG8_STAGE(PG8_SA(1, 0), cA + kstep, voffA); PG8_STAGE(PG8_SB(1, 1), cB + hstep + kstep, voffB);
    PG8_WAIT_V(6); PG8_BAR;
    for (;;) {
        const bool has_next = S.next(ui + 1, nxt);
        const char* nA = has_next ? (const char*)g.A + (size_t)nxt.pm * tstep : cA; const char* nB = has_next ? (const char*)g.Bt + (size_t)nxt.pn * tstep : cB;
        for (int t = 0; t < nt; t += 2) {
            const bool last = (t == nt - 2);
            const char* a1 = cA + (size_t)(t + 1) * kstep;
            const char* a2 = last ? nA : cA + (size_t)(t + 2) * kstep; const char* b2 = last ? nB : cB + (size_t)(t + 2) * kstep;
            const char* a3 = a2 + kstep; const char* b3 = b2 + kstep;
            PG8_LDB(B0, 0, 0); PG8_SCHED; PG8_LDA(At, 0, 0); PG8_STAGE(PG8_SA(1, 1), a1 + hstep, voffA);
            PG8_WAIT_L(8); PG8_BAR; PG8_WAIT_L(0); PG8_MMA(0, 0, At, B0); PG8_BAR; PG8_SCHED;
            PG8_LDB(B1, 0, 1); PG8_STAGE(PG8_SB(0, 0), b2, voffB);
            PG8_BAR; PG8_WAIT_L(0); PG8_MMA(0, 1, At, B1); PG8_BAR;
            PG8_LDA(At, 0, 1); PG8_STAGE(PG8_SA(0, 0), a2, voffA);
            PG8_BAR; PG8_WAIT_L(0); PG8_MMA(1, 0, At, B0); PG8_BAR; PG8_SCHED;
            PG8_STAGE(PG8_SB(0, 1), b2 + hstep, voffB);
            PG8_WAIT_V(6); PG8_BAR; PG8_MMA(1, 1, At, B1); PG8_BAR;
            PG8_LDB(B0, 1, 0); PG8_SCHED; PG8_LDA(At, 1, 0); PG8_STAGE(PG8_SA(0, 1), a2 + hstep, voffA);
            PG8_WAIT_L(8); PG8_BAR; PG8_WAIT_L(0); PG8_MMA(0, 0, At, B0); PG8_BAR; PG8_SCHED;
            PG8_LDB(B1, 1, 1); PG8_STAGE(PG8_SB(1, 0), b3, voffB);
            PG8_BAR; PG8_WAIT_L(0); PG8_MMA(0, 1, At, B1); PG8_BAR;
            PG8_LDA(At, 1, 1); PG8_STAGE(PG8_SA(1, 0), a3, voffA);
            PG8_BAR; PG8_WAIT_L(0); PG8_MMA(1, 0, At, B0); PG8_BAR; PG8_SCHED;
            PG8_STAGE(PG8_SB(1, 1), b3 + hstep, voffB);
            PG8_WAIT_V(6); PG8_BAR; PG8_MMA(1, 1, At, B1); PG8_BAR;
        }
        E(acc, cur, wr, wc, fr, fq);
        if (!has_next) break;
#pragma unroll
        for (int a = 0; a < 2; ++a)
#pragma unroll
            for (int b = 0; b < 2; ++b)
#pragma unroll
                for (int m = 0; m < 4; ++m)
#pragma unroll
                    for (int n = 0; n < 2; ++n) acc[a][b][m][n] = (f32x4){0.f, 0.f, 0.f, 0.f};
        cur = nxt; cA = nA; cB = nB; ++ui;
    }
    PG8_WAIT_V(0);
    if (wr == 0) PG8_BAR;
    PG8_BAR;
#undef PG8_SA
#undef PG8_SB
#undef PG8_STAGE
#undef PG8_LDA
#undef PG8_LDB
#undef PG8_MMA
#undef PG8_WAIT_V
#undef PG8_WAIT_L
#undef PG8_BAR
#undef PG8_SCHED
}
}

struct EpiFfnIn {
    static constexpr bool PERM = true;
    bf16_t* H; const float* ssq; int g;
    __device__ __forceinline__ void operator()(const f32x4 (&acc)[2][2][4][2], const pg8::Unit& u, int wr, int wc, int fr_in, int fq) const {
        int fr = fr_in; asm volatile("" : "+v"(fr));
        const int lane_ = fr | (fq << 4), i16 = (lane_ ^ 16) << 2, i32 = (lane_ ^ 32) << 2; (void)i16; (void)i32;
        const int R0 = grow_tile(g, u.pm);
        const int col0 = u.pn * 128 + wc * 32 + 8 * fq;
        float rs8[8]; rows_rstd8(rs8, ssq, R0 + wr * 64 + fr, fq, i16, i32);
#pragma unroll
        for (int ai = 0; ai < 2; ++ai)
#pragma unroll
            for (int m = 0; m < 4; ++m) {
                const int rt = ai * 128 + wr * 64 + m * 16 + fr;
                const float rs = rs8[ai * 4 + m];
                float hv[8];
                const float nrs = rs * -1.44269504f;
#pragma unroll
                for (int n = 0; n < 2; ++n)
#pragma unroll
                    for (int jp = 0; jp < 2; ++jp) {
                        const f32x2 ra = {acc[ai][0][m][n][2 * jp], acc[ai][0][m][n][2 * jp + 1]}, rb = {acc[ai][1][m][n][2 * jp], acc[ai][1][m][n][2 * jp + 1]};
                        f32x2 na = ra * nrs; na.x = fminf(na.x, 60.f); na.y = fminf(na.y, 60.f);
                        f32x2 d; d.x = __builtin_amdgcn_exp2f(na.x); d.y = __builtin_amdgcn_exp2f(na.y); d = d + 1.0f;
                        const float rinv = __builtin_amdgcn_rcpf(d.x * d.y);
                        const f32x2 ab = (ra * rs) * (rb * rs);
                        const f32x2 sg = {rinv * d.y, rinv * d.x};
                        const f32x2 hh = ab * sg;
                        hv[n * 4 + 2 * jp] = hh.x; hv[n * 4 + 2 * jp + 1] = hh.y;
                    }
                u32x4 w; w.x = pk2(hv[0], hv[1]); w.y = pk2(hv[2], hv[3]); w.z = pk2(hv[4], hv[5]); w.w = pk2(hv[6], hv[7]);
                *(u32x4*)(H + (size_t)(u.pm * 256 + rt) * DFF + col0) = w;
            }
    }
};
struct EpiNull { static constexpr bool PERM = true; float* sink; __device__ __forceinline__ void operator()(const f32x4 (&acc)[2][2][4][2], const pg8::Unit& u, int wr, int wc, int fr, int fq) const {
    float s = 0.f;
#pragma unroll
    for (int a = 0; a < 2; ++a)
#pragma unroll
        for (int b = 0; b < 2; ++b)
#pragma unroll
            for (int m = 0; m < 4; ++m)
#pragma unroll
                for (int n = 0; n < 2; ++n) s += (acc[a][b][m][n][0] + acc[a][b][m][n][1]) + (acc[a][b][m][n][2] + acc[a][b][m][n][3]);
    if (s == 123.456f) sink[0] = 1.f; } };
struct EpiRes {
    static constexpr bool PERM = true;
    bf16_t* XB; float* ssq; float scale; int g;
    __device__ __forceinline__ void operator()(const f32x4 (&acc)[2][2][4][2], const pg8::Unit& u, int wr, int wc, int fr_in, int fq) const {
        int fr = fr_in; asm volatile("" : "+v"(fr));
        const int lane_ = fr | (fq << 4), i16 = (lane_ ^ 16) << 2, i32 = (lane_ ^ 32) << 2; (void)i16; (void)i32;
        const int R0 = grow_tile(g, u.pm);
#pragma unroll
        for (int ai = 0; ai < 2; ++ai) {
            u32x4 old[4][2];
#pragma unroll
            for (int m = 0; m < 4; ++m)
#pragma unroll
                for (int bj = 0; bj < 2; ++bj)
                    old[m][bj] = *(const u32x4*)(XB + (size_t)(u.pm * 256 + ai * 128 + wr * 64 + m * 16 + fr) * DM + u.pn * 256 + bj * 128 + wc * 32 + 8 * fq);
#pragma unroll
            for (int m = 0; m < 4; ++m) {
                const int rt = ai * 128 + wr * 64 + m * 16 + fr;
                bf16_t* xb = XB + (size_t)(u.pm * 256 + rt) * DM;
                float part = 0.f;
#pragma unroll
                for (int bj = 0; bj < 2; ++bj) {
                    const int c0 = u.pn * 256 + bj * 128 + wc * 32 + 8 * fq;
                    const u32x4 o = old[m][bj];
                    const f32x4 a0 = acc[ai][bj][m][0], a1 = acc[ai][bj][m][1];
                    float n[8];
                    n[0] = bflo(o.x) + a0[0] * scale; n[1] = bfhi(o.x) + a0[1] * scale; n[2] = bflo(o.y) + a0[2] * scale; n[3] = bfhi(o.y) + a0[3] * scale;
                    n[4] = bflo(o.z) + a1[0] * scale; n[5] = bfhi(o.z) + a1[1] * scale; n[6] = bflo(o.w) + a1[2] * scale; n[7] = bfhi(o.w) + a1[3] * scale;
                    u32x4 w; w.x = pk2(n[0], n[1]); w.y = pk2(n[2], n[3]); w.z = pk2(n[4], n[5]); w.w = pk2(n[6], n[7]);
                    *(u32x4*)(xb + c0) = w;
                    part += (n[0] * n[0] + n[1] * n[1]) + (n[2] * n[2] + n[3] * n[3]) + (n[4] * n[4] + n[5] * n[5]) + (n[6] * n[6] + n[7] * n[7]);
                }
                part += bperm(part, i16); part += bperm(part, i32);
                if (fq == 0) ssq[(size_t)(R0 + rt) * 16 + u.pn * 4 + wc] = part;
            }
            asm volatile("" ::: "memory");
        }
    }
};
struct EpiWin {
    static constexpr bool PERM = true;
    bf16_t* P; const float* ssq; const float* lbA; const float* lbB; const float* bg; int g;
    __device__ __forceinline__ void operator()(const f32x4 (&acc)[2][2][4][2], const pg8::Unit& u, int wr, int wc, int fr_in, int fq) const {
        int fr = fr_in; asm volatile("" : "+v"(fr));
        const int lane_ = fr | (fq << 4), i16 = (lane_ ^ 16) << 2, i32 = (lane_ ^ 32) << 2; (void)i16; (void)i32;
        const int R0 = grow_tile(g, u.pm);
        const int pn = u.pn;
        const int mode = (pn >= 2 && pn <= 5) ? 1 : (pn == 8 || pn == 9) ? 2 : (pn == 14 || pn == 15) ? 4 : (pn >= 16) ? 5 : 0;
        float rs8[8]; rows_rstd8(rs8, ssq, R0 + wr * 64 + fr, fq, i16, i32);
#pragma unroll
        for (int bj = 0; bj < 2; ++bj) {
            const int cin = bj * 128 + wc * 32 + 8 * fq;
            float ca[8], cb[8];
            if (mode == 1) { const int lc = 256 * (pn - 2) + cin;
#pragma unroll
                for (int j = 0; j < 8; ++j) { ca[j] = lbA[lc + j]; cb[j] = lbB[lc + j]; } }
            else if (mode == 4) { const int lc = 256 * (pn - 14) + cin;
#pragma unroll
                for (int j = 0; j < 8; ++j) { ca[j] = bg[lc + j]; cb[j] = 0.f; } }
            else {
#pragma unroll
                for (int j = 0; j < 8; ++j) { ca[j] = 0.f; cb[j] = 0.f; } }
#pragma unroll
            for (int ai = 0; ai < 2; ++ai)
#pragma unroll
                for (int m = 0; m < 4; ++m) {
                    const int rt = ai * 128 + wr * 64 + m * 16 + fr;
                    const float rs = rs8[ai * 4 + m];
                    float v[8];
#pragma unroll
                    for (int n = 0; n < 2; ++n)
#pragma unroll
                        for (int j = 0; j < 4; ++j) v[n * 4 + j] = acc[ai][bj][m][n][j] * rs;
                    if (mode == 1) {
#pragma unroll
                        for (int j = 0; j < 8; ++j) v[j] = __builtin_amdgcn_logf(ca[j] + cb[j] * sigmoid_f(v[j]));
                    } else if (mode == 2) {
#pragma unroll
                        for (int j = 0; j < 8; ++j) v[j] = sigmoid_f(v[j]);
                    } else if (mode == 4) {
#pragma unroll
                        for (int j = 0; j < 8; ++j) v[j] = log2sig_f(v[j] + ca[j]) * (1.f / 16.f);
                    } else if (mode == 5) {
#pragma unroll
                        for (int j = 0; j < 8; ++j) v[j] = v[j] * sigmoid_f(v[j]);
                    }
                    u32x4 w; w.x = pk2(v[0], v[1]); w.y = pk2(v[2], v[3]); w.z = pk2(v[4], v[5]); w.w = pk2(v[6], v[7]);
                    *(u32x4*)(P + (size_t)(u.pm * 256 + rt) * NP_ + pn * 256 + cin) = w;
                }
        }
    }
};

struct Args {
    const float* xp; const float* xs; const float* lower_bounds; const float* n1; const float* w1i; const float* w1o; const float* nm; const float* wi;
    const float* wg; const float* bg; const float* hgn; const float* glan; const float* wo; const float* n2; const float* w2i; const float* w2o; const float* nf;
    float* out; unsigned char* ws;
};

__device__ __forceinline__ void p0_convert(const Args& A) {
    const long nth = (long)gridDim.x * NTHREADS, gt = (long)blockIdx.x * NTHREADS + threadIdx.x;
    unsigned char* ws = A.ws;
    const long cnt[6] = {(long)NFF * 128, (long)DM * 352, (long)NP_ * 128, (long)DM * 128, (long)NFF * 128, (long)DM * 352};
    const long per_layer = cnt[0] + cnt[1] + cnt[2] + cnt[3] + cnt[4] + cnt[5];
    for (long it = gt; it < 2 * per_layer; it += nth) {
        const int l = it >= per_layer ? 1 : 0; long i = it - (long)l * per_layer;
        int job = 0;
#pragma unroll
        for (int j = 0; j < 5; ++j) if (job == j && i >= cnt[j]) { i -= cnt[j]; job = j + 1; }
        unsigned char* wl = ws + OFF_W + (size_t)l * SZ_LAYER;
        float v[8];
        bf16_t* dst;
        if (job == 0 || job == 4) {
            const int np = (int)(i % NFF), k0 = (int)(i / NFF) * 8;
            const float* W = (job == 0 ? A.w1i : A.w2i) + (size_t)l * DM * NFF; const float* gn = (job == 0 ? A.n1 : A.n2) + l * DM;
            const int n = ((np & 128) ? DFF : 0) + (np >> 8) * 128 + (np & 127);
#pragma unroll
            for (int e = 0; e < 8; ++e) v[e] = W[(size_t)(k0 + e) * NFF + n] * gn[k0 + e];
            dst = (bf16_t*)(wl + (job == 0 ? 0 : SZ_W1I + SZ_W1O + SZ_WIN + SZ_WO)) + (size_t)np * DM + k0;
        } else if (job == 1 || job == 5) {
            const int np = (int)(i % DM), k0 = (int)(i / DM) * 8;
            const float* W = (job == 1 ? A.w1o : A.w2o) + (size_t)l * DFF * DM;
#pragma unroll
            for (int e = 0; e < 8; ++e) v[e] = W[(size_t)(k0 + e) * DM + np];
            dst = (bf16_t*)(wl + (job == 1 ? SZ_W1I : 2 * SZ_W1I + SZ_W1O + SZ_WIN + SZ_WO)) + (size_t)np * DFF + k0;
        } else if (job == 3) {
            const int np = (int)(i % DM), k0 = (int)(i / DM) * 8;
            const float* W = A.wo + (size_t)l * DM * DM;
#pragma unroll
            for (int e = 0; e < 8; ++e) v[e] = W[(size_t)(k0 + e) * DM + np];
            dst = (bf16_t*)(wl + SZ_W1I + SZ_W1O + SZ_WIN) + (size_t)np * DM + k0;
        } else {
            const int np = (int)(i % NP_), k0 = (int)(i / NP_) * 8;
            const float* W = A.wi + (size_t)l * DM * DINSRC; const float* gn = A.nm + l * DM;
            if (np >= 3584 && np < 4096) {
                const int d = np >= 3840 ? 1 : 0, c = np - 3584 - 256 * d;
                const float* G = A.wg + ((size_t)l * 2 + d) * 16 * 256;
                float gc[16];
#pragma unroll
                for (int r = 0; r < 16; ++r) gc[r] = G[r * 256 + c];
#pragma unroll
                for (int e = 0; e < 8; ++e) { const float* wr_ = W + (size_t)(k0 + e) * DINSRC + 3584 + 16 * d; float s = 0.f;
#pragma unroll
                    for (int r = 0; r < 16; ++r) s += wr_[r] * gc[r];
                    v[e] = s * gn[k0 + e]; }
            } else {
                const int n = np < 3584 ? np : 3616 + (np - 4096);
                const float sc = (np >= 2560 && np < 2816) ? 0.125f : 1.f;
#pragma unroll
                for (int e = 0; e < 8; ++e) v[e] = W[(size_t)(k0 + e) * DINSRC + n] * gn[k0 + e] * sc;
            }
            dst = (bf16_t*)(wl + SZ_W1I + SZ_W1O) + (size_t)np * DM + k0;
        }
        u32x4 w; w.x = pk2(v[0], v[1]); w.y = pk2(v[2], v[3]); w.z = pk2(v[4], v[5]); w.w = pk2(v[6], v[7]);
        *(u32x4*)dst = w;
    }
    float* lbt = (float*)(ws + OFF_LBT);
    for (long i = gt; i < 2048; i += nth) {
        const int l = (int)(i >> 10), c = (int)(i & 1023);
        const float a = A.lower_bounds[c], b = A.lower_bounds[1024 + c], mx = fmaxf(a, b);
        const float ea = __expf(a - mx), eb = __expf(b - mx);
        const float lb = l == 0 ? 0.f : eb / (ea + eb);
        lbt[l * 2048 + c] = fmaxf(lb, 1e-30f);
        lbt[l * 2048 + 1024 + c] = 1.f - lb;
    }
}

__device__ __forceinline__ void g0_prologue(const float* xp, const float* xs, unsigned char* ws, int g) {
    int tid_ = threadIdx.x; asm volatile("" : "+v"(tid_));
    const int lane = tid_ & 63, wv = blockIdx.x * 8 + (tid_ >> 6), nwv = gridDim.x * 8;
    bf16_t* XB = (bf16_t*)(ws + OFF_XB); float* ssq = (float*)(ws + OFF_SSQ);
    for (int r = wv; r < (g == 0 ? 65536 : 32768); r += nwv) {
        const int R = grow(g, r);
        const float* x = R < 32768 ? xp + (size_t)R * DM : xs + (size_t)(R - 32768) * DM;
        float s = 0.f;
#pragma unroll
        for (int i = 0; i < 4; ++i) { const f32x4 v = *(const f32x4*)(x + i * 256 + lane * 4);
            s += (v[0] * v[0] + v[1] * v[1]) + (v[2] * v[2] + v[3] * v[3]);
            u32x2 w; w.x = pk2(v[0], v[1]); w.y = pk2(v[2], v[3]); *(u32x2*)(XB + (size_t)r * DM + i * 256 + lane * 4) = w; }
#pragma unroll
        for (int o = 32; o >= 1; o >>= 1) s += bperm(s, (lane ^ o) << 2);
        if (lane < 4) *(f32x4*)(ssq + (size_t)R * 16 + 4 * lane) = (f32x4){lane == 0 ? s : 0.f, 0.f, 0.f, 0.f};
    }
}
__device__ __forceinline__ void final_norm(float* outp, const float* nf, unsigned char* ws, int g) {
    int tid_ = threadIdx.x; asm volatile("" : "+v"(tid_));
    const int lane = tid_ & 63, wv = blockIdx.x * 8 + (tid_ >> 6), nwv = gridDim.x * 8;
    const float* ssq = (const float*)(ws + OFF_SSQ) + 6 * SSQ_SITE; const bf16_t* XB = (const bf16_t*)(ws + OFF_XB);
    for (int r = wv; r < (g == 0 ? 65536 : 32768); r += nwv) {
        const int R = grow(g, r);
        float* x = outp + (size_t)R * DM;
        const f32x4 q0 = *(const f32x4*)(ssq + (size_t)R * 16), q1 = *(const f32x4*)(ssq + (size_t)R * 16 + 4), q2 = *(const f32x4*)(ssq + (size_t)R * 16 + 8), q3 = *(const f32x4*)(ssq + (size_t)R * 16 + 12);
        const float rs = rsqrtf((((q0[0] + q0[1]) + (q0[2] + q0[3])) + ((q1[0] + q1[1]) + (q1[2] + q1[3])) + (((q2[0] + q2[1]) + (q2[2] + q2[3])) + ((q3[0] + q3[1]) + (q3[2] + q3[3])))) * (1.f / 1024.f) + EPS);
#pragma unroll
        for (int i = 0; i < 4; ++i) { const int c = i * 256 + lane * 4; const u32x2 xv = *(const u32x2*)(XB + (size_t)r * DM + c); const f32x4 gn = *(const f32x4*)(nf + c);
            f32x4 v = {bflo(xv.x) * rs * gn[0], bfhi(xv.x) * rs * gn[1], bflo(xv.y) * rs * gn[2], bfhi(xv.y) * rs * gn[3]}; *(f32x4*)(x + c) = v; }
    }
}

#define MFMA32(a, b, c) __builtin_amdgcn_mfma_f32_32x32x16_bf16((a), (b), (c), 0, 0, 0)
constexpr int SC_QT = 0, SC_KT = 34816, SC_VT = 69632, SC_ST = 104448, SC_TOT = 139264, SC_VEC = 143360, SC_RED = 144896, SC_END = 145920;
constexpr int TSTR = 272;

template <int DK>
__device__ __forceinline__ void scan_half(LAS unsigned char* L, const bf16_t* __restrict__ P, bf16_t* RAW, bf16_t* OBF, const float* __restrict__ gain,
                                          int seqbase, int T, int dir, int qcol, int kcol, int gcol, int vcol, int gatecol, int ocol,
                                          int j0, int j1, bool second, f32x16& S0, f32x16& S1) {
    constexpr bool GLA = (DK == 64);
    constexpr int NPAIR = DK / 2, NSEG = NTHREADS / NPAIR, SL = 128 / NSEG, QSTR = (DK + 8) * 2, NKS = DK / 16;
    int tid_ = threadIdx.x; asm volatile("" : "+v"(tid_));
    const int tid = tid_, lane = tid & 63, w = __builtin_amdgcn_readfirstlane(tid >> 6);
    const int r = lane & 31, h = lane >> 5;
    const int cp = tid % NPAIR, seg = tid / NPAIR, vp = tid & 63, vseg = tid >> 6;
    const int tb = w >> 1, dh = w & 1, dvb_s = w & 3, kq = w >> 2;
    unsigned g2[SL], q2[SL], k2[SL], v2[16];

#define ROWOF(j, i) (seqbase + (dir ? (T - 1 - ((j) * 128 + (i))) : ((j) * 128 + (i))))
    const char* Pg = (const char*)P + gcol * 2; const char* Pq = (const char*)P + qcol * 2; const char* Pk = (const char*)P + kcol * 2; const char* Pv = (const char*)P + vcol * 2;
    const int rstep = dir ? -(NP_ * 2) : (NP_ * 2);
#define LOAD_CHUNK(j) do { int jj_ = (j); asm volatile("" : "+s"(jj_)); \
        { const int p0_ = jj_ * 128 + seg * SL; const int off0_ = (seqbase + (dir ? (T - 1 - p0_) : p0_)) * (NP_ * 2) + 4 * cp; \
          _Pragma("unroll") for (int i_ = 0; i_ < SL; ++i_) { const unsigned o_ = (unsigned)(off0_ + i_ * rstep); \
            g2[i_] = *(const unsigned*)(Pg + o_); q2[i_] = *(const unsigned*)(Pq + o_); if (GLA) k2[i_] = *(const unsigned*)(Pk + o_); else k2[i_] = 0u; } } \
        { const int p0_ = jj_ * 128 + vseg * 16; const int off0_ = (seqbase + (dir ? (T - 1 - p0_) : p0_)) * (NP_ * 2) + 4 * vp; \
          _Pragma("unroll") for (int i_ = 0; i_ < 16; ++i_) { const unsigned o_ = (unsigned)(off0_ + i_ * rstep); v2[i_] = *(const unsigned*)(Pv + o_); } } \
    } while (0)

    LOAD_CHUNK(j0);
    for (int j = j0; j < j1; ++j) {
        int rq = r * QSTR + 16 * h, rt = r * TSTR + 16 * h, rq8 = r * QSTR + 8 * h, rt8 = r * TSTR + 8 * h, h16 = 16 * h;
        asm volatile("" : "+v"(rq), "+v"(rt), "+v"(rq8), "+v"(rt8), "+v"(h16));
        f32x2 cs[SL];
        { f32x2 run = {0.f, 0.f};
#pragma unroll
          for (int i = 0; i < SL; ++i) { run = run + (f32x2){bflo(g2[i]), bfhi(g2[i])}; cs[i] = run; }
          *(LAS f32x2*)(L + SC_TOT + (seg * DK + 2 * cp) * 4) = run; }
        __syncthreads();
        f32x2 off = {0.f, 0.f}, mm = {0.f, 0.f}, bl = {0.f, 0.f};
#pragma unroll
        for (int s = 0; s < NSEG; ++s) { const f32x2 t = *(const LAS f32x2*)(L + SC_TOT + (s * DK + 2 * cp) * 4);
            if (s < seg) off = off + t;
            if (s < NSEG / 2) mm = mm + t;
            bl = bl + t; }
        unsigned kk[SL];
        const f32x2 dd = off - mm;
#pragma unroll
        for (int i = 0; i < SL; ++i) {
            f32x2 ee = cs[i] + dd;
            ee.x = __builtin_amdgcn_fmed3f(ee.x, -115.f, 115.f); ee.y = __builtin_amdgcn_fmed3f(ee.y, -115.f, 115.f);
            const f32x2 xx = {__builtin_amdgcn_exp2f(ee.x), __builtin_amdgcn_exp2f(ee.y)}, yy = {__builtin_amdgcn_exp2f(-ee.x), __builtin_amdgcn_exp2f(-ee.y)};
            f32x2 kv;
            if (GLA) kv = (f32x2){bflo(k2[i]), bfhi(k2[i])};
            else kv = (f32x2){1.f, 1.f} - (f32x2){__builtin_amdgcn_exp2f(bflo(g2[i])), __builtin_amdgcn_exp2f(bfhi(g2[i]))};
            const f32x2 qv = (f32x2){bflo(q2[i]), bfhi(q2[i])} * xx, kw = kv * yy;
            const unsigned qq = pk2(qv.x, qv.y);
            kk[i] = pk2(kw.x, kw.y);
            *(LAS unsigned*)(L + SC_QT + (seg * SL + i) * QSTR + 4 * cp) = qq;
            *(LAS unsigned*)(L + SC_KT + (seg * SL + i) * QSTR + 4 * cp) = kk[i];
        }
        {
            u32x4 a0, a1, b0, b1;
            a0.x = (v2[0] & 0xffffu) | (v2[1] << 16); a0.y = (v2[2] & 0xffffu) | (v2[3] << 16); a0.z = (v2[4] & 0xffffu) | (v2[5] << 16); a0.w = (v2[6] & 0xffffu) | (v2[7] << 16);
            a1.x = (v2[8] & 0xffffu) | (v2[9] << 16); a1.y = (v2[10] & 0xffffu) | (v2[11] << 16); a1.z = (v2[12] & 0xffffu) | (v2[13] << 16); a1.w = (v2[14] & 0xffffu) | (v2[15] << 16);
            b0.x = (v2[0] >> 16) | (v2[1] & 0xffff0000u); b0.y = (v2[2] >> 16) | (v2[3] & 0xffff0000u); b0.z = (v2[4] >> 16) | (v2[5] & 0xffff0000u); b0.w = (v2[6] >> 16) | (v2[7] & 0xffff0000u);
            b1.x = (v2[8] >> 16) | (v2[9] & 0xffff0000u); b1.y = (v2[10] >> 16) | (v2[11] & 0xffff0000u); b1.z = (v2[12] >> 16) | (v2[13] & 0xffff0000u); b1.w = (v2[14] >> 16) | (v2[15] & 0xffff0000u);
            LAS unsigned char* pv = L + SC_VT + (2 * vp) * TSTR + vseg * 32;
            *(LAS u32x4*)(pv) = a0; *(LAS u32x4*)(pv + 16) = a1; *(LAS u32x4*)(pv + TSTR) = b0; *(LAS u32x4*)(pv + TSTR + 16) = b1;
        }
        if (seg == 0) {
            *(LAS f32x2*)(L + SC_VEC + (2 * cp) * 4) = (f32x2){__builtin_amdgcn_exp2f(mm.x), __builtin_amdgcn_exp2f(mm.y)};
            *(LAS f32x2*)(L + SC_VEC + 512 + (2 * cp) * 4) = (f32x2){__builtin_amdgcn_exp2f(bl.x), __builtin_amdgcn_exp2f(bl.y)};
            *(LAS f32x2*)(L + SC_VEC + 1024 + (2 * cp) * 4) = (f32x2){__builtin_amdgcn_exp2f(bl.x - mm.x), __builtin_amdgcn_exp2f(bl.y - mm.y)};
        }
        __syncthreads();
#pragma unroll
        for (int ti = 0; ti < (GLA ? 1 : 2); ++ti) {
            const int kb_ = GLA ? kq : 2 * kq + ti;
            const f32x16& Sx = ti == 0 ? S0 : S1;
#pragma unroll
            for (int gq = 0; gq < 4; ++gq) {
                const int k = 32 * kb_ + 8 * gq + 4 * h;
                const f32x4 em = *(const LAS f32x4*)(L + SC_VEC + (32 * kb_ + 8 * gq) * 4 + h16);
                u32x2 wv; wv.x = pk2(Sx[4 * gq] * em[0], Sx[4 * gq + 1] * em[1]); wv.y = pk2(Sx[4 * gq + 2] * em[2], Sx[4 * gq + 3] * em[3]);
                *(LAS u32x2*)(L + SC_ST + 32 * dvb_s * QSTR + rq8 + (32 * kb_ + 8 * gq) * 2) = wv;
            }
        }
        bf16x8 ps[4][2];
        {
            bf16x8 qf[NKS];
#pragma unroll
            for (int ks = 0; ks < NKS; ++ks) qf[ks] = *(const LAS bf16x8*)(L + SC_QT + 32 * tb * QSTR + rq + 32 * ks);
#pragma unroll
            for (int sb = 0; sb < 4; ++sb) {
                if (sb <= tb) {
                    bf16x8 af[NKS];
#pragma unroll
                    for (int ks = 0; ks < NKS; ++ks) af[ks] = *(const LAS bf16x8*)(L + SC_KT + 32 * sb * QSTR + rq + 32 * ks);
                    f32x16 x;
#pragma unroll
                    for (int i = 0; i < 16; ++i) x[i] = 0.f;
#pragma unroll
                    for (int ks = 0; ks < NKS; ++ks) x = MFMA32(af[ks], qf[ks], x);
                    if (sb == tb) {
#pragma unroll
                        for (int i = 0; i < 16; ++i) { const int cr = (i & 3) + 8 * (i >> 2) + 4 * h; x[i] = cr <= r ? x[i] : 0.f; }
                    }
#pragma unroll
                    for (int ss = 0; ss < 2; ++ss) { u32x4 pw; pw.x = pk2(x[8 * ss], x[8 * ss + 1]); pw.y = pk2(x[8 * ss + 2], x[8 * ss + 3]); pw.z = pk2(x[8 * ss + 4], x[8 * ss + 5]); pw.w = pk2(x[8 * ss + 6], x[8 * ss + 7]);
                        ps[sb][ss] = __builtin_bit_cast(bf16x8, pw); }
                } else { ps[sb][0] = (bf16x8){0, 0, 0, 0, 0, 0, 0, 0}; ps[sb][1] = (bf16x8){0, 0, 0, 0, 0, 0, 0, 0}; }
            }
        }
        __syncthreads();
        {
            LAS unsigned char* pk_ = L + SC_KT + (2 * cp) * TSTR + seg * SL * 2;
            if (SL == 16) {
                u32x4 a0, a1, b0, b1;
                a0.x = (kk[0] & 0xffffu) | (kk[1] << 16); a0.y = (kk[2] & 0xffffu) | (kk[3] << 16); a0.z = (kk[4] & 0xffffu) | (kk[5] << 16); a0.w = (kk[6] & 0xffffu) | (kk[7] << 16);
                a1.x = (kk[8 % SL] & 0xffffu) | (kk[9 % SL] << 16); a1.y = (kk[10 % SL] & 0xffffu) | (kk[11 % SL] << 16); a1.z = (kk[12 % SL] & 0xffffu) | (kk[13 % SL] << 16); a1.w = (kk[14 % SL] & 0xffffu) | (kk[15 % SL] << 16);
                b0.x = (kk[0] >> 16) | (kk[1] & 0xffff0000u); b0.y = (kk[2] >> 16) | (kk[3] & 0xffff0000u); b0.z = (kk[4] >> 16) | (kk[5] & 0xffff0000u); b0.w = (kk[6] >> 16) | (kk[7] & 0xffff0000u);
                b1.x = (kk[8 % SL] >> 16) | (kk[9 % SL] & 0xffff0000u); b1.y = (kk[10 % SL] >> 16) | (kk[11 % SL] & 0xffff0000u); b1.z = (kk[12 % SL] >> 16) | (kk[13 % SL] & 0xffff0000u); b1.w = (kk[14 % SL] >> 16) | (kk[15 % SL] & 0xffff0000u);
                *(LAS u32x4*)(pk_) = a0; *(LAS u32x4*)(pk_ + 16) = a1; *(LAS u32x4*)(pk_ + TSTR) = b0; *(LAS u32x4*)(pk_ + TSTR + 16) = b1;
            } else {
                u32x4 a0, b0;
                a0.x = (kk[0] & 0xffffu) | (kk[1] << 16); a0.y = (kk[2] & 0xffffu) | (kk[3] << 16); a0.z = (kk[4] & 0xffffu) | (kk[5] << 16); a0.w = (kk[6] & 0xffffu) | (kk[7] << 16);
                b0.x = (kk[0] >> 16) | (kk[1] & 0xffff0000u); b0.y = (kk[2] >> 16) | (kk[3] & 0xffff0000u); b0.z = (kk[4] >> 16) | (kk[5] & 0xffff0000u); b0.w = (kk[6] >> 16) | (kk[7] & 0xffff0000u);
                *(LAS u32x4*)(pk_) = a0; *(LAS u32x4*)(pk_ + TSTR) = b0;
            }
        }
        const int orow = ROWOF(j, 32 * tb + r);
        f32x16 O[2];
        {
            bf16x8 qf[NKS];
#pragma unroll
            for (int ks = 0; ks < NKS; ++ks) qf[ks] = *(const LAS bf16x8*)(L + SC_QT + 32 * tb * QSTR + rq + 32 * ks);
#pragma unroll
            for (int dvi = 0; dvi < 2; ++dvi) {
                const int dvb = 2 * dh + dvi;
                bf16x8 sf[NKS];
#pragma unroll
                for (int ks = 0; ks < NKS; ++ks) sf[ks] = *(const LAS bf16x8*)(L + SC_ST + 32 * dvb * QSTR + rq + 32 * ks);
                f32x16 o;
#pragma unroll
                for (int i = 0; i < 16; ++i) o[i] = 0.f;
#pragma unroll
                for (int ks = 0; ks < NKS; ++ks) o = MFMA32(sf[ks], qf[ks], o);
                O[dvi] = o;
            }
        }
        u32x2 praw[2][4];
        if (second) {
#pragma unroll
            for (int dvi = 0; dvi < 2; ++dvi)
#pragma unroll
                for (int gq = 0; gq < 4; ++gq) praw[dvi][gq] = *(const u32x2*)(RAW + (size_t)orow * DM + ocol + 32 * (2 * dh + dvi) + 8 * gq + 4 * h);
        }
#pragma unroll
        for (int dvi = 0; dvi < 2; ++dvi) {
            const int dvb = 2 * dh + dvi;
            f32x16 o = O[dvi];
#pragma unroll
            for (int sb = 0; sb < 4; ++sb) {
                if (sb <= tb) {
                    const LAS unsigned char* pa = L + SC_VT + 32 * dvb * TSTR + rt8 + 64 * sb;
                    const s16x4 l0 = *(const LAS s16x4*)(pa), h0 = *(const LAS s16x4*)(pa + 16), l1 = *(const LAS s16x4*)(pa + 32), h1 = *(const LAS s16x4*)(pa + 48);
                    o = MFMA32(__builtin_shufflevector(l0, h0, 0, 1, 2, 3, 4, 5, 6, 7), ps[sb][0], o);
                    o = MFMA32(__builtin_shufflevector(l1, h1, 0, 1, 2, 3, 4, 5, 6, 7), ps[sb][1], o);
                }
            }
            O[dvi] = o;
        }
        if (!second) {
#pragma unroll
            for (int dvi = 0; dvi < 2; ++dvi)
#pragma unroll
                for (int gq = 0; gq < 4; ++gq) {
                    const int dv = 32 * (2 * dh + dvi) + 8 * gq + 4 * h;
                    u32x2 wv; wv.x = pk2(O[dvi][4 * gq], O[dvi][4 * gq + 1]); wv.y = pk2(O[dvi][4 * gq + 2], O[dvi][4 * gq + 3]);
                    *(u32x2*)(RAW + (size_t)orow * DM + ocol + dv) = wv;
                }
        } else {
            float ssum = 0.f;
#pragma unroll
            for (int dvi = 0; dvi < 2; ++dvi)
#pragma unroll
                for (int gq = 0; gq < 4; ++gq) {
                    const u32x2 pw_ = praw[dvi][gq]; const f32x4 pr = {bflo(pw_.x), bfhi(pw_.x), bflo(pw_.y), bfhi(pw_.y)};
#pragma unroll
                    for (int e = 0; e < 4; ++e) { const float t = O[dvi][4 * gq + e] + pr[e]; O[dvi][4 * gq + e] = t; ssum += t * t; }
                }
            ssum += bperm(ssum, (lane ^ 32) << 2);
            if (h == 0) *(LAS float*)(L + SC_RED + (w * 32 + r) * 4) = ssum;
        }
        __syncthreads();
        if (second) {
            const float tot = *(const LAS float*)(L + SC_RED + ((w & ~1) * 32 + r) * 4) + *(const LAS float*)(L + SC_RED + ((w | 1) * 32 + r) * 4);
            const float rs = __builtin_amdgcn_rsqf(tot * (1.f / 128.f) + EPS);
#pragma unroll
            for (int dvi = 0; dvi < 2; ++dvi)
#pragma unroll
                for (int gq = 0; gq < 4; ++gq) {
                    const int dv = 32 * (2 * dh + dvi) + 8 * gq + 4 * h;
                    const f32x4 gn = *(const f32x4*)(gain + dv);
                    const u32x2 gt = *(const u32x2*)(P + (size_t)orow * NP_ + gatecol + dv);
                    u32x2 wv; wv.x = pk2(O[dvi][4 * gq] * rs * gn[0] * bflo(gt.x), O[dvi][4 * gq + 1] * rs * gn[1] * bfhi(gt.x));
                    wv.y = pk2(O[dvi][4 * gq + 2] * rs * gn[2] * bflo(gt.y), O[dvi][4 * gq + 3] * rs * gn[3] * bfhi(gt.y));
                    *(u32x2*)(OBF + (size_t)orow * DM + ocol + dv) = wv;
                }
        }
        if (j + 1 < j1) LOAD_CHUNK(j + 1);
        {
            bf16x8 vb[8];
#pragma unroll
            for (int ks = 0; ks < 8; ++ks) vb[ks] = *(const LAS bf16x8*)(L + SC_VT + 32 * dvb_s * TSTR + rt + 32 * ks);
#pragma unroll
            for (int ti = 0; ti < (GLA ? 1 : 2); ++ti) {
                const int kb_ = GLA ? kq : 2 * kq + ti;
                bf16x8 ka[8];
#pragma unroll
                for (int ks = 0; ks < 8; ++ks) ka[ks] = *(const LAS bf16x8*)(L + SC_KT + 32 * kb_ * TSTR + rt + 32 * ks);
                f32x16 pkv;
#pragma unroll
                for (int i = 0; i < 16; ++i) pkv[i] = 0.f;
#pragma unroll
                for (int ks = 0; ks < 8; ++ks) pkv = MFMA32(ka[ks], vb[ks], pkv);
                f32x16& Sx = ti == 0 ? S0 : S1;
#pragma unroll
                for (int gq = 0; gq < 4; ++gq) {
                    const int k = 32 * kb_ + 8 * gq + 4 * h;
                    const f32x4 eb = *(const LAS f32x4*)(L + SC_VEC + 512 + (32 * kb_ + 8 * gq) * 4 + h16), ebm = *(const LAS f32x4*)(L + SC_VEC + 1024 + (32 * kb_ + 8 * gq) * 4 + h16);
                    { const f32x2 s01 = (f32x2){eb[0], eb[1]} * (f32x2){Sx[4 * gq], Sx[4 * gq + 1]} + (f32x2){ebm[0], ebm[1]} * (f32x2){pkv[4 * gq], pkv[4 * gq + 1]};
                      const f32x2 s23 = (f32x2){eb[2], eb[3]} * (f32x2){Sx[4 * gq + 2], Sx[4 * gq + 3]} + (f32x2){ebm[2], ebm[3]} * (f32x2){pkv[4 * gq + 2], pkv[4 * gq + 3]};
                      Sx[4 * gq] = s01.x; Sx[4 * gq + 1] = s01.y; Sx[4 * gq + 2] = s23.x; Sx[4 * gq + 3] = s23.y; }
                }
            }
        }
    }
    __syncthreads();
#undef ROWOF
#undef LOAD_CHUNK
}


template <class T> __device__ __forceinline__ T* opaque_ptr(T* p) { __attribute__((address_space(1))) T* gp = (__attribute__((address_space(1))) T*)p; asm volatile("" : "+s"(gp)); return (T*)gp; }
__device__ __forceinline__ unsigned opaque_zero() { unsigned z; asm volatile("s_mov_b32 %0, 0" : "=s"(z)); return z; }
__device__ __forceinline__ void gbar(unsigned* ctr, unsigned target) {
    asm volatile("s_waitcnt vmcnt(0)" ::: "memory");
    __syncthreads();
    if (threadIdx.x == 0) {
        __builtin_amdgcn_fence(__ATOMIC_RELEASE, "agent");
        asm volatile("s_waitcnt vmcnt(0)" ::: "memory");
        __hip_atomic_fetch_add(ctr, 1u, __ATOMIC_RELAXED, __HIP_MEMORY_SCOPE_AGENT);
        while (__hip_atomic_load(ctr, __ATOMIC_RELAXED, __HIP_MEMORY_SCOPE_AGENT) < target) __builtin_amdgcn_s_sleep(2);
        __builtin_amdgcn_fence(__ATOMIC_ACQUIRE, "agent");
        asm volatile("s_waitcnt vmcnt(0)" ::: "memory");
    }
    __syncthreads();
}

__global__ void __launch_bounds__(NTHREADS) hymba_fwd(Args A) {
    extern __shared__ __attribute__((aligned(16))) unsigned char lds_raw[];
    cg::grid_group grid = cg::this_grid();
    unsigned nbar = 0;
#define PH_BEGIN() const unsigned zs = opaque_zero(); LAS unsigned char* L = (LAS unsigned char*)lds_raw + zs; unsigned char* ws = opaque_ptr(A.ws); const int G = (int)(gridDim.x + zs), bid = (int)(blockIdx.x + zs); const float* xp = opaque_ptr(A.xp); const float* xs = opaque_ptr(A.xs); float* outp = opaque_ptr(A.out); (void)L; (void)ws; (void)G; (void)bid; (void)xp; (void)xs; (void)outp
#define GBAR() do { for (int rb_ = 0; rb_ < PROBE_BAR; ++rb_) { nbar += 256u; gbar((unsigned*)(A.ws + OFF_BAR + opaque_zero()), nbar); } } while (0)

    for (int rep = 0; rep < PROBE_P0; ++rep) { PH_BEGIN(); p0_convert(A); }
    grid.sync();

#pragma unroll 1
    for (int g = 0; g < NGRP; ++g) {
        const int MGg = g == 0 ? 65536 : 32768;
        for (int rep = 0; rep < PROBE_G0F; ++rep) { PH_BEGIN(); g0_prologue(xp, xs, ws, g); }
        GBAR();
#pragma unroll 1
        for (int l = 0; l < 2; ++l) {
            const size_t wlo = OFF_W + (size_t)l * SZ_LAYER;
            const size_t sq = OFF_SSQ + (size_t)(3 * l) * SSQ_SITE * 4;
            for (int rep = 0; rep < PROBE_FFNIN; ++rep) { PH_BEGIN(); pg8::Gemm gm{(const bf16_t*)(ws + OFF_XB), (const bf16_t*)(ws + wlo), MGg, NFF, DM}; pg8::StaticOrder S; S.init(MGg, NFF, G, bid);
              EpiFfnIn E{(bf16_t*)(ws + OFF_PH), (const float*)(ws + sq), g}; pg8::gemm_phase(L, gm, S, E); }
            GBAR();
            for (int rep = 0; rep < PROBE_FFNOUT_NULL; ++rep) { PH_BEGIN(); pg8::Gemm gm{(const bf16_t*)(ws + OFF_PH), (const bf16_t*)(ws + wlo + SZ_W1I), MGg, DM, DFF}; pg8::StaticOrder S; S.init(MGg, DM, G, bid); EpiNull E{(float*)(ws + OFF_RAW)}; pg8::gemm_phase(L, gm, S, E); }
            { PH_BEGIN(); pg8::Gemm gm{(const bf16_t*)(ws + OFF_PH), (const bf16_t*)(ws + wlo + SZ_W1I), MGg, DM, DFF}; pg8::StaticOrder S; S.init(MGg, DM, G, bid);
              EpiRes E{(bf16_t*)(ws + OFF_XB), (float*)(ws + sq) + SSQ_SITE, 0.5f, g}; pg8::gemm_phase(L, gm, S, E); }
            GBAR();
            for (int rep = 0; rep < PROBE_WIN; ++rep) { PH_BEGIN(); pg8::Gemm gm{(const bf16_t*)(ws + OFF_XB), (const bf16_t*)(ws + wlo + SZ_W1I + SZ_W1O), MGg, NP_, DM}; pg8::StaticOrder S; S.init(MGg, NP_, G, bid);
              const float* LBT = (const float*)(ws + OFF_LBT) + l * 2048;
              EpiWin E{(bf16_t*)(ws + OFF_PH), (const float*)(ws + sq) + SSQ_SITE, LBT, LBT + 1024, A.bg + l * 512, g}; pg8::gemm_phase(L, gm, S, E); }
            GBAR();
            for (int rep = 0; rep < PROBE_SCAN; ++rep) {
                f32x16 S0, S1;
#pragma unroll
                for (int i = 0; i < 16; ++i) { S0[i] = 0.f; S1[i] = 0.f; }
#pragma unroll 1
                for (int half = 0; half < 2; ++half) {
                    { PH_BEGIN();
                      const bf16_t* PH = (const bf16_t*)(ws + OFF_PH); bf16_t* RAW = (bf16_t*)(ws + OFF_RAW); bf16_t* OBF = (bf16_t*)(ws + OFF_OBF);
                      const int dir = bid & 1, hh = (bid >> 1) & 7, sidx = (bid >> 4) & 15;
                      const int T = g == 0 ? TSAMPLE : TPROMPT, seqbase = sidx * T, N = T / 128;
                      const int j0 = half ? N / 2 : 0, j1 = half ? N : N / 2;
                      if (hh < 4) { const int hd = hh;
                          scan_half<128>(L, PH, RAW, OBF, A.hgn + l * 512 + 128 * hd, seqbase, T, dir, 128 * hd, 0, (dir ? 1024 : 512) + 128 * hd, 1536 + 128 * hd, 2048 + 128 * hd, 128 * hd, j0, j1, half != 0, S0, S1);
                      } else { const int hd = hh - 4;
                          scan_half<64>(L, PH, RAW, OBF, A.glan + l * 512 + 128 * hd, seqbase, T, dir, 2560 + 64 * hd, 2816 + 64 * hd, (dir ? 3840 : 3584) + 64 * hd, 3072 + 128 * hd, 4096 + 128 * hd, 512 + 128 * hd, j0, j1, half != 0, S0, S1);
                      } }
                    GBAR();
                }
            }
            { PH_BEGIN(); pg8::Gemm gm{(const bf16_t*)(ws + OFF_OBF), (const bf16_t*)(ws + wlo + SZ_W1I + SZ_W1O + SZ_WIN), MGg, DM, DM}; pg8::StaticOrder S; S.init(MGg, DM, G, bid);
              EpiRes E{(bf16_t*)(ws + OFF_XB), (float*)(ws + sq) + 2 * SSQ_SITE, 1.0f, g}; pg8::gemm_phase(L, gm, S, E); }
            GBAR();
            for (int rep = 0; rep < PROBE_FFNIN; ++rep) { PH_BEGIN(); pg8::Gemm gm{(const bf16_t*)(ws + OFF_XB), (const bf16_t*)(ws + wlo + SZ_W1I + SZ_W1O + SZ_WIN + SZ_WO), MGg, NFF, DM}; pg8::StaticOrder S; S.init(MGg, NFF, G, bid);
              EpiFfnIn E{(bf16_t*)(ws + OFF_PH), (const float*)(ws + sq) + 2 * SSQ_SITE, g}; pg8::gemm_phase(L, gm, S, E); }
            GBAR();
            for (int rep = 0; rep < PROBE_FFNOUT_NULL; ++rep) { PH_BEGIN(); pg8::Gemm gm{(const bf16_t*)(ws + OFF_PH), (const bf16_t*)(ws + wlo + 2 * SZ_W1I + SZ_W1O + SZ_WIN + SZ_WO), MGg, DM, DFF}; pg8::StaticOrder S; S.init(MGg, DM, G, bid); EpiNull E{(float*)(ws + OFF_RAW)}; pg8::gemm_phase(L, gm, S, E); }
            { PH_BEGIN(); pg8::Gemm gm{(const bf16_t*)(ws + OFF_PH), (const bf16_t*)(ws + wlo + 2 * SZ_W1I + SZ_W1O + SZ_WIN + SZ_WO), MGg, DM, DFF}; pg8::StaticOrder S; S.init(MGg, DM, G, bid);
              EpiRes E{(bf16_t*)(ws + OFF_XB), (float*)(ws + sq) + 3 * SSQ_SITE, 0.5f, g}; pg8::gemm_phase(L, gm, S, E); }
            GBAR();
        }
        for (int rep = 0; rep < PROBE_G0F; ++rep) { PH_BEGIN(); final_norm(outp, opaque_ptr(A.nf), ws, g); }
    }
#undef PH_BEGIN
#undef GBAR
}

constexpr int LDS_BYTES = 146432;
extern "C" void kernel_launch(void* const* d_in, const int* in_sizes, int n_in, void* d_out, int out_size, void* d_ws, size_t ws_size, hipStream_t stream) {
    static int ready = 0;
    if (!ready) {
        if (n_in != 17 || out_size != MTOT * DM || ws_size < WS_END) { fprintf(stderr, "kernel_launch: unexpected shapes (n_in %d out %d ws %zu need %zu)\n", n_in, out_size, ws_size, (size_t)WS_END); ready = -1; return; }
        if (hipFuncSetAttribute((const void*)hymba_fwd, hipFuncAttributeMaxDynamicSharedMemorySize, LDS_BYTES) != hipSuccess) { fprintf(stderr, "kernel_launch: hipFuncSetAttribute failed\n"); ready = -1; return; }
        int per_cu = 0; (void)hipOccupancyMaxActiveBlocksPerMultiprocessor(&per_cu, (const void*)hymba_fwd, NTHREADS, LDS_BYTES); (void)hipGetLastError();
        ready = 1;
    }
    if (ready < 0) return;
    if (hipMemsetAsync((char*)d_ws + OFF_BAR, 0, 256, stream) != hipSuccess) { fprintf(stderr, "kernel_launch: memset failed\n"); return; }
    Args a{};
    a.xp = (const float*)d_in[0]; a.xs = (const float*)d_in[1]; a.lower_bounds = (const float*)d_in[2]; a.n1 = (const float*)d_in[3]; a.w1i = (const float*)d_in[4]; a.w1o = (const float*)d_in[5];
    a.nm = (const float*)d_in[6]; a.wi = (const float*)d_in[7]; a.wg = (const float*)d_in[8]; a.bg = (const float*)d_in[9]; a.hgn = (const float*)d_in[10]; a.glan = (const float*)d_in[11];
    a.wo = (const float*)d_in[12]; a.n2 = (const float*)d_in[13]; a.w2i = (const float*)d_in[14]; a.w2o = (const float*)d_in[15]; a.nf = (const float*)d_in[16];
    a.out = (float*)d_out; a.ws = (unsigned char*)d_ws;
    void* args[] = {&a};
    hipError_t e = hipLaunchCooperativeKernel((const void*)hymba_fwd, dim3(256), dim3(NTHREADS), args, LDS_BYTES, stream);
    if (e != hipSuccess) fprintf(stderr, "cooperative launch failed: %s\n", hipGetErrorString(e));
}
```

```cpp
#include <hip/hip_runtime.h>
#include <hip/hip_cooperative_groups.h>
#include <cstdio>
namespace cg = cooperative_groups;

#define LAS __attribute__((address_space(3)))
typedef unsigned short bf16_t;
typedef short bf16x8 __attribute__((ext_vector_type(8)));
typedef short s16x4 __attribute__((ext_vector_type(4)));
typedef float f32x2 __attribute__((ext_vector_type(2)));
typedef float f32x4 __attribute__((ext_vector_type(4)));
typedef float f32x16 __attribute__((ext_vector_type(16)));
typedef unsigned u32x2 __attribute__((ext_vector_type(2)));
typedef unsigned u32x4 __attribute__((ext_vector_type(4)));

constexpr int DM = 1024, DFF = 2816, NFF = 5632, DINSRC = 4128, NP_ = 4608;
constexpr int MTOT = 98304, MGMAX = 65536, NGRP = 2;
constexpr int TPROMPT = 2048, TSAMPLE = 4096;
constexpr float EPS = 1e-6f;
constexpr int NTHREADS = 512;
#ifndef PROBE_SCAN
#define PROBE_SCAN 1
#endif
#ifndef PROBE_FFNIN
#define PROBE_FFNIN 1
#endif
#ifndef PROBE_P0
#define PROBE_P0 1
#endif
#ifndef PROBE_WIN
#define PROBE_WIN 1
#endif
#ifndef PROBE_FFNOUT_NULL
#define PROBE_FFNOUT_NULL 0
#endif
#ifndef PROBE_G0F
#define PROBE_G0F 1
#endif
#ifndef PROBE_BAR
#define PROBE_BAR 1
#endif

constexpr size_t SZ_W1I = (size_t)NFF * DM * 2, SZ_W1O = (size_t)DM * DFF * 2, SZ_WIN = (size_t)NP_ * DM * 2, SZ_WO = (size_t)DM * DM * 2;
constexpr size_t SZ_LAYER = 2 * SZ_W1I + 2 * SZ_W1O + SZ_WIN + SZ_WO;
constexpr size_t OFF_W = 0;
constexpr size_t OFF_LBT = OFF_W + 2 * SZ_LAYER;
constexpr size_t OFF_SSQ = OFF_LBT + 2 * 2 * 1024 * 4;
constexpr size_t SSQ_SITE = (size_t)MTOT * 16;
constexpr size_t OFF_XB = OFF_SSQ + 7 * SSQ_SITE * 4;
constexpr size_t OFF_OBF = OFF_XB + (size_t)MGMAX * DM * 2;
constexpr size_t OFF_RAW = OFF_OBF;
constexpr size_t OFF_PH = OFF_OBF + (size_t)MGMAX * DM * 2;
constexpr size_t OFF_BAR = OFF_PH + (size_t)MGMAX * NP_ * 2;
constexpr size_t WS_END = OFF_BAR + 256;

__device__ __forceinline__ unsigned pk2(float lo, float hi) {
    typedef __bf16 bf2 __attribute__((ext_vector_type(2)));
    f32x2 v = {lo, hi};
    return __builtin_bit_cast(unsigned, __builtin_convertvector(v, bf2));
}
__device__ __forceinline__ float bflo(unsigned u) { return __uint_as_float(u << 16); }
__device__ __forceinline__ float bfhi(unsigned u) { return __uint_as_float(u & 0xffff0000u); }
__device__ __forceinline__ int grow_tile(int g, int pm) { return (g == 0 ? 32768 : 0) + pm * 256; }
__device__ __forceinline__ int grow(int g, int r) { return (g == 0 ? 32768 : 0) + r; }
__device__ __forceinline__ float sigmoid_f(float x) { return __builtin_amdgcn_rcpf(1.f + __builtin_amdgcn_exp2f(x * -1.44269504f)); }
__device__ __forceinline__ float log2sig_f(float z) { return fminf(z, 0.f) * 1.44269504f - __builtin_amdgcn_logf(1.f + __builtin_amdgcn_exp2f(fabsf(z) * -1.44269504f)); }

__device__ __forceinline__ float bperm(float x, int byte_idx) { return __int_as_float(__builtin_amdgcn_ds_bpermute(byte_idx, __float_as_int(x))); }
__device__ __forceinline__ float row_rstd(const float* ssq16, int R, int fq, int i16, int i32) {
    const f32x4 v = *(const f32x4*)(ssq16 + (size_t)R * 16 + 4 * fq);
    float s = (v[0] + v[1]) + (v[2] + v[3]);
    s += bperm(s, i16); s += bperm(s, i32);
    return rsqrtf(s * (1.f / 1024.f) + EPS);
}

__device__ __forceinline__ void rows_rstd8(float (&rs)[8], const float* ssq16, int Rbase  , int fq, int i16, int i32) {
    f32x4 v[8];
#pragma unroll
    for (int q = 0; q < 8; ++q) v[q] = *(const f32x4*)(ssq16 + (size_t)(Rbase + (q >> 2) * 128 + (q & 3) * 16) * 16 + 4 * fq);
    float s1[8], t1[8];
#pragma unroll
    for (int q = 0; q < 8; ++q) s1[q] = (v[q][0] + v[q][1]) + (v[q][2] + v[q][3]);
#pragma unroll
    for (int q = 0; q < 8; ++q) t1[q] = bperm(s1[q], i16);
#pragma unroll
    for (int q = 0; q < 8; ++q) s1[q] += t1[q];
#pragma unroll
    for (int q = 0; q < 8; ++q) t1[q] = bperm(s1[q], i32);
#pragma unroll
    for (int q = 0; q < 8; ++q) rs[q] = __builtin_amdgcn_rsqf((s1[q] + t1[q]) * (1.f / 1024.f) + EPS);
}

namespace pg8 {
constexpr int BM = 256, BK = 64, HALF = 128, HTB = HALF * BK * 2, STAGE_BYTES = 8 * HTB, NXCD = 8, WGM = 8;
__device__ __forceinline__ int lds_byte(int r, int c) { const int st = (r >> 4) * 2 + (c >> 5), rr = r & 15, cc = c & 31, ob = rr * 64 + cc * 2; return st * 1024 + (ob ^ (((ob >> 9) & 1) << 5)); }
__device__ __forceinline__ void stage_rc(int b, int& R, int& C) { const int st = b / 1024, sb = b % 1024, swz = sb ^ (((sb >> 9) & 1) << 5); R = (st >> 1) * 16 + swz / 64; C = (st & 1) * 32 + (swz % 64) / 2; }
__device__ __forceinline__ int perm32(int rho) { const int n = rho >> 4, i = rho & 15; return 8 * (i >> 2) + 4 * n + (i & 3); }
struct Unit { int pm, pn; };
struct Gemm { const bf16_t* A; const bf16_t* Bt; int M, N, K; };
struct StaticOrder {
    int nM, nN, nwg, G, c;
    __device__ void init(int M, int N, int G_, int c_) { nM = M / BM; nN = N / BM; nwg = nM * nN; G = G_; c = c_; }
    __device__ bool next(int i, Unit& u) const {
        const long L = (long)i * G + c; if (L >= nwg) return false;
        int wgid = (int)L; { const int q = nwg / NXCD, r = nwg % NXCD, xcd = wgid % NXCD, off = wgid / NXCD; wgid = (xcd < r ? xcd * (q + 1) : r * (q + 1) + (xcd - r) * q) + off; }
        const int nig = WGM * nN, gid = wgid / nig, fm = gid * WGM, gsz = (nM - fm) < WGM ? (nM - fm) : WGM;
        u.pm = fm + ((wgid % nig) % gsz); u.pn = (wgid % nig) / gsz; return true;
    }
};

template <class Epi>
__device__ __forceinline__ void gemm_phase(LAS unsigned char* lds, const Gemm g, const StaticOrder& S, const Epi& E) {
    int tid_ = threadIdx.x; asm volatile("" : "+v"(tid_));
    const int tid = tid_, wid = __builtin_amdgcn_readfirstlane(tid >> 6), lane = tid & 63, wr = wid >> 2, wc = wid & 3, fr = lane & 15, fq = lane >> 4;
    const int K = g.K, nt = K / BK;
    unsigned voffA[2], voffB[2];
#pragma unroll
    for (int i = 0; i < 2; ++i) { int R, C; stage_rc(tid * 16 + i * 8192, R, C); const int Rb = Epi::PERM ? ((R & ~31) + perm32(R & 31)) : R;
        voffA[i] = (unsigned)(R * K + C) * 2u; voffB[i] = (unsigned)(Rb * K + C) * 2u; }
    const size_t kstep = (size_t)(BK * 2);
    const size_t hstep = (size_t)HALF * K * 2;
    const size_t tstep = 2 * hstep;
    const unsigned ldsw = (unsigned)wid * 1024u;
    const int aoff = lds_byte(wr * 64 + fr, fq * 8), boff = lds_byte(wc * 32 + fr, fq * 8);
#define PG8_SA(b, h) (((b) * 2 + (h)) * HTB)
#define PG8_SB(b, h) ((4 + (b) * 2 + (h)) * HTB)
#define PG8_STAGE(bufoff, gbase, voff) do { _Pragma("unroll") for (int _i = 0; _i < 2; ++_i) \
        __builtin_amdgcn_global_load_lds((const unsigned*)((const char*)(gbase) + (voff)[_i]), (LAS unsigned*)(lds + (bufoff) + ldsw + _i * 8192), 16, 0, 0); } while (0)
#define PG8_LDA(dst, b, h) do { _Pragma("unroll") for (int m = 0; m < 4; ++m) _Pragma("unroll") for (int k = 0; k < 2; ++k) dst[m][k] = *(const LAS bf16x8*)(lds + PG8_SA(b, h) + aoff + m * 2048 + k * 1024); } while (0)
#define PG8_LDB(dst, b, h) do { _Pragma("unroll") for (int n = 0; n < 2; ++n) _Pragma("unroll") for (int k = 0; k < 2; ++k) dst[n][k] = *(const LAS bf16x8*)(lds + PG8_SB(b, h) + boff + n * 2048 + k * 1024); } while (0)
#define PG8_MMA(ai, bj, At, Bt) do { __builtin_amdgcn_s_setprio(1); _Pragma("unroll") for (int m = 0; m < 4; ++m) _Pragma("unroll") for (int n = 0; n < 2; ++n) _Pragma("unroll") for (int k = 0; k < 2; ++k) \
        acc[ai][bj][m][n] = __builtin_amdgcn_mfma_f32_16x16x32_bf16(Bt[n][k], At[m][k], acc[ai][bj][m][n], 0, 0, 0); __builtin_amdgcn_s_setprio(0); } while (0)
#define PG8_WAIT_V(n) asm volatile("s_waitcnt vmcnt(" #n ")" ::: "memory")
#define PG8_WAIT_L(n) asm volatile("s_waitcnt lgkmcnt(" #n ")" ::: "memory")
#define PG8_BAR __builtin_amdgcn_s_barrier()
#define PG8_SCHED __builtin_amdgcn_sched_barrier(0)
    Unit cur, nxt; int ui = 0;
    if (!S.next(0, cur)) return;
    f32x4 acc[2][2][4][2];
#pragma unroll
    for (int a = 0; a < 2; ++a)
#pragma unroll
        for (int b = 0; b < 2; ++b)
#pragma unroll
            for (int m = 0; m < 4; ++m)
#pragma unroll
                for (int n = 0; n < 2; ++n) acc[a][b][m][n] = (f32x4){0.f, 0.f, 0.f, 0.f};
    bf16x8 At[4][2], B0[2][2], B1[2][2];
    const char* cA = (const char*)g.A + (size_t)cur.pm * tstep; const char* cB = (const char*)g.Bt + (size_t)cur.pn * tstep;
    PG8_STAGE(PG8_SB(0, 0), cB, voffB); PG8_STAGE(PG8_SA(0, 0), cA, voffA); PG8_STAGE(PG8_SB(0, 1), cB + hstep, voffB); PG8_STAGE(PG8_SA(0, 1), cA + hstep, voffA);
    if (wr == 1) PG8_BAR;
    PG8_WAIT_V(4); PG8_BAR;
    PG8_STAGE(PG8_SB(1, 0), cB + kstep, voffB); PG8_STAGE(PG8_SA(1, 0), cA + kstep, voffA); PG8_STAGE(PG8_SB(1, 1), cB + hstep + kstep, voffB);
    PG8_WAIT_V(6); PG8_BAR;
    for (;;) {
        const bool has_next = S.next(ui + 1, nxt);
        const char* nA = has_next ? (const char*)g.A + (size_t)nxt.pm * tstep : cA; const char* nB = has_next ? (const char*)g.Bt + (size_t)nxt.pn * tstep : cB;
        for (int t = 0; t < nt; t += 2) {
            const bool last = (t == nt - 2);
            const char* a1 = cA + (size_t)(t + 1) * kstep;
            const char* a2 = last ? nA : cA + (size_t)(t + 2) * kstep; const char* b2 = last ? nB : cB + (size_t)(t + 2) * kstep;
            const char* a3 = a2 + kstep; const char* b3 = b2 + kstep;
            PG8_LDB(B0, 0, 0); PG8_SCHED; PG8_LDA(At, 0, 0); PG8_STAGE(PG8_SA(1, 1), a1 + hstep, voffA);
            PG8_WAIT_L(8); PG8_BAR; PG8_WAIT_L(0); PG8_MMA(0, 0, At, B0); PG8_BAR; PG8_SCHED;
            PG8_LDB(B1, 0, 1); PG8_STAGE(PG8_SB(0, 0), b2, voffB);
            PG8_BAR; PG8_WAIT_L(0); PG8_MMA(0, 1, At, B1); PG8_BAR;
            PG8_LDA(At, 0, 1); PG8_STAGE(PG8_SA(0, 0), a2, voffA);
            PG8_BAR; PG8_WAIT_L(0); PG8_MMA(1, 0, At, B0); PG8_BAR; PG8_SCHED;
            PG8_STAGE(PG8_SB(0, 1), b2 + hstep, voffB);
            PG8_WAIT_V(6); PG8_BAR; PG8_MMA(1, 1, At, B1); PG8_BAR;
            PG8_LDB(B0, 1, 0); PG8_SCHED; PG8_LDA(At, 1, 0); PG8_STAGE(PG8_SA(0, 1), a2 + hstep, voffA);
            PG8_WAIT_L(8); PG8_BAR; PG8_WAIT_L(0); PG8_MMA(0, 0, At, B0); PG8_BAR; PG8_SCHED;
            PG8_LDB(B1, 1, 1); PG8_STAGE(PG8_SB(1, 0), b3, voffB);
            PG8_BAR; PG8_WAIT_L(0); PG8_MMA(0, 1, At, B1); PG8_BAR;
            PG8_LDA(At, 1, 1); PG8_STAGE(PG8_SA(1, 0), a3, voffA);
            PG8_BAR; PG8_WAIT_L(0); PG8_MMA(1, 0, At, B0); PG8_BAR; PG8_SCHED;
            PG8_STAGE(PG8_SB(1, 1), b3 + hstep, voffB);
            PG8_WAIT_V(6); PG8_BAR; PG8_MMA(1, 1, At, B1); PG8_BAR;
        }
        E(acc, cur, wr, wc, fr, fq);
        if (!has_next) break;
#pragma unroll
        for (int a = 0; a < 2; ++a)
#pragma unroll
            for (int b = 0; b < 2; ++b)
#pragma unroll
                for (int m = 0; m < 4; ++m)
#pragma unroll
                    for (int n = 0; n < 2; ++n) acc[a][b][m][n] = (f32x4){0.f, 0.f, 0.f, 0.f};
        cur = nxt; cA = nA; cB = nB; ++ui;
    }
    PG8_WAIT_V(0);
    if (wr == 0) PG8_BAR;
    PG8_BAR;
#undef PG8_SA
#undef PG8_SB
#undef PG8_STAGE
#undef PG8_LDA
#undef PG8_LDB
#undef PG8_MMA
#undef PG8_WAIT_V
#undef PG8_WAIT_L
#undef PG8_BAR
#undef PG8_SCHED
}
}

struct EpiFfnIn {
    static constexpr bool PERM = true;
    bf16_t* H; const float* ssq; int g;
    __device__ __forceinline__ void operator()(const f32x4 (&acc)[2][2][4][2], const pg8::Unit& u, int wr, int wc, int fr_in, int fq) const {
        int fr = fr_in; asm volatile("" : "+v"(fr));
        const int lane_ = fr | (fq << 4), i16 = (lane_ ^ 16) << 2, i32 = (lane_ ^ 32) << 2; (void)i16; (void)i32;
        const int R0 = grow_tile(g, u.pm);
        const int col0 = u.pn * 128 + wc * 32 + 8 * fq;
        float rs8[8]; rows_rstd8(rs8, ssq, R0 + wr * 64 + fr, fq, i16, i32);
#pragma unroll
        for (int ai = 0; ai < 2; ++ai)
#pragma unroll
            for (int m = 0; m < 4; ++m) {
                const int rt = ai * 128 + wr * 64 + m * 16 + fr;
                const float rs = rs8[ai * 4 + m];
                float hv[8];
                const float nrs = rs * -1.44269504f;
#pragma unroll
                for (int n = 0; n < 2; ++n)
#pragma unroll
                    for (int jp = 0; jp < 2; ++jp) {
                        const f32x2 ra = {acc[ai][0][m][n][2 * jp], acc[ai][0][m][n][2 * jp + 1]}, rb = {acc[ai][1][m][n][2 * jp], acc[ai][1][m][n][2 * jp + 1]};
                        f32x2 na = ra * nrs; na.x = fminf(na.x, 60.f); na.y = fminf(na.y, 60.f);
                        f32x2 d; d.x = __builtin_amdgcn_exp2f(na.x); d.y = __builtin_amdgcn_exp2f(na.y); d = d + 1.0f;
                        const float rinv = __builtin_amdgcn_rcpf(d.x * d.y);
                        const f32x2 ab = (ra * rs) * (rb * rs);
                        const f32x2 sg = {rinv * d.y, rinv * d.x};
                        const f32x2 hh = ab * sg;
                        hv[n * 4 + 2 * jp] = hh.x; hv[n * 4 + 2 * jp + 1] = hh.y;
                    }
                u32x4 w; w.x = pk2(hv[0], hv[1]); w.y = pk2(hv[2], hv[3]); w.z = pk2(hv[4], hv[5]); w.w = pk2(hv[6], hv[7]);
                *(u32x4*)(H + (size_t)(u.pm * 256 + rt) * DFF + col0) = w;
            }
    }
};
struct EpiNull { static constexpr bool PERM = true; float* sink; __device__ __forceinline__ void operator()(const f32x4 (&acc)[2][2][4][2], const pg8::Unit& u, int wr, int wc, int fr, int fq) const {
    float s = 0.f;
#pragma unroll
    for (int a = 0; a < 2; ++a)
#pragma unroll
        for (int b = 0; b < 2; ++b)
#pragma unroll
            for (int m = 0; m < 4; ++m)
#pragma unroll
                for (int n = 0; n < 2; ++n) s += (acc[a][b][m][n][0] + acc[a][b][m][n][1]) + (acc[a][b][m][n][2] + acc[a][b][m][n][3]);
    if (s == 123.456f) sink[0] = 1.f; } };
struct EpiRes {
    static constexpr bool PERM = true;
    bf16_t* XB; float* ssq; float scale; int g;
    __device__ __forceinline__ void operator()(const f32x4 (&acc)[2][2][4][2], const pg8::Unit& u, int wr, int wc, int fr_in, int fq) const {
        int fr = fr_in; asm volatile("" : "+v"(fr));
        const int lane_ = fr | (fq << 4), i16 = (lane_ ^ 16) << 2, i32 = (lane_ ^ 32) << 2; (void)i16; (void)i32;
        const int R0 = grow_tile(g, u.pm);
#pragma unroll
        for (int ai = 0; ai < 2; ++ai) {
            u32x4 old[4][2];
#pragma unroll
            for (int m = 0; m < 4; ++m)
#pragma unroll
                for (int bj = 0; bj < 2; ++bj)
                    old[m][bj] = *(const u32x4*)(XB + (size_t)(u.pm * 256 + ai * 128 + wr * 64 + m * 16 + fr) * DM + u.pn * 256 + bj * 128 + wc * 32 + 8 * fq);
#pragma unroll
            for (int m = 0; m < 4; ++m) {
                const int rt = ai * 128 + wr * 64 + m * 16 + fr;
                bf16_t* xb = XB + (size_t)(u.pm * 256 + rt) * DM;
                float part = 0.f;
#pragma unroll
                for (int bj = 0; bj < 2; ++bj) {
                    const int c0 = u.pn * 256 + bj * 128 + wc * 32 + 8 * fq;
                    const u32x4 o = old[m][bj];
                    const f32x4 a0 = acc[ai][bj][m][0], a1 = acc[ai][bj][m][1];
                    float n[8];
                    n[0] = bflo(o.x) + a0[0] * scale; n[1] = bfhi(o.x) + a0[1] * scale; n[2] = bflo(o.y) + a0[2] * scale; n[3] = bfhi(o.y) + a0[3] * scale;
                    n[4] = bflo(o.z) + a1[0] * scale; n[5] = bfhi(o.z) + a1[1] * scale; n[6] = bflo(o.w) + a1[2] * scale; n[7] = bfhi(o.w) + a1[3] * scale;
                    u32x4 w; w.x = pk2(n[0], n[1]); w.y = pk2(n[2], n[3]); w.z = pk2(n[4], n[5]); w.w = pk2(n[6], n[7]);
                    *(u32x4*)(xb + c0) = w;
                    part += (n[0] * n[0] + n[1] * n[1]) + (n[2] * n[2] + n[3] * n[3]) + (n[4] * n[4] + n[5] * n[5]) + (n[6] * n[6] + n[7] * n[7]);
                }
                part += bperm(part, i16); part += bperm(part, i32);
                if (fq == 0) ssq[(size_t)(R0 + rt) * 16 + u.pn * 4 + wc] = part;
            }
            asm volatile("" ::: "memory");
        }
    }
};
struct EpiWin {
    static constexpr bool PERM = true;
    bf16_t* P; const float* ssq; const float* lbA; const float* lbB; const float* bg; int g;
    __device__ __forceinline__ void operator()(const f32x4 (&acc)[2][2][4][2], const pg8::Unit& u, int wr, int wc, int fr_in, int fq) const {
        int fr = fr_in; asm volatile("" : "+v"(fr));
        const int lane_ = fr | (fq << 4), i16 = (lane_ ^ 16) << 2, i32 = (lane_ ^ 32) << 2; (void)i16; (void)i32;
        const int R0 = grow_tile(g, u.pm);
        const int pn = u.pn;
        const int mode = (pn >= 2 && pn <= 5) ? 1 : (pn == 8 || pn == 9) ? 2 : (pn == 14 || pn == 15) ? 4 : (pn >= 16) ? 5 : 0;
        float rs8[8]; rows_rstd8(rs8, ssq, R0 + wr * 64 + fr, fq, i16, i32);
#pragma unroll
        for (int bj = 0; bj < 2; ++bj) {
            const int cin = bj * 128 + wc * 32 + 8 * fq;
            float ca[8], cb[8];
            if (mode == 1) { const int lc = 256 * (pn - 2) + cin;
#pragma unroll
                for (int j = 0; j < 8; ++j) { ca[j] = lbA[lc + j]; cb[j] = lbB[lc + j]; } }
            else if (mode == 4) { const int lc = 256 * (pn - 14) + cin;
#pragma unroll
                for (int j = 0; j < 8; ++j) { ca[j] = bg[lc + j]; cb[j] = 0.f; } }
            else {
#pragma unroll
                for (int j = 0; j < 8; ++j) { ca[j] = 0.f; cb[j] = 0.f; } }
#pragma unroll
            for (int ai = 0; ai < 2; ++ai)
#pragma unroll
                for (int m = 0; m < 4; ++m) {
                    const int rt = ai * 128 + wr * 64 + m * 16 + fr;
                    const float rs = rs8[ai * 4 + m];
                    float v[8];
#pragma unroll
                    for (int n = 0; n < 2; ++n)
#pragma unroll
                        for (int j = 0; j < 4; ++j) v[n * 4 + j] = acc[ai][bj][m][n][j] * rs;
                    if (mode == 1) {
#pragma unroll
                        for (int j = 0; j < 8; ++j) v[j] = __builtin_amdgcn_logf(ca[j] + cb[j] * sigmoid_f(v[j]));
                    } else if (mode == 2) {
#pragma unroll
                        for (int j = 0; j < 8; ++j) v[j] = sigmoid_f(v[j]);
                    } else if (mode == 4) {
#pragma unroll
                        for (int j = 0; j < 8; ++j) v[j] = log2sig_f(v[j] + ca[j]) * (1.f / 16.f);
                    } else if (mode == 5) {
#pragma unroll
                        for (int j = 0; j < 8; ++j) v[j] = v[j] * sigmoid_f(v[j]);
                    }
                    u32x4 w; w.x = pk2(v[0], v[1]); w.y = pk2(v[2], v[3]); w.z = pk2(v[4], v[5]); w.w = pk2(v[6], v[7]);
                    *(u32x4*)(P + (size_t)(u.pm * 256 + rt) * NP_ + pn * 256 + cin) = w;
                }
        }
    }
};

struct Args {
    const float* xp; const float* xs; const float* lower_bounds; const float* n1; const float* w1i; const float* w1o; const float* nm; const float* wi;
    const float* wg; const float* bg; const float* hgn; const float* glan; const float* wo; const float* n2; const float* w2i; const float* w2o; const float* nf;
    float* out; unsigned char* ws;
};

__device__ __forceinline__ void p0_convert(const Args& A) {
    const long nth = (long)gridDim.x * NTHREADS, gt = (long)blockIdx.x * NTHREADS + threadIdx.x;
    unsigned char* ws = A.ws;
    const long cnt[6] = {(long)NFF * 128, (long)DM * 352, (long)NP_ * 128, (long)DM * 128, (long)NFF * 128, (long)DM * 352};
    const long per_layer = cnt[0] + cnt[1] + cnt[2] + cnt[3] + cnt[4] + cnt[5];
    for (long it = gt; it < 2 * per_layer; it += nth) {
        const int l = it >= per_layer ? 1 : 0; long i = it - (long)l * per_layer;
        int job = 0;
#pragma unroll
        for (int j = 0; j < 5; ++j) if (job == j && i >= cnt[j]) { i -= cnt[j]; job = j + 1; }
        unsigned char* wl = ws + OFF_W + (size_t)l * SZ_LAYER;
        float v[8];
        bf16_t* dst;
        if (job == 0 || job == 4) {
            const int np = (int)(i % NFF), k0 = (int)(i / NFF) * 8;
            const float* W = (job == 0 ? A.w1i : A.w2i) + (size_t)l * DM * NFF; const float* gn = (job == 0 ? A.n1 : A.n2) + l * DM;
            const int n = ((np & 128) ? DFF : 0) + (np >> 8) * 128 + (np & 127);
#pragma unroll
            for (int e = 0; e < 8; ++e) v[e] = W[(size_t)(k0 + e) * NFF + n] * gn[k0 + e];
            dst = (bf16_t*)(wl + (job == 0 ? 0 : SZ_W1I + SZ_W1O + SZ_WIN + SZ_WO)) + (size_t)np * DM + k0;
        } else if (job == 1 || job == 5) {
            const int np = (int)(i % DM), k0 = (int)(i / DM) * 8;
            const float* W = (job == 1 ? A.w1o : A.w2o) + (size_t)l * DFF * DM;
#pragma unroll
            for (int e = 0; e < 8; ++e) v[e] = W[(size_t)(k0 + e) * DM + np];
            dst = (bf16_t*)(wl + (job == 1 ? SZ_W1I : 2 * SZ_W1I + SZ_W1O + SZ_WIN + SZ_WO)) + (size_t)np * DFF + k0;
        } else if (job == 3) {
            const int np = (int)(i % DM), k0 = (int)(i / DM) * 8;
            const float* W = A.wo + (size_t)l * DM * DM;
#pragma unroll
            for (int e = 0; e < 8; ++e) v[e] = W[(size_t)(k0 + e) * DM + np];
            dst = (bf16_t*)(wl + SZ_W1I + SZ_W1O + SZ_WIN) + (size_t)np * DM + k0;
        } else {
            const int np = (int)(i % NP_), k0 = (int)(i / NP_) * 8;
            const float* W = A.wi + (size_t)l * DM * DINSRC; const float* gn = A.nm + l * DM;
            if (np >= 3584 && np < 4096) {
                const int d = np >= 3840 ? 1 : 0, c = np - 3584 - 256 * d;
                const float* G = A.wg + ((size_t)l * 2 + d) * 16 * 256;
                float gc[16];
#pragma unroll
                for (int r = 0; r < 16; ++r) gc[r] = G[r * 256 + c];
#pragma unroll
                for (int e = 0; e < 8; ++e) { const float* wr_ = W + (size_t)(k0 + e) * DINSRC + 3584 + 16 * d; float s = 0.f;
#pragma unroll
                    for (int r = 0; r < 16; ++r) s += wr_[r] * gc[r];
                    v[e] = s * gn[k0 + e]; }
            } else {
                const int n = np < 3584 ? np : 3616 + (np - 4096);
                const float sc = (np >= 2560 && np < 2816) ? 0.125f : 1.f;
#pragma unroll
                for (int e = 0; e < 8; ++e) v[e] = W[(size_t)(k0 + e) * DINSRC + n] * gn[k0 + e] * sc;
            }
            dst = (bf16_t*)(wl + SZ_W1I + SZ_W1O) + (size_t)np * DM + k0;
        }
        u32x4 w; w.x = pk2(v[0], v[1]); w.y = pk2(v[2], v[3]); w.z = pk2(v[4], v[5]); w.w = pk2(v[6], v[7]);
        *(u32x4*)dst = w;
    }
    float* lbt = (float*)(ws + OFF_LBT);
    for (long i = gt; i < 2048; i += nth) {
        const int l = (int)(i >> 10), c = (int)(i & 1023);
        const float a = A.lower_bounds[c], b = A.lower_bounds[1024 + c], mx = fmaxf(a, b);
        const float ea = __expf(a - mx), eb = __expf(b - mx);
        const float lb = l == 0 ? 0.f : eb / (ea + eb);
        lbt[l * 2048 + c] = fmaxf(lb, 1e-30f);
        lbt[l * 2048 + 1024 + c] = 1.f - lb;
    }
}

__device__ __forceinline__ void g0_prologue(const float* xp, const float* xs, unsigned char* ws, int g) {
    int tid_ = threadIdx.x; asm volatile("" : "+v"(tid_));
    const int lane = tid_ & 63, wv = blockIdx.x * 8 + (tid_ >> 6), nwv = gridDim.x * 8;
    bf16_t* XB = (bf16_t*)(ws + OFF_XB); float* ssq = (float*)(ws + OFF_SSQ);
    for (int r = wv; r < (g == 0 ? 65536 : 32768); r += nwv) {
        const int R = grow(g, r);
        const float* x = R < 32768 ? xp + (size_t)R * DM : xs + (size_t)(R - 32768) * DM;
        float s = 0.f;
#pragma unroll
        for (int i = 0; i < 4; ++i) { const f32x4 v = *(const f32x4*)(x + i * 256 + lane * 4);
            s += (v[0] * v[0] + v[1] * v[1]) + (v[2] * v[2] + v[3] * v[3]);
            u32x2 w; w.x = pk2(v[0], v[1]); w.y = pk2(v[2], v[3]); *(u32x2*)(XB + (size_t)r * DM + i * 256 + lane * 4) = w; }
#pragma unroll
        for (int o = 32; o >= 1; o >>= 1) s += bperm(s, (lane ^ o) << 2);
        if (lane < 4) *(f32x4*)(ssq + (size_t)R * 16 + 4 * lane) = (f32x4){lane == 0 ? s : 0.f, 0.f, 0.f, 0.f};
    }
}
__device__ __forceinline__ void final_norm(float* outp, const float* nf, unsigned char* ws, int g) {
    int tid_ = threadIdx.x; asm volatile("" : "+v"(tid_));
    const int lane = tid_ & 63, wv = blockIdx.x * 8 + (tid_ >> 6), nwv = gridDim.x * 8;
    const float* ssq = (const float*)(ws + OFF_SSQ) + 6 * SSQ_SITE; const bf16_t* XB = (const bf16_t*)(ws + OFF_XB);
    for (int r = wv; r < (g == 0 ? 65536 : 32768); r += nwv) {
        const int R = grow(g, r);
        float* x = outp + (size_t)R * DM;
        const f32x4 q0 = *(const f32x4*)(ssq + (size_t)R * 16), q1 = *(const f32x4*)(ssq + (size_t)R * 16 + 4), q2 = *(const f32x4*)(ssq + (size_t)R * 16 + 8), q3 = *(const f32x4*)(ssq + (size_t)R * 16 + 12);
        const float rs = rsqrtf((((q0[0] + q0[1]) + (q0[2] + q0[3])) + ((q1[0] + q1[1]) + (q1[2] + q1[3])) + (((q2[0] + q2[1]) + (q2[2] + q2[3])) + ((q3[0] + q3[1]) + (q3[2] + q3[3])))) * (1.f / 1024.f) + EPS);
#pragma unroll
        for (int i = 0; i < 4; ++i) { const int c = i * 256 + lane * 4; const u32x2 xv = *(const u32x2*)(XB + (size_t)r * DM + c); const f32x4 gn = *(const f32x4*)(nf + c);
            f32x4 v = {bflo(xv.x) * rs * gn[0], bfhi(xv.x) * rs * gn[1], bflo(xv.y) * rs * gn[2], bfhi(xv.y) * rs * gn[3]}; *(f32x4*)(x + c) = v; }
    }
}

#define MFMA32(a, b, c) __builtin_amdgcn_mfma_f32_32x32x16_bf16((a), (b), (c), 0, 0, 0)
constexpr int SC_QT = 0, SC_KT = 34816, SC_VT = 69632, SC_ST = 104448, SC_TOT = 139264, SC_VEC = 143360, SC_RED = 144896, SC_END = 145920;
constexpr int TSTR = 272;

template <int DK, bool second>
__device__ __forceinline__ void scan_half(LAS unsigned char* L, const bf16_t* __restrict__ P, bf16_t* RAW, bf16_t* OBF, const float* __restrict__ gain,
                                          int seqbase, int T, int dir, int qcol, int kcol, int gcol, int vcol, int gatecol, int ocol,
                                          int j0, int j1, f32x16& S0, f32x16& S1) {
    constexpr bool GLA = (DK == 64);
    constexpr int NPAIR = DK / 2, NSEG = NTHREADS / NPAIR, SL = 128 / NSEG, QSTR = (DK + 8) * 2, NKS = DK / 16;
    int tid_ = threadIdx.x; asm volatile("" : "+v"(tid_));
    const int tid = tid_, lane = tid & 63, w = __builtin_amdgcn_readfirstlane(tid >> 6);
    const int r = lane & 31, h = lane >> 5;
    const int cp = tid % NPAIR, seg = tid / NPAIR, vp = tid & 63, vseg = tid >> 6;
    const int tb = w >> 1, dh = w & 1, dvb_s = w & 3, kq = w >> 2;
    unsigned g2[SL], q2[SL], k2[SL], v2[16];

#define ROWOF(j, i) (seqbase + (dir ? (T - 1 - ((j) * 128 + (i))) : ((j) * 128 + (i))))
    const char* Pg = (const char*)P + gcol * 2; const char* Pq = (const char*)P + qcol * 2; const char* Pk = (const char*)P + kcol * 2; const char* Pv = (const char*)P + vcol * 2;
    const int rstep = dir ? -(NP_ * 2) : (NP_ * 2);
#define LOAD_CHUNK(j) do { int jj_ = (j); asm volatile("" : "+s"(jj_)); \
        { const int p0_ = jj_ * 128 + seg * SL; const int off0_ = (seqbase + (dir ? (T - 1 - p0_) : p0_)) * (NP_ * 2) + 4 * cp; \
          _Pragma("unroll") for (int i_ = 0; i_ < SL; ++i_) { const unsigned o_ = (unsigned)(off0_ + i_ * rstep); \
            g2[i_] = *(const unsigned*)(Pg + o_); q2[i_] = *(const unsigned*)(Pq + o_); if (GLA) k2[i_] = *(const unsigned*)(Pk + o_); else k2[i_] = 0u; } } \
        { const int p0_ = jj_ * 128 + vseg * 16; const int off0_ = (seqbase + (dir ? (T - 1 - p0_) : p0_)) * (NP_ * 2) + 4 * vp; \
          _Pragma("unroll") for (int i_ = 0; i_ < 16; ++i_) { const unsigned o_ = (unsigned)(off0_ + i_ * rstep); v2[i_] = *(const unsigned*)(Pv + o_); } } \
    } while (0)

    LOAD_CHUNK(j0);
    for (int j = j0; j < j1; ++j) {
        int rq = r * QSTR + 16 * h, rt = r * TSTR + 16 * h, rq8 = r * QSTR + 8 * h, rt8 = r * TSTR + 8 * h, h16 = 16 * h;
        asm volatile("" : "+v"(rq), "+v"(rt), "+v"(rq8), "+v"(rt8), "+v"(h16));
        f32x2 cs[SL];
        { f32x2 run = {0.f, 0.f};
#pragma unroll
          for (int i = 0; i < SL; ++i) { run = run + (f32x2){bflo(g2[i]), bfhi(g2[i])}; cs[i] = run; }
          *(LAS f32x2*)(L + SC_TOT + (seg * DK + 2 * cp) * 4) = run; }
        __syncthreads();
        f32x2 off = {0.f, 0.f}, mm = {0.f, 0.f}, bl = {0.f, 0.f};
#pragma unroll
        for (int s = 0; s < NSEG; ++s) { const f32x2 t = *(const LAS f32x2*)(L + SC_TOT + (s * DK + 2 * cp) * 4);
            if (s < seg) off = off + t;
            if (s < NSEG / 2) mm = mm + t;
            bl = bl + t; }
        unsigned kk[SL];
        const f32x2 dd = off - mm;
#pragma unroll
        for (int i = 0; i < SL; ++i) {
            f32x2 ee = cs[i] + dd;
            ee.x = __builtin_amdgcn_fmed3f(ee.x, -115.f, 115.f); ee.y = __builtin_amdgcn_fmed3f(ee.y, -115.f, 115.f);
            const f32x2 xx = {__builtin_amdgcn_exp2f(ee.x), __builtin_amdgcn_exp2f(ee.y)}, yy = {__builtin_amdgcn_exp2f(-ee.x), __builtin_amdgcn_exp2f(-ee.y)};
            f32x2 kv;
            if (GLA) kv = (f32x2){bflo(k2[i]), bfhi(k2[i])};
            else kv = (f32x2){1.f, 1.f} - (f32x2){__builtin_amdgcn_exp2f(bflo(g2[i])), __builtin_amdgcn_exp2f(bfhi(g2[i]))};
            const f32x2 qv = (f32x2){bflo(q2[i]), bfhi(q2[i])} * xx, kw = kv * yy;
            const unsigned qq = pk2(qv.x, qv.y);
            kk[i] = pk2(kw.x, kw.y);
            *(LAS unsigned*)(L + SC_QT + (seg * SL + i) * QSTR + 4 * cp) = qq;
            *(LAS unsigned*)(L + SC_KT + (seg * SL + i) * QSTR + 4 * cp) = kk[i];
        }
        {
            u32x4 a0, a1, b0, b1;
            a0.x = (v2[0] & 0xffffu) | (v2[1] << 16); a0.y = (v2[2] & 0xffffu) | (v2[3] << 16); a0.z = (v2[4] & 0xffffu) | (v2[5] << 16); a0.w = (v2[6] & 0xffffu) | (v2[7] << 16);
            a1.x = (v2[8] & 0xffffu) | (v2[9] << 16); a1.y = (v2[10] & 0xffffu) | (v2[11] << 16); a1.z = (v2[12] & 0xffffu) | (v2[13] << 16); a1.w = (v2[14] & 0xffffu) | (v2[15] << 16);
            b0.x = (v2[0] >> 16) | (v2[1] & 0xffff0000u); b0.y = (v2[2] >> 16) | (v2[3] & 0xffff0000u); b0.z = (v2[4] >> 16) | (v2[5] & 0xffff0000u); b0.w = (v2[6] >> 16) | (v2[7] & 0xffff0000u);
            b1.x = (v2[8] >> 16) | (v2[9] & 0xffff0000u); b1.y = (v2[10] >> 16) | (v2[11] & 0xffff0000u); b1.z = (v2[12] >> 16) | (v2[13] & 0xffff0000u); b1.w = (v2[14] >> 16) | (v2[15] & 0xffff0000u);
            LAS unsigned char* pv = L + SC_VT + (2 * vp) * TSTR + vseg * 32;
            *(LAS u32x4*)(pv) = a0; *(LAS u32x4*)(pv + 16) = a1; *(LAS u32x4*)(pv + TSTR) = b0; *(LAS u32x4*)(pv + TSTR + 16) = b1;
        }
        if (seg == 0) {
            *(LAS f32x2*)(L + SC_VEC + (2 * cp) * 4) = (f32x2){__builtin_amdgcn_exp2f(mm.x), __builtin_amdgcn_exp2f(mm.y)};
            *(LAS f32x2*)(L + SC_VEC + 512 + (2 * cp) * 4) = (f32x2){__builtin_amdgcn_exp2f(bl.x), __builtin_amdgcn_exp2f(bl.y)};
            *(LAS f32x2*)(L + SC_VEC + 1024 + (2 * cp) * 4) = (f32x2){__builtin_amdgcn_exp2f(bl.x - mm.x), __builtin_amdgcn_exp2f(bl.y - mm.y)};
        }
        __syncthreads();
#pragma unroll
        for (int ti = 0; ti < (GLA ? 1 : 2); ++ti) {
            const int kb_ = GLA ? kq : 2 * kq + ti;
            const f32x16& Sx = ti == 0 ? S0 : S1;
#pragma unroll
            for (int gq = 0; gq < 4; ++gq) {
                const int k = 32 * kb_ + 8 * gq + 4 * h;
                const f32x4 em = *(const LAS f32x4*)(L + SC_VEC + (32 * kb_ + 8 * gq) * 4 + h16);
                u32x2 wv; wv.x = pk2(Sx[4 * gq] * em[0], Sx[4 * gq + 1] * em[1]); wv.y = pk2(Sx[4 * gq + 2] * em[2], Sx[4 * gq + 3] * em[3]);
                *(LAS u32x2*)(L + SC_ST + 32 * dvb_s * QSTR + rq8 + (32 * kb_ + 8 * gq) * 2) = wv;
            }
        }
        bf16x8 ps[4][2];
        {
            bf16x8 qf[NKS];
#pragma unroll
            for (int ks = 0; ks < NKS; ++ks) qf[ks] = *(const LAS bf16x8*)(L + SC_QT + 32 * tb * QSTR + rq + 32 * ks);
#pragma unroll
            for (int sb = 0; sb < 4; ++sb) {
                if (sb <= tb) {
                    bf16x8 af[NKS];
#pragma unroll
                    for (int ks = 0; ks < NKS; ++ks) af[ks] = *(const LAS bf16x8*)(L + SC_KT + 32 * sb * QSTR + rq + 32 * ks);
                    f32x16 x;
#pragma unroll
                    for (int i = 0; i < 16; ++i) x[i] = 0.f;
#pragma unroll
                    for (int ks = 0; ks < NKS; ++ks) x = MFMA32(af[ks], qf[ks], x);
                    if (sb == tb) {
#pragma unroll
                        for (int i = 0; i < 16; ++i) { const int cr = (i & 3) + 8 * (i >> 2) + 4 * h; x[i] = cr <= r ? x[i] : 0.f; }
                    }
#pragma unroll
                    for (int ss = 0; ss < 2; ++ss) { u32x4 pw; pw.x = pk2(x[8 * ss], x[8 * ss + 1]); pw.y = pk2(x[8 * ss + 2], x[8 * ss + 3]); pw.z = pk2(x[8 * ss + 4], x[8 * ss + 5]); pw.w = pk2(x[8 * ss + 6], x[8 * ss + 7]);
                        ps[sb][ss] = __builtin_bit_cast(bf16x8, pw); }
                } else { ps[sb][0] = (bf16x8){0, 0, 0, 0, 0, 0, 0, 0}; ps[sb][1] = (bf16x8){0, 0, 0, 0, 0, 0, 0, 0}; }
            }
        }
        __syncthreads();
        {
            LAS unsigned char* pk_ = L + SC_KT + (2 * cp) * TSTR + seg * SL * 2;
            if (SL == 16) {
                u32x4 a0, a1, b0, b1;
                a0.x = (kk[0] & 0xffffu) | (kk[1] << 16); a0.y = (kk[2] & 0xffffu) | (kk[3] << 16); a0.z = (kk[4] & 0xffffu) | (kk[5] << 16); a0.w = (kk[6] & 0xffffu) | (kk[7] << 16);
                a1.x = (kk[8 % SL] & 0xffffu) | (kk[9 % SL] << 16); a1.y = (kk[10 % SL] & 0xffffu) | (kk[11 % SL] << 16); a1.z = (kk[12 % SL] & 0xffffu) | (kk[13 % SL] << 16); a1.w = (kk[14 % SL] & 0xffffu) | (kk[15 % SL] << 16);
                b0.x = (kk[0] >> 16) | (kk[1] & 0xffff0000u); b0.y = (kk[2] >> 16) | (kk[3] & 0xffff0000u); b0.z = (kk[4] >> 16) | (kk[5] & 0xffff0000u); b0.w = (kk[6] >> 16) | (kk[7] & 0xffff0000u);
                b1.x = (kk[8 % SL] >> 16) | (kk[9 % SL] & 0xffff0000u); b1.y = (kk[10 % SL] >> 16) | (kk[11 % SL] & 0xffff0000u); b1.z = (kk[12 % SL] >> 16) | (kk[13 % SL] & 0xffff0000u); b1.w = (kk[14 % SL] >> 16) | (kk[15 % SL] & 0xffff0000u);
                *(LAS u32x4*)(pk_) = a0; *(LAS u32x4*)(pk_ + 16) = a1; *(LAS u32x4*)(pk_ + TSTR) = b0; *(LAS u32x4*)(pk_ + TSTR + 16) = b1;
            } else {
                u32x4 a0, b0;
                a0.x = (kk[0] & 0xffffu) | (kk[1] << 16); a0.y = (kk[2] & 0xffffu) | (kk[3] << 16); a0.z = (kk[4] & 0xffffu) | (kk[5] << 16); a0.w = (kk[6] & 0xffffu) | (kk[7] << 16);
                b0.x = (kk[0] >> 16) | (kk[1] & 0xffff0000u); b0.y = (kk[2] >> 16) | (kk[3] & 0xffff0000u); b0.z = (kk[4] >> 16) | (kk[5] & 0xffff0000u); b0.w = (kk[6] >> 16) | (kk[7] & 0xffff0000u);
                *(LAS u32x4*)(pk_) = a0; *(LAS u32x4*)(pk_ + TSTR) = b0;
            }
        }
        const int orow = ROWOF(j, 32 * tb + r);
        f32x16 O[2];
        {
            bf16x8 qf[NKS];
#pragma unroll
            for (int ks = 0; ks < NKS; ++ks) qf[ks] = *(const LAS bf16x8*)(L + SC_QT + 32 * tb * QSTR + rq + 32 * ks);
#pragma unroll
            for (int dvi = 0; dvi < 2; ++dvi) {
                const int dvb = 2 * dh + dvi;
                bf16x8 sf[NKS];
#pragma unroll
                for (int ks = 0; ks < NKS; ++ks) sf[ks] = *(const LAS bf16x8*)(L + SC_ST + 32 * dvb * QSTR + rq + 32 * ks);
                f32x16 o;
#pragma unroll
                for (int i = 0; i < 16; ++i) o[i] = 0.f;
#pragma unroll
                for (int ks = 0; ks < NKS; ++ks) o = MFMA32(sf[ks], qf[ks], o);
                O[dvi] = o;
            }
        }
        u32x2 praw[2][4];
        if (second) {
#pragma unroll
            for (int dvi = 0; dvi < 2; ++dvi)
#pragma unroll
                for (int gq = 0; gq < 4; ++gq) praw[dvi][gq] = *(const u32x2*)(RAW + (size_t)orow * DM + ocol + 32 * (2 * dh + dvi) + 8 * gq + 4 * h);
        }
#pragma unroll
        for (int dvi = 0; dvi < 2; ++dvi) {
            const int dvb = 2 * dh + dvi;
            f32x16 o = O[dvi];
#pragma unroll
            for (int sb = 0; sb < 4; ++sb) {
                if (sb <= tb) {
                    const LAS unsigned char* pa = L + SC_VT + 32 * dvb * TSTR + rt8 + 64 * sb;
                    const s16x4 l0 = *(const LAS s16x4*)(pa), h0 = *(const LAS s16x4*)(pa + 16), l1 = *(const LAS s16x4*)(pa + 32), h1 = *(const LAS s16x4*)(pa + 48);
                    o = MFMA32(__builtin_shufflevector(l0, h0, 0, 1, 2, 3, 4, 5, 6, 7), ps[sb][0], o);
                    o = MFMA32(__builtin_shufflevector(l1, h1, 0, 1, 2, 3, 4, 5, 6, 7), ps[sb][1], o);
                }
            }
            O[dvi] = o;
        }
        if (!second) {
#pragma unroll
            for (int dvi = 0; dvi < 2; ++dvi)
#pragma unroll
                for (int gq = 0; gq < 4; ++gq) {
                    const int dv = 32 * (2 * dh + dvi) + 8 * gq + 4 * h;
                    u32x2 wv; wv.x = pk2(O[dvi][4 * gq], O[dvi][4 * gq + 1]); wv.y = pk2(O[dvi][4 * gq + 2], O[dvi][4 * gq + 3]);
                    *(u32x2*)(RAW + (size_t)orow * DM + ocol + dv) = wv;
                }
        } else {
            float ssum = 0.f;
#pragma unroll
            for (int dvi = 0; dvi < 2; ++dvi)
#pragma unroll
                for (int gq = 0; gq < 4; ++gq) {
                    const u32x2 pw_ = praw[dvi][gq]; const f32x4 pr = {bflo(pw_.x), bfhi(pw_.x), bflo(pw_.y), bfhi(pw_.y)};
#pragma unroll
                    for (int e = 0; e < 4; ++e) { const float t = O[dvi][4 * gq + e] + pr[e]; O[dvi][4 * gq + e] = t; ssum += t * t; }
                }
            ssum += bperm(ssum, (lane ^ 32) << 2);
            if (h == 0) *(LAS float*)(L + SC_RED + (w * 32 + r) * 4) = ssum;
        }
        __syncthreads();
        if (second) {
            const float tot = *(const LAS float*)(L + SC_RED + ((w & ~1) * 32 + r) * 4) + *(const LAS float*)(L + SC_RED + ((w | 1) * 32 + r) * 4);
            const float rs = __builtin_amdgcn_rsqf(tot * (1.f / 128.f) + EPS);
#pragma unroll
            for (int dvi = 0; dvi < 2; ++dvi)
#pragma unroll
                for (int gq = 0; gq < 4; ++gq) {
                    const int dv = 32 * (2 * dh + dvi) + 8 * gq + 4 * h;
                    const f32x4 gn = *(const f32x4*)(gain + dv);
                    const u32x2 gt = *(const u32x2*)(P + (size_t)orow * NP_ + gatecol + dv);
                    u32x2 wv; wv.x = pk2(O[dvi][4 * gq] * rs * gn[0] * bflo(gt.x), O[dvi][4 * gq + 1] * rs * gn[1] * bfhi(gt.x));
                    wv.y = pk2(O[dvi][4 * gq + 2] * rs * gn[2] * bflo(gt.y), O[dvi][4 * gq + 3] * rs * gn[3] * bfhi(gt.y));
                    *(u32x2*)(OBF + (size_t)orow * DM + ocol + dv) = wv;
                }
        }
        if (j + 1 < j1) LOAD_CHUNK(j + 1);
        {
            bf16x8 vb[8];
#pragma unroll
            for (int ks = 0; ks < 8; ++ks) vb[ks] = *(const LAS bf16x8*)(L + SC_VT + 32 * dvb_s * TSTR + rt + 32 * ks);
#pragma unroll
            for (int ti = 0; ti < (GLA ? 1 : 2); ++ti) {
                const int kb_ = GLA ? kq : 2 * kq + ti;
                bf16x8 ka[8];
#pragma unroll
                for (int ks = 0; ks < 8; ++ks) ka[ks] = *(const LAS bf16x8*)(L + SC_KT + 32 * kb_ * TSTR + rt + 32 * ks);
                f32x16 pkv;
#pragma unroll
                for (int i = 0; i < 16; ++i) pkv[i] = 0.f;
#pragma unroll
                for (int ks = 0; ks < 8; ++ks) pkv = MFMA32(ka[ks], vb[ks], pkv);
                f32x16& Sx = ti == 0 ? S0 : S1;
#pragma unroll
                for (int gq = 0; gq < 4; ++gq) {
                    const int k = 32 * kb_ + 8 * gq + 4 * h;
                    const f32x4 eb = *(const LAS f32x4*)(L + SC_VEC + 512 + (32 * kb_ + 8 * gq) * 4 + h16), ebm = *(const LAS f32x4*)(L + SC_VEC + 1024 + (32 * kb_ + 8 * gq) * 4 + h16);
                    { const f32x2 s01 = (f32x2){eb[0], eb[1]} * (f32x2){Sx[4 * gq], Sx[4 * gq + 1]} + (f32x2){ebm[0], ebm[1]} * (f32x2){pkv[4 * gq], pkv[4 * gq + 1]};
                      const f32x2 s23 = (f32x2){eb[2], eb[3]} * (f32x2){Sx[4 * gq + 2], Sx[4 * gq + 3]} + (f32x2){ebm[2], ebm[3]} * (f32x2){pkv[4 * gq + 2], pkv[4 * gq + 3]};
                      Sx[4 * gq] = s01.x; Sx[4 * gq + 1] = s01.y; Sx[4 * gq + 2] = s23.x; Sx[4 * gq + 3] = s23.y; }
                }
            }
        }
    }
    __syncthreads();
#undef ROWOF
#undef LOAD_CHUNK
}


template <class T> __device__ __forceinline__ T* opaque_ptr(T* p) { __attribute__((address_space(1))) T* gp = (__attribute__((address_space(1))) T*)p; asm volatile("" : "+s"(gp)); return (T*)gp; }
__device__ __forceinline__ unsigned opaque_zero() { unsigned z; asm volatile("s_mov_b32 %0, 0" : "=s"(z)); return z; }
__device__ __forceinline__ void gbar(unsigned* ctr, unsigned target) {
    asm volatile("s_waitcnt vmcnt(0)" ::: "memory");
    __syncthreads();
    if (threadIdx.x == 0) {
        __builtin_amdgcn_fence(__ATOMIC_RELEASE, "agent");
        asm volatile("s_waitcnt vmcnt(0)" ::: "memory");
        __hip_atomic_fetch_add(ctr, 1u, __ATOMIC_RELAXED, __HIP_MEMORY_SCOPE_AGENT);
        while (__hip_atomic_load(ctr, __ATOMIC_RELAXED, __HIP_MEMORY_SCOPE_AGENT) < target) __builtin_amdgcn_s_sleep(2);
        __builtin_amdgcn_fence(__ATOMIC_ACQUIRE, "agent");
        asm volatile("s_waitcnt vmcnt(0)" ::: "memory");
    }
    __syncthreads();
}

__global__ void __launch_bounds__(NTHREADS) hymba_fwd(Args A) {
    extern __shared__ __attribute__((aligned(16))) unsigned char lds_raw[];
    cg::grid_group grid = cg::this_grid();
    unsigned nbar = 0;
#define PH_BEGIN() const unsigned zs = opaque_zero(); LAS unsigned char* L = (LAS unsigned char*)lds_raw + zs; unsigned char* ws = opaque_ptr(A.ws); const int G = (int)(gridDim.x + zs), bid = (int)(blockIdx.x + zs); const float* xp = opaque_ptr(A.xp); const float* xs = opaque_ptr(A.xs); float* outp = opaque_ptr(A.out); (void)L; (void)ws; (void)G; (void)bid; (void)xp; (void)xs; (void)outp
#define GBAR() do { for (int rb_ = 0; rb_ < PROBE_BAR; ++rb_) { nbar += 256u; gbar((unsigned*)(A.ws + OFF_BAR + opaque_zero()), nbar); } } while (0)

    for (int rep = 0; rep < PROBE_P0; ++rep) { PH_BEGIN(); p0_convert(A); }
    { PH_BEGIN(); g0_prologue(xp, xs, ws, 0); }
    grid.sync();

#pragma unroll 1
    for (int g = 0; g < NGRP; ++g) {
        const int MGg = g == 0 ? 65536 : 32768;
        if (g > 0) { { PH_BEGIN(); g0_prologue(xp, xs, ws, g); } GBAR(); }
#pragma unroll 1
        for (int l = 0; l < 2; ++l) {
            const size_t wlo = OFF_W + (size_t)l * SZ_LAYER;
            const size_t sq = OFF_SSQ + (size_t)(3 * l) * SSQ_SITE * 4;
            for (int rep = 0; rep < PROBE_FFNIN; ++rep) { PH_BEGIN(); pg8::Gemm gm{(const bf16_t*)(ws + OFF_XB), (const bf16_t*)(ws + wlo), MGg, NFF, DM}; pg8::StaticOrder S; S.init(MGg, NFF, G, bid);
              EpiFfnIn E{(bf16_t*)(ws + OFF_PH), (const float*)(ws + sq), g}; pg8::gemm_phase(L, gm, S, E); }
            GBAR();
            for (int rep = 0; rep < PROBE_FFNOUT_NULL; ++rep) { PH_BEGIN(); pg8::Gemm gm{(const bf16_t*)(ws + OFF_PH), (const bf16_t*)(ws + wlo + SZ_W1I), MGg, DM, DFF}; pg8::StaticOrder S; S.init(MGg, DM, G, bid); EpiNull E{(float*)(ws + OFF_RAW)}; pg8::gemm_phase(L, gm, S, E); }
            { PH_BEGIN(); pg8::Gemm gm{(const bf16_t*)(ws + OFF_PH), (const bf16_t*)(ws + wlo + SZ_W1I), MGg, DM, DFF}; pg8::StaticOrder S; S.init(MGg, DM, G, bid);
              EpiRes E{(bf16_t*)(ws + OFF_XB), (float*)(ws + sq) + SSQ_SITE, 0.5f, g}; pg8::gemm_phase(L, gm, S, E); }
            GBAR();
            for (int rep = 0; rep < PROBE_WIN; ++rep) { PH_BEGIN(); pg8::Gemm gm{(const bf16_t*)(ws + OFF_XB), (const bf16_t*)(ws + wlo + SZ_W1I + SZ_W1O), MGg, NP_, DM}; pg8::StaticOrder S; S.init(MGg, NP_, G, bid);
              const float* LBT = (const float*)(ws + OFF_LBT) + l * 2048;
              EpiWin E{(bf16_t*)(ws + OFF_PH), (const float*)(ws + sq) + SSQ_SITE, LBT, LBT + 1024, A.bg + l * 512, g}; pg8::gemm_phase(L, gm, S, E); }
            GBAR();
            for (int rep = 0; rep < PROBE_SCAN; ++rep) {
                f32x16 S0, S1;
#pragma unroll
                for (int i = 0; i < 16; ++i) { S0[i] = 0.f; S1[i] = 0.f; }
                { PH_BEGIN();
                  const bf16_t* PH = (const bf16_t*)(ws + OFF_PH); bf16_t* RAW = (bf16_t*)(ws + OFF_RAW); bf16_t* OBF = (bf16_t*)(ws + OFF_OBF);
                  const int dir = bid & 1, hh = (bid >> 1) & 7, sidx = (bid >> 4) & 15;
                  const int T = g == 0 ? TSAMPLE : TPROMPT, seqbase = sidx * T, N = T / 128;
                  if (hh < 4) { const int hd = hh;
                      scan_half<128, false>(L, PH, RAW, OBF, A.hgn + l * 512 + 128 * hd, seqbase, T, dir, 128 * hd, 0, (dir ? 1024 : 512) + 128 * hd, 1536 + 128 * hd, 2048 + 128 * hd, 128 * hd, 0, N / 2, S0, S1);
                  } else { const int hd = hh - 4;
                      scan_half<64, false>(L, PH, RAW, OBF, A.glan + l * 512 + 128 * hd, seqbase, T, dir, 2560 + 64 * hd, 2816 + 64 * hd, (dir ? 3840 : 3584) + 64 * hd, 3072 + 128 * hd, 4096 + 128 * hd, 512 + 128 * hd, 0, N / 2, S0, S1);
                  } }
                GBAR();
                { PH_BEGIN();
                  const bf16_t* PH = (const bf16_t*)(ws + OFF_PH); bf16_t* RAW = (bf16_t*)(ws + OFF_RAW); bf16_t* OBF = (bf16_t*)(ws + OFF_OBF);
                  const int dir = bid & 1, hh = (bid >> 1) & 7, sidx = (bid >> 4) & 15;
                  const int T = g == 0 ? TSAMPLE : TPROMPT, seqbase = sidx * T, N = T / 128;
                  if (hh < 4) { const int hd = hh;
                      scan_half<128, true>(L, PH, RAW, OBF, A.hgn + l * 512 + 128 * hd, seqbase, T, dir, 128 * hd, 0, (dir ? 1024 : 512) + 128 * hd, 1536 + 128 * hd, 2048 + 128 * hd, 128 * hd, N / 2, N, S0, S1);
                  } else { const int hd = hh - 4;
                      scan_half<64, true>(L, PH, RAW, OBF, A.glan + l * 512 + 128 * hd, seqbase, T, dir, 2560 + 64 * hd, 2816 + 64 * hd, (dir ? 3840 : 3584) + 64 * hd, 3072 + 128 * hd, 4096 + 128 * hd, 512 + 128 * hd, N / 2, N, S0, S1);
                  } }
                GBAR();
            }
            { PH_BEGIN(); pg8::Gemm gm{(const bf16_t*)(ws + OFF_OBF), (const bf16_t*)(ws + wlo + SZ_W1I + SZ_W1O + SZ_WIN), MGg, DM, DM}; pg8::StaticOrder S; S.init(MGg, DM, G, bid);
              EpiRes E{(bf16_t*)(ws + OFF_XB), (float*)(ws + sq) + 2 * SSQ_SITE, 1.0f, g}; pg8::gemm_phase(L, gm, S, E); }
            GBAR();
            for (int rep = 0; rep < PROBE_FFNIN; ++rep) { PH_BEGIN(); pg8::Gemm gm{(const bf16_t*)(ws + OFF_XB), (const bf16_t*)(ws + wlo + SZ_W1I + SZ_W1O + SZ_WIN + SZ_WO), MGg, NFF, DM}; pg8::StaticOrder S; S.init(MGg, NFF, G, bid);
              EpiFfnIn E{(bf16_t*)(ws + OFF_PH), (const float*)(ws + sq) + 2 * SSQ_SITE, g}; pg8::gemm_phase(L, gm, S, E); }
            GBAR();
            for (int rep = 0; rep < PROBE_FFNOUT_NULL; ++rep) { PH_BEGIN(); pg8::Gemm gm{(const bf16_t*)(ws + OFF_PH), (const bf16_t*)(ws + wlo + 2 * SZ_W1I + SZ_W1O + SZ_WIN + SZ_WO), MGg, DM, DFF}; pg8::StaticOrder S; S.init(MGg, DM, G, bid); EpiNull E{(float*)(ws + OFF_RAW)}; pg8::gemm_phase(L, gm, S, E); }
            { PH_BEGIN(); pg8::Gemm gm{(const bf16_t*)(ws + OFF_PH), (const bf16_t*)(ws + wlo + 2 * SZ_W1I + SZ_W1O + SZ_WIN + SZ_WO), MGg, DM, DFF}; pg8::StaticOrder S; S.init(MGg, DM, G, bid);
              EpiRes E{(bf16_t*)(ws + OFF_XB), (float*)(ws + sq) + 3 * SSQ_SITE, 0.5f, g}; pg8::gemm_phase(L, gm, S, E); }
            GBAR();
        }
        for (int rep = 0; rep < PROBE_G0F; ++rep) { PH_BEGIN(); final_norm(outp, opaque_ptr(A.nf), ws, g); }
    }
#undef PH_BEGIN
#undef GBAR
}

constexpr int LDS_BYTES = 146432;
extern "C" void kernel_launch(void* const* d_in, const int* in_sizes, int n_in, void* d_out, int out_size, void* d_ws, size_t ws_size, hipStream_t stream) {
    static int ready = 0;
    if (!ready) {
        if (n_in != 17 || out_size != MTOT * DM || ws_size < WS_END) { fprintf(stderr, "kernel_launch: unexpected shapes (n_in %d out %d ws %zu need %zu)\n", n_in, out_size, ws_size, (size_t)WS_END); ready = -1; return; }
        if (hipFuncSetAttribute((const void*)hymba_fwd, hipFuncAttributeMaxDynamicSharedMemorySize, LDS_BYTES) != hipSuccess) { fprintf(stderr, "kernel_launch: hipFuncSetAttribute failed\n"); ready = -1; return; }
        int per_cu = 0; (void)hipOccupancyMaxActiveBlocksPerMultiprocessor(&per_cu, (const void*)hymba_fwd, NTHREADS, LDS_BYTES); (void)hipGetLastError();
        ready = 1;
    }
    if (ready < 0) return;
    if (hipMemsetAsync((char*)d_ws + OFF_BAR, 0, 256, stream) != hipSuccess) { fprintf(stderr, "kernel_launch: memset failed\n"); return; }
    Args a{};
    a.xp = (const float*)d_in[0]; a.xs = (const float*)d_in[1]; a.lower_bounds = (const float*)d_in[2]; a.n1 = (const float*)d_in[3]; a.w1i = (const float*)d_in[4]; a.w1o = (const float*)d_in[5];
    a.nm = (const float*)d_in[6]; a.wi = (const float*)d_in[7]; a.wg = (const float*)d_in[8]; a.bg = (const float*)d_in[9]; a.hgn = (const float*)d_in[10]; a.glan = (const float*)d_in[11];
    a.wo = (const float*)d_in[12]; a.n2 = (const float*)d_in[13]; a.w2i = (const float*)d_in[14]; a.w2o = (const float*)d_in[15]; a.nf = (const float*)d_in[16];
    a.out = (float*)d_out; a.ws = (unsigned char*)d_ws;
    void* args[] = {&a};
    hipError_t e = hipLaunchCooperativeKernel((const void*)hymba_fwd, dim3(256), dim3(NTHREADS), args, LDS_BYTES, stream);
    if (e != hipSuccess) fprintf(stderr, "cooperative launch failed: %s\n", hipGetErrorString(e));
}
```

```cpp
#include <hip/hip_runtime.h>
#include <hip/hip_cooperative_groups.h>
#include <cstdio>
namespace cg = cooperative_groups;

#define LAS __attribute__((address_space(3)))
typedef unsigned short bf16_t;
typedef short bf16x8 __attribute__((ext_vector_type(8)));
typedef short s16x4 __attribute__((ext_vector_type(4)));
typedef float f32x2 __attribute__((ext_vector_type(2)));
typedef float f32x4 __attribute__((ext_vector_type(4)));
typedef float f32x16 __attribute__((ext_vector_type(16)));
typedef unsigned u32x2 __attribute__((ext_vector_type(2)));
typedef unsigned u32x4 __attribute__((ext_vector_type(4)));

constexpr int DM = 1024, DFF = 2816, NFF = 5632, DINSRC = 4128, NP_ = 4608;
constexpr int MTOT = 98304, MGMAX = 65536, NGRP = 2;
constexpr int TPROMPT = 2048, TSAMPLE = 4096;
constexpr float EPS = 1e-6f;
constexpr int NTHREADS = 512;
#ifndef PROBE_SCAN
#define PROBE_SCAN 1
#endif
#ifndef PROBE_FFNIN
#define PROBE_FFNIN 1
#endif
#ifndef PROBE_P0
#define PROBE_P0 1
#endif
#ifndef PROBE_WIN
#define PROBE_WIN 1
#endif
#ifndef PROBE_FFNOUT_NULL
#define PROBE_FFNOUT_NULL 0
#endif
#ifndef PROBE_G0F
#define PROBE_G0F 1
#endif
#ifndef TIMEPROBE
#define TIMEPROBE -1
#endif
#ifndef PROBE_RES0
#define PROBE_RES0 0
#endif
#ifndef PROBE_BAR
#define PROBE_BAR 1
#endif

constexpr size_t SZ_W1I = (size_t)NFF * DM * 2, SZ_W1O = (size_t)DM * DFF * 2, SZ_WIN = (size_t)NP_ * DM * 2, SZ_WO = (size_t)DM * DM * 2;
constexpr size_t SZ_LAYER = 2 * SZ_W1I + 2 * SZ_W1O + SZ_WIN + SZ_WO;
constexpr size_t OFF_W = 0;
constexpr size_t OFF_LBT = OFF_W + 2 * SZ_LAYER;
constexpr size_t OFF_SSQ = OFF_LBT + 2 * 2 * 1024 * 4;
constexpr size_t SSQ_SITE = (size_t)MTOT * 16;
constexpr size_t OFF_XB = OFF_SSQ + 7 * SSQ_SITE * 4;
constexpr size_t OFF_OBF = OFF_XB + (size_t)MGMAX * DM * 2;
constexpr size_t OFF_RAW = OFF_OBF;
constexpr size_t OFF_PH = OFF_OBF + (size_t)MGMAX * DM * 2;
constexpr size_t OFF_BAR = OFF_PH + (size_t)MGMAX * NP_ * 2;
constexpr size_t WS_END = OFF_BAR + 16384;

__device__ __forceinline__ unsigned pk2(float lo, float hi) {
    typedef __bf16 bf2 __attribute__((ext_vector_type(2)));
    f32x2 v = {lo, hi};
    return __builtin_bit_cast(unsigned, __builtin_convertvector(v, bf2));
}
__device__ __forceinline__ float bflo(unsigned u) { return __uint_as_float(u << 16); }
__device__ __forceinline__ float bfhi(unsigned u) { return __uint_as_float(u & 0xffff0000u); }
__device__ __forceinline__ int grow_tile(int g, int pm) { return (g == 0 ? 32768 : 0) + pm * 256; }
__device__ __forceinline__ int grow(int g, int r) { return (g == 0 ? 32768 : 0) + r; }
__device__ __forceinline__ float sigmoid_f(float x) { return __builtin_amdgcn_rcpf(1.f + __builtin_amdgcn_exp2f(x * -1.44269504f)); }
__device__ __forceinline__ float log2sig_f(float z) { return fminf(z, 0.f) * 1.44269504f - __builtin_amdgcn_logf(1.f + __builtin_amdgcn_exp2f(fabsf(z) * -1.44269504f)); }

__device__ __forceinline__ float bperm(float x, int byte_idx) { return __int_as_float(__builtin_amdgcn_ds_bpermute(byte_idx, __float_as_int(x))); }
__device__ __forceinline__ float row_rstd(const float* ssq16, int R, int fq, int i16, int i32) {
    const f32x4 v = *(const f32x4*)(ssq16 + (size_t)R * 16 + 4 * fq);
    float s = (v[0] + v[1]) + (v[2] + v[3]);
    s += bperm(s, i16); s += bperm(s, i32);
    return rsqrtf(s * (1.f / 1024.f) + EPS);
}

__device__ __forceinline__ void rows_rstd8(float (&rs)[8], const float* ssq16, int Rbase  , int fq, int i16, int i32) {
    f32x4 v[8];
#pragma unroll
    for (int q = 0; q < 8; ++q) v[q] = *(const f32x4*)(ssq16 + (size_t)(Rbase + (q >> 2) * 128 + (q & 3) * 16) * 16 + 4 * fq);
    float s1[8], t1[8];
#pragma unroll
    for (int q = 0; q < 8; ++q) s1[q] = (v[q][0] + v[q][1]) + (v[q][2] + v[q][3]);
#pragma unroll
    for (int q = 0; q < 8; ++q) t1[q] = bperm(s1[q], i16);
#pragma unroll
    for (int q = 0; q < 8; ++q) s1[q] += t1[q];
#pragma unroll
    for (int q = 0; q < 8; ++q) t1[q] = bperm(s1[q], i32);
#pragma unroll
    for (int q = 0; q < 8; ++q) rs[q] = __builtin_amdgcn_rsqf((s1[q] + t1[q]) * (1.f / 1024.f) + EPS);
}

namespace pg8 {
constexpr int BM = 256, BK = 64, HALF = 128, HTB = HALF * BK * 2, STAGE_BYTES = 8 * HTB, NXCD = 8, WGM = 8;
__device__ __forceinline__ int lds_byte(int r, int c) { const int st = (r >> 4) * 2 + (c >> 5), rr = r & 15, cc = c & 31, ob = rr * 64 + cc * 2; return st * 1024 + (ob ^ (((ob >> 9) & 1) << 5)); }
__device__ __forceinline__ void stage_rc(int b, int& R, int& C) { const int st = b / 1024, sb = b % 1024, swz = sb ^ (((sb >> 9) & 1) << 5); R = (st >> 1) * 16 + swz / 64; C = (st & 1) * 32 + (swz % 64) / 2; }
__device__ __forceinline__ int perm32(int rho) { const int n = rho >> 4, i = rho & 15; return 8 * (i >> 2) + 4 * n + (i & 3); }
struct Unit { int pm, pn, ord; };
struct Gemm { const bf16_t* A; const bf16_t* Bt; int M, N, K; };
struct StaticOrder {
    int nM, nN, nwg, G, c;
    __device__ void init(int M, int N, int G_, int c_) { nM = M / BM; nN = N / BM; nwg = nM * nN; G = G_; c = c_; }
    __device__ bool next(int i, Unit& u) const {
        const long L = (long)i * G + c; if (L >= nwg) return false;
        int wgid = (int)L; { const int q = nwg / NXCD, r = nwg % NXCD, xcd = wgid % NXCD, off = wgid / NXCD; wgid = (xcd < r ? xcd * (q + 1) : r * (q + 1) + (xcd - r) * q) + off; }
        const int nig = WGM * nN, gid = wgid / nig, fm = gid * WGM, gsz = (nM - fm) < WGM ? (nM - fm) : WGM;
        u.pm = fm + ((wgid % nig) % gsz); u.pn = (wgid % nig) / gsz; u.ord = i; return true;
    }
};

template <class Epi>
__device__ __forceinline__ void gemm_phase(LAS unsigned char* lds, const Gemm g, const StaticOrder& S, const Epi& E) {
    int tid_ = threadIdx.x; asm volatile("" : "+v"(tid_));
    const int tid = tid_, wid = __builtin_amdgcn_readfirstlane(tid >> 6), lane = tid & 63, wr = wid >> 2, wc = wid & 3, fr = lane & 15, fq = lane >> 4;
    const int K = g.K, nt = K / BK;
    unsigned voffA[2], voffB[2];
#pragma unroll
    for (int i = 0; i < 2; ++i) { int R, C; stage_rc(tid * 16 + i * 8192, R, C); const int Rb = Epi::PERM ? ((R & ~31) + perm32(R & 31)) : R;
        voffA[i] = (unsigned)(R * K + C) * 2u; voffB[i] = (unsigned)(Rb * K + C) * 2u; }
    const size_t kstep = (size_t)(BK * 2);
    const size_t hstep = (size_t)HALF * K * 2;
    const size_t tstep = 2 * hstep;
    const unsigned ldsw = (unsigned)wid * 1024u;
    const int aoff = lds_byte(wr * 64 + fr, fq * 8), boff = lds_byte(wc * 32 + fr, fq * 8);
#define PG8_SA(b, h) (((b) * 2 + (h)) * HTB)
#define PG8_SB(b, h) ((4 + (b) * 2 + (h)) * HTB)
#define PG8_STAGE(bufoff, gbase, voff) do { _Pragma("unroll") for (int _i = 0; _i < 2; ++_i) \
        __builtin_amdgcn_global_load_lds((const unsigned*)((const char*)(gbase) + (voff)[_i]), (LAS unsigned*)(lds + (bufoff) + ldsw + _i * 8192), 16, 0, 0); } while (0)
#define PG8_LDA(dst, b, h) do { _Pragma("unroll") for (int m = 0; m < 4; ++m) _Pragma("unroll") for (int k = 0; k < 2; ++k) dst[m][k] = *(const LAS bf16x8*)(lds + PG8_SA(b, h) + aoff + m * 2048 + k * 1024); } while (0)
#define PG8_LDB(dst, b, h) do { _Pragma("unroll") for (int n = 0; n < 2; ++n) _Pragma("unroll") for (int k = 0; k < 2; ++k) dst[n][k] = *(const LAS bf16x8*)(lds + PG8_SB(b, h) + boff + n * 2048 + k * 1024); } while (0)
#define PG8_MMA(ai, bj, At, Bt) do { __builtin_amdgcn_s_setprio(1); _Pragma("unroll") for (int m = 0; m < 4; ++m) _Pragma("unroll") for (int n = 0; n < 2; ++n) _Pragma("unroll") for (int k = 0; k < 2; ++k) \
        acc[ai][bj][m][n] = __builtin_amdgcn_mfma_f32_16x16x32_bf16(Bt[n][k], At[m][k], acc[ai][bj][m][n], 0, 0, 0); __builtin_amdgcn_s_setprio(0); } while (0)
#define PG8_WAIT_V(n) asm volatile("s_waitcnt vmcnt(" #n ")" ::: "memory")
#define PG8_WAIT_L(n) asm volatile("s_waitcnt lgkmcnt(" #n ")" ::: "memory")
#define PG8_BAR __builtin_amdgcn_s_barrier()
#define PG8_SCHED __builtin_amdgcn_sched_barrier(0)
    Unit cur, nxt; int ui = 0;
    if (!S.next(0, cur)) return;
    f32x4 acc[2][2][4][2];
#pragma unroll
    for (int a = 0; a < 2; ++a)
#pragma unroll
        for (int b = 0; b < 2; ++b)
#pragma unroll
            for (int m = 0; m < 4; ++m)
#pragma unroll
                for (int n = 0; n < 2; ++n) acc[a][b][m][n] = (f32x4){0.f, 0.f, 0.f, 0.f};
    bf16x8 At[4][2], B0[2][2], B1[2][2];
    const char* cA = (const char*)g.A + (size_t)cur.pm * tstep; const char* cB = (const char*)g.Bt + (size_t)cur.pn * tstep;
    PG8_STAGE(PG8_SB(0, 0), cB, voffB); PG8_STAGE(PG8_SA(0, 0), cA, voffA); PG8_STAGE(PG8_SB(0, 1), cB + hstep, voffB); PG8_STAGE(PG8_SA(0, 1), cA + hstep, voffA);
    if (wr == 1) PG8_BAR;
    PG8_WAIT_V(4); PG8_BAR;
    PG8_STAGE(PG8_SB(1, 0), cB + kstep, voffB); PG8_STAGE(PG8_SA(1, 0), cA + kstep, voffA); PG8_STAGE(PG8_SB(1, 1), cB + hstep + kstep, voffB);
    PG8_WAIT_V(6); PG8_BAR;
    for (;;) {
        const bool has_next = S.next(ui + 1, nxt);
        const char* nA = has_next ? (const char*)g.A + (size_t)nxt.pm * tstep : cA; const char* nB = has_next ? (const char*)g.Bt + (size_t)nxt.pn * tstep : cB;
        for (int t = 0; t < nt; t += 2) {
            const bool last = (t == nt - 2);
            const char* a1 = cA + (size_t)(t + 1) * kstep;
            const char* a2 = last ? nA : cA + (size_t)(t + 2) * kstep; const char* b2 = last ? nB : cB + (size_t)(t + 2) * kstep;
            const char* a3 = a2 + kstep; const char* b3 = b2 + kstep;
            PG8_LDB(B0, 0, 0); PG8_SCHED; PG8_LDA(At, 0, 0); PG8_STAGE(PG8_SA(1, 1), a1 + hstep, voffA);
            PG8_WAIT_L(8); PG8_BAR; PG8_WAIT_L(0); PG8_MMA(0, 0, At, B0); PG8_BAR; PG8_SCHED;
            PG8_LDB(B1, 0, 1); PG8_STAGE(PG8_SB(0, 0), b2, voffB);
            PG8_BAR; PG8_WAIT_L(0); PG8_MMA(0, 1, At, B1); PG8_BAR;
            PG8_LDA(At, 0, 1); PG8_STAGE(PG8_SA(0, 0), a2, voffA);
            PG8_BAR; PG8_WAIT_L(0); PG8_MMA(1, 0, At, B0); PG8_BAR; PG8_SCHED;
            PG8_STAGE(PG8_SB(0, 1), b2 + hstep, voffB);
            PG8_WAIT_V(6); PG8_BAR; PG8_MMA(1, 1, At, B1); PG8_BAR;
            PG8_LDB(B0, 1, 0); PG8_SCHED; PG8_LDA(At, 1, 0); PG8_STAGE(PG8_SA(0, 1), a2 + hstep, voffA);
            PG8_WAIT_L(8); PG8_BAR; PG8_WAIT_L(0); PG8_MMA(0, 0, At, B0); PG8_BAR; PG8_SCHED;
            PG8_LDB(B1, 1, 1); PG8_STAGE(PG8_SB(1, 0), b3, voffB);
            PG8_BAR; PG8_WAIT_L(0); PG8_MMA(0, 1, At, B1); PG8_BAR;
            PG8_LDA(At, 1, 1); PG8_STAGE(PG8_SA(1, 0), a3, voffA);
            PG8_BAR; PG8_WAIT_L(0); PG8_MMA(1, 0, At, B0); PG8_BAR; PG8_SCHED;
            PG8_STAGE(PG8_SB(1, 1), b3 + hstep, voffB);
            PG8_WAIT_V(6); PG8_BAR; PG8_MMA(1, 1, At, B1); PG8_BAR;
        }
        E(acc, cur, wr, wc, fr, fq);
        if (!has_next) break;
#pragma unroll
        for (int a = 0; a < 2; ++a)
#pragma unroll
            for (int b = 0; b < 2; ++b)
#pragma unroll
                for (int m = 0; m < 4; ++m)
#pragma unroll
                    for (int n = 0; n < 2; ++n) acc[a][b][m][n] = (f32x4){0.f, 0.f, 0.f, 0.f};
        cur = nxt; cA = nA; cB = nB; ++ui;
    }
    PG8_WAIT_V(0);
    if (wr == 0) PG8_BAR;
    PG8_BAR;
#undef PG8_SA
#undef PG8_SB
#undef PG8_STAGE
#undef PG8_LDA
#undef PG8_LDB
#undef PG8_MMA
#undef PG8_WAIT_V
#undef PG8_WAIT_L
#undef PG8_BAR
#undef PG8_SCHED
}
}

constexpr int RSTD_OFF = 131072;
__device__ __forceinline__ void precompute_rstd(LAS unsigned char* L, const float* ssq16, const pg8::StaticOrder& S, int g) {
    int tid_ = threadIdx.x; asm volatile("" : "+v"(tid_));
    const int row = tid_ >> 1, hf = tid_ & 1, ix1 = ((tid_ & 63) ^ 1) << 2;
    const int nunits = (S.nwg - S.c + S.G - 1) / S.G;
    for (int i0 = 0; i0 < nunits; i0 += 8) {
        f32x4 a[8], b[8];
#pragma unroll
        for (int k = 0; k < 8; ++k) {
            pg8::Unit u; const int ii = (i0 + k < nunits) ? i0 + k : nunits - 1; S.next(ii, u);
            const float* p = ssq16 + (size_t)(grow_tile(g, u.pm) + row) * 16 + hf * 8;
            a[k] = *(const f32x4*)p; b[k] = *(const f32x4*)(p + 4);
        }
#pragma unroll
        for (int k = 0; k < 8; ++k) {
            float s = ((a[k][0] + a[k][1]) + (a[k][2] + a[k][3])) + ((b[k][0] + b[k][1]) + (b[k][2] + b[k][3]));
            s += bperm(s, ix1);
            if (hf == 0 && i0 + k < nunits) *(LAS float*)(L + RSTD_OFF + ((i0 + k) * 256 + row) * 4) = __builtin_amdgcn_rsqf(s * (1.f / 1024.f) + EPS);
        }
    }
    __syncthreads();
}

struct EpiFfnIn {
    static constexpr bool PERM = true;
    bf16_t* H; LAS unsigned char* L; int g;
    __device__ __forceinline__ void operator()(const f32x4 (&acc)[2][2][4][2], const pg8::Unit& u, int wr, int wc, int fr_in, int fq) const {
        int fr = fr_in; asm volatile("" : "+v"(fr));
        const int lane_ = fr | (fq << 4), i16 = (lane_ ^ 16) << 2, i32 = (lane_ ^ 32) << 2; (void)i16; (void)i32;
        const int R0 = grow_tile(g, u.pm);
        const int col0 = u.pn * 128 + wc * 32 + 8 * fq;
        float rs8[8];
#pragma unroll
        for (int q = 0; q < 8; ++q) rs8[q] = *(const LAS float*)(L + RSTD_OFF + (u.ord * 256 + wr * 64 + fr + (q >> 2) * 128 + (q & 3) * 16) * 4);
#pragma unroll
        for (int ai = 0; ai < 2; ++ai)
#pragma unroll
            for (int m = 0; m < 4; ++m) {
                const int rt = ai * 128 + wr * 64 + m * 16 + fr;
                const float rs = rs8[ai * 4 + m];
                float hv[8];
                const float nrs = rs * -1.44269504f;
#pragma unroll
                for (int n = 0; n < 2; ++n)
#pragma unroll
                    for (int jp = 0; jp < 2; ++jp) {
                        const f32x2 ra = {acc[ai][0][m][n][2 * jp], acc[ai][0][m][n][2 * jp + 1]}, rb = {acc[ai][1][m][n][2 * jp], acc[ai][1][m][n][2 * jp + 1]};
                        f32x2 na = ra * nrs; na.x = fminf(na.x, 60.f); na.y = fminf(na.y, 60.f);
                        f32x2 d; d.x = __builtin_amdgcn_exp2f(na.x); d.y = __builtin_amdgcn_exp2f(na.y); d = d + 1.0f;
                        const float rinv = __builtin_amdgcn_rcpf(d.x * d.y);
                        const f32x2 ab = (ra * rs) * (rb * rs);
                        const f32x2 sg = {rinv * d.y, rinv * d.x};
                        const f32x2 hh = ab * sg;
                        hv[n * 4 + 2 * jp] = hh.x; hv[n * 4 + 2 * jp + 1] = hh.y;
                    }
                u32x4 w; w.x = pk2(hv[0], hv[1]); w.y = pk2(hv[2], hv[3]); w.z = pk2(hv[4], hv[5]); w.w = pk2(hv[6], hv[7]);
                *(u32x4*)(H + (size_t)(u.pm * 256 + rt) * DFF + col0) = w;
            }
    }
};
struct EpiNull { static constexpr bool PERM = true; float* sink; __device__ __forceinline__ void operator()(const f32x4 (&acc)[2][2][4][2], const pg8::Unit& u, int wr, int wc, int fr, int fq) const {
    float s = 0.f;
#pragma unroll
    for (int a = 0; a < 2; ++a)
#pragma unroll
        for (int b = 0; b < 2; ++b)
#pragma unroll
            for (int m = 0; m < 4; ++m)
#pragma unroll
                for (int n = 0; n < 2; ++n) s += (acc[a][b][m][n][0] + acc[a][b][m][n][1]) + (acc[a][b][m][n][2] + acc[a][b][m][n][3]);
    if (s == 123.456f) sink[0] = 1.f; } };
struct EpiRes {
    static constexpr bool PERM = true;
    bf16_t* XB; float* ssq; float scale; int g;
    __device__ __forceinline__ void operator()(const f32x4 (&acc)[2][2][4][2], const pg8::Unit& u, int wr, int wc, int fr_in, int fq) const {
        int fr = fr_in; asm volatile("" : "+v"(fr));
        const int lane_ = fr | (fq << 4), i16 = (lane_ ^ 16) << 2, i32 = (lane_ ^ 32) << 2; (void)i16; (void)i32;
        const int R0 = grow_tile(g, u.pm);
        u32x4 old[2][4][2];
#pragma unroll
        for (int ai = 0; ai < 2; ++ai)
#pragma unroll
            for (int m = 0; m < 4; ++m)
#pragma unroll
                for (int bj = 0; bj < 2; ++bj)
                    old[ai][m][bj] = *(const u32x4*)(XB + (size_t)(u.pm * 256 + ai * 128 + wr * 64 + m * 16 + fr) * DM + u.pn * 256 + bj * 128 + wc * 32 + 8 * fq);
#pragma unroll
        for (int ai = 0; ai < 2; ++ai) {
#pragma unroll
            for (int m = 0; m < 4; ++m) {
                const int rt = ai * 128 + wr * 64 + m * 16 + fr;
                bf16_t* xb = XB + (size_t)(u.pm * 256 + rt) * DM;
                float part = 0.f;
#pragma unroll
                for (int bj = 0; bj < 2; ++bj) {
                    const int c0 = u.pn * 256 + bj * 128 + wc * 32 + 8 * fq;
                    const u32x4 o = old[ai][m][bj];
                    const f32x4 a0 = acc[ai][bj][m][0], a1 = acc[ai][bj][m][1];
                    float n[8];
                    n[0] = bflo(o.x) + a0[0] * scale; n[1] = bfhi(o.x) + a0[1] * scale; n[2] = bflo(o.y) + a0[2] * scale; n[3] = bfhi(o.y) + a0[3] * scale;
                    n[4] = bflo(o.z) + a1[0] * scale; n[5] = bfhi(o.z) + a1[1] * scale; n[6] = bflo(o.w) + a1[2] * scale; n[7] = bfhi(o.w) + a1[3] * scale;
                    u32x4 w; w.x = pk2(n[0], n[1]); w.y = pk2(n[2], n[3]); w.z = pk2(n[4], n[5]); w.w = pk2(n[6], n[7]);
                    *(u32x4*)(xb + c0) = w;
                    part += (n[0] * n[0] + n[1] * n[1]) + (n[2] * n[2] + n[3] * n[3]) + (n[4] * n[4] + n[5] * n[5]) + (n[6] * n[6] + n[7] * n[7]);
                }
                part += bperm(part, i16); part += bperm(part, i32);
                if (fq == 0) ssq[(size_t)(R0 + rt) * 16 + u.pn * 4 + wc] = part;
            }
        }
    }
};
struct EpiWin {
    static constexpr bool PERM = true;
    bf16_t* P; LAS unsigned char* L; const float* lbA; const float* lbB; const float* bg; int g;
    template <int MODE>
    __device__ __forceinline__ void body(const f32x4 (&acc)[2][2][4][2], const pg8::Unit& u, int wr, int wc, int fr, int fq, const float* tab) const {
        const int pn = u.pn;
        float rs8[8];
#pragma unroll
        for (int q = 0; q < 8; ++q) rs8[q] = *(const LAS float*)(L + RSTD_OFF + (u.ord * 256 + wr * 64 + fr + (q >> 2) * 128 + (q & 3) * 16) * 4);
        f32x4 ta[2][2], tb[2][2];
        if (MODE == 1 || MODE == 4) {
#pragma unroll
            for (int bj = 0; bj < 2; ++bj) { const int lc = bj * 128 + wc * 32 + 8 * fq;
                ta[bj][0] = *(const f32x4*)(tab + lc); ta[bj][1] = *(const f32x4*)(tab + lc + 4);
                if (MODE == 1) { tb[bj][0] = *(const f32x4*)(tab + 1024 + lc); tb[bj][1] = *(const f32x4*)(tab + 1024 + lc + 4); } }
        }
#pragma unroll
        for (int bj = 0; bj < 2; ++bj) {
            const int cin = bj * 128 + wc * 32 + 8 * fq;
#pragma unroll
            for (int ai = 0; ai < 2; ++ai)
#pragma unroll
                for (int m = 0; m < 4; ++m) {
                    const int rt = ai * 128 + wr * 64 + m * 16 + fr;
                    const float rs = rs8[ai * 4 + m];
                    float v[8];
#pragma unroll
                    for (int n = 0; n < 2; ++n)
#pragma unroll
                        for (int j = 0; j < 4; ++j) v[n * 4 + j] = acc[ai][bj][m][n][j] * rs;
                    if (MODE == 1) {
#pragma unroll
                        for (int j = 0; j < 8; ++j) v[j] = __builtin_amdgcn_logf(ta[bj][j >> 2][j & 3] + tb[bj][j >> 2][j & 3] * sigmoid_f(v[j]));
                    } else if (MODE == 2) {
#pragma unroll
                        for (int j = 0; j < 8; ++j) v[j] = sigmoid_f(v[j]);
                    } else if (MODE == 4) {
#pragma unroll
                        for (int j = 0; j < 8; ++j) v[j] = log2sig_f(v[j] + ta[bj][j >> 2][j & 3]) * (1.f / 16.f);
                    } else if (MODE == 5) {
#pragma unroll
                        for (int j = 0; j < 8; ++j) v[j] = v[j] * sigmoid_f(v[j]);
                    }
                    u32x4 w; w.x = pk2(v[0], v[1]); w.y = pk2(v[2], v[3]); w.z = pk2(v[4], v[5]); w.w = pk2(v[6], v[7]);
                    *(u32x4*)(P + (size_t)(u.pm * 256 + rt) * NP_ + pn * 256 + cin) = w;
                }
        }
    }
    __device__ __forceinline__ void operator()(const f32x4 (&acc)[2][2][4][2], const pg8::Unit& u, int wr, int wc, int fr_in, int fq) const {
        int fr = fr_in; asm volatile("" : "+v"(fr));
        const int pn = u.pn;
        if (pn >= 2 && pn <= 5) body<1>(acc, u, wr, wc, fr, fq, lbA + 256 * (pn - 2));
        else if (pn == 8 || pn == 9) body<2>(acc, u, wr, wc, fr, fq, nullptr);
        else if (pn == 14 || pn == 15) body<4>(acc, u, wr, wc, fr, fq, bg + 256 * (pn - 14));
        else if (pn >= 16) body<5>(acc, u, wr, wc, fr, fq, nullptr);
        else body<0>(acc, u, wr, wc, fr, fq, nullptr);
    }
};

struct Args {
    const float* xp; const float* xs; const float* lower_bounds; const float* n1; const float* w1i; const float* w1o; const float* nm; const float* wi;
    const float* wg; const float* bg; const float* hgn; const float* glan; const float* wo; const float* n2; const float* w2i; const float* w2o; const float* nf;
    float* out; unsigned char* ws;
};

__device__ __forceinline__ void p0_convert(const Args& A) {
    const long nth = (long)gridDim.x * NTHREADS, gt = (long)blockIdx.x * NTHREADS + threadIdx.x;
    unsigned char* ws = A.ws;
    const long cnt[6] = {(long)NFF * 128, (long)DM * 352, (long)NP_ * 128, (long)DM * 128, (long)NFF * 128, (long)DM * 352};
    const long per_layer = cnt[0] + cnt[1] + cnt[2] + cnt[3] + cnt[4] + cnt[5];
    for (long it = gt; it < 2 * per_layer; it += nth) {
        const int l = it >= per_layer ? 1 : 0; long i = it - (long)l * per_layer;
        int job = 0;
#pragma unroll
        for (int j = 0; j < 5; ++j) if (job == j && i >= cnt[j]) { i -= cnt[j]; job = j + 1; }
        unsigned char* wl = ws + OFF_W + (size_t)l * SZ_LAYER;
        float v[8];
        bf16_t* dst;
        if (job == 0 || job == 4) {
            const int np = (int)(i % NFF), k0 = (int)(i / NFF) * 8;
            const float* W = (job == 0 ? A.w1i : A.w2i) + (size_t)l * DM * NFF; const float* gn = (job == 0 ? A.n1 : A.n2) + l * DM;
            const int n = ((np & 128) ? DFF : 0) + (np >> 8) * 128 + (np & 127);
#pragma unroll
            for (int e = 0; e < 8; ++e) v[e] = W[(size_t)(k0 + e) * NFF + n] * gn[k0 + e];
            dst = (bf16_t*)(wl + (job == 0 ? 0 : SZ_W1I + SZ_W1O + SZ_WIN + SZ_WO)) + (size_t)np * DM + k0;
        } else if (job == 1 || job == 5) {
            const int np = (int)(i % DM), k0 = (int)(i / DM) * 8;
            const float* W = (job == 1 ? A.w1o : A.w2o) + (size_t)l * DFF * DM;
#pragma unroll
            for (int e = 0; e < 8; ++e) v[e] = W[(size_t)(k0 + e) * DM + np];
            dst = (bf16_t*)(wl + (job == 1 ? SZ_W1I : 2 * SZ_W1I + SZ_W1O + SZ_WIN + SZ_WO)) + (size_t)np * DFF + k0;
        } else if (job == 3) {
            const int np = (int)(i % DM), k0 = (int)(i / DM) * 8;
            const float* W = A.wo + (size_t)l * DM * DM;
#pragma unroll
            for (int e = 0; e < 8; ++e) v[e] = W[(size_t)(k0 + e) * DM + np];
            dst = (bf16_t*)(wl + SZ_W1I + SZ_W1O + SZ_WIN) + (size_t)np * DM + k0;
        } else {
            const int np = (int)(i % NP_), k0 = (int)(i / NP_) * 8;
            const float* W = A.wi + (size_t)l * DM * DINSRC; const float* gn = A.nm + l * DM;
            if (np >= 3584 && np < 4096) {
                const int d = np >= 3840 ? 1 : 0, c = np - 3584 - 256 * d;
                const float* G = A.wg + ((size_t)l * 2 + d) * 16 * 256;
                float gc[16];
#pragma unroll
                for (int r = 0; r < 16; ++r) gc[r] = G[r * 256 + c];
#pragma unroll
                for (int e = 0; e < 8; ++e) { const float* wr_ = W + (size_t)(k0 + e) * DINSRC + 3584 + 16 * d; float s = 0.f;
#pragma unroll
                    for (int r = 0; r < 16; ++r) s += wr_[r] * gc[r];
                    v[e] = s * gn[k0 + e]; }
            } else {
                const int n = np < 3584 ? np : 3616 + (np - 4096);
                const float sc = (np >= 2560 && np < 2816) ? 0.125f : 1.f;
#pragma unroll
                for (int e = 0; e < 8; ++e) v[e] = W[(size_t)(k0 + e) * DINSRC + n] * gn[k0 + e] * sc;
            }
            dst = (bf16_t*)(wl + SZ_W1I + SZ_W1O) + (size_t)np * DM + k0;
        }
        u32x4 w; w.x = pk2(v[0], v[1]); w.y = pk2(v[2], v[3]); w.z = pk2(v[4], v[5]); w.w = pk2(v[6], v[7]);
        *(u32x4*)dst = w;
    }
    float* lbt = (float*)(ws + OFF_LBT);
    for (long i = gt; i < 2048; i += nth) {
        const int l = (int)(i >> 10), c = (int)(i & 1023);
        const float a = A.lower_bounds[c], b = A.lower_bounds[1024 + c], mx = fmaxf(a, b);
        const float ea = __expf(a - mx), eb = __expf(b - mx);
        const float lb = l == 0 ? 0.f : eb / (ea + eb);
        lbt[l * 2048 + c] = fmaxf(lb, 1e-30f);
        lbt[l * 2048 + 1024 + c] = 1.f - lb;
    }
}

__device__ __forceinline__ void g0_prologue(const float* xp, const float* xs, unsigned char* ws, int g) {
    int tid_ = threadIdx.x; asm volatile("" : "+v"(tid_));
    const int lane = tid_ & 63, wv = blockIdx.x * 8 + (tid_ >> 6), nwv = gridDim.x * 8;
    bf16_t* XB = (bf16_t*)(ws + OFF_XB); float* ssq = (float*)(ws + OFF_SSQ);
    const int nrows = g == 0 ? 65536 : 32768;
    for (int r0 = wv; r0 < nrows; r0 += 8 * nwv) {
        f32x4 v[8][4];
#pragma unroll
        for (int k = 0; k < 8; ++k) { const int R = grow(g, r0 + k * nwv);
            const float* x = R < 32768 ? xp + (size_t)R * DM : xs + (size_t)(R - 32768) * DM;
#pragma unroll
            for (int i = 0; i < 4; ++i) v[k][i] = *(const f32x4*)(x + i * 256 + lane * 4); }
#pragma unroll
        for (int k = 0; k < 8; ++k) { const int r = r0 + k * nwv, R = grow(g, r);
            float s = 0.f;
#pragma unroll
            for (int i = 0; i < 4; ++i) { const f32x4 q = v[k][i];
                s += (q[0] * q[0] + q[1] * q[1]) + (q[2] * q[2] + q[3] * q[3]);
                u32x2 w; w.x = pk2(q[0], q[1]); w.y = pk2(q[2], q[3]); *(u32x2*)(XB + (size_t)r * DM + i * 256 + lane * 4) = w; }
#pragma unroll
            for (int o = 32; o >= 1; o >>= 1) s += bperm(s, (lane ^ o) << 2);
            if (lane < 4) *(f32x4*)(ssq + (size_t)R * 16 + 4 * lane) = (f32x4){lane == 0 ? s : 0.f, 0.f, 0.f, 0.f};
        }
    }
}
__device__ __forceinline__ void final_norm(float* outp, const float* nf, unsigned char* ws, int g) {
    int tid_ = threadIdx.x; asm volatile("" : "+v"(tid_));
    const int lane = tid_ & 63, wv = blockIdx.x * 8 + (tid_ >> 6), nwv = gridDim.x * 8;
    const float* ssq = (const float*)(ws + OFF_SSQ) + 6 * SSQ_SITE; const bf16_t* XB = (const bf16_t*)(ws + OFF_XB);
    const int nrows = g == 0 ? 65536 : 32768;
    f32x4 gn[4];
#pragma unroll
    for (int i = 0; i < 4; ++i) gn[i] = *(const f32x4*)(nf + i * 256 + lane * 4);
    for (int r0 = wv; r0 < nrows; r0 += 4 * nwv) {
        f32x4 q[4][4]; u32x2 xv[4][4];
#pragma unroll
        for (int k = 0; k < 4; ++k) { const int r = r0 + k * nwv, R = grow(g, r);
#pragma unroll
            for (int i = 0; i < 4; ++i) { q[k][i] = *(const f32x4*)(ssq + (size_t)R * 16 + 4 * i); xv[k][i] = *(const u32x2*)(XB + (size_t)r * DM + i * 256 + lane * 4); } }
#pragma unroll
        for (int k = 0; k < 4; ++k) { const int R = grow(g, r0 + k * nwv);
            float* x = outp + (size_t)R * DM;
            const f32x4 q0 = q[k][0], q1 = q[k][1], q2 = q[k][2], q3 = q[k][3];
            const float rs = __builtin_amdgcn_rsqf((((q0[0] + q0[1]) + (q0[2] + q0[3])) + ((q1[0] + q1[1]) + (q1[2] + q1[3])) + (((q2[0] + q2[1]) + (q2[2] + q2[3])) + ((q3[0] + q3[1]) + (q3[2] + q3[3])))) * (1.f / 1024.f) + EPS);
#pragma unroll
            for (int i = 0; i < 4; ++i) { const u32x2 t = xv[k][i];
                f32x4 o = {bflo(t.x) * rs * gn[i][0], bfhi(t.x) * rs * gn[i][1], bflo(t.y) * rs * gn[i][2], bfhi(t.y) * rs * gn[i][3]}; *(f32x4*)(x + i * 256 + lane * 4) = o; }
        }
    }
}

#define MFMA32(a, b, c) __builtin_amdgcn_mfma_f32_32x32x16_bf16((a), (b), (c), 0, 0, 0)
constexpr int SC_QT = 0, SC_KT = 34816, SC_VT = 69632, SC_ST = 104448, SC_TOT = 139264, SC_VEC = 143360, SC_RED = 144896, SC_END = 145920;
constexpr int TSTR = 272;

#define LDS_BARRIER() do { asm volatile("s_waitcnt lgkmcnt(0)" ::: "memory"); __builtin_amdgcn_s_barrier(); asm volatile("" ::: "memory"); } while (0)
template <int DK, bool second>
__device__ __forceinline__ void scan_half(LAS unsigned char* L, const bf16_t* __restrict__ P, bf16_t* RAW, bf16_t* OBF, const float* __restrict__ gain,
                                          int seqbase, int T, int dir, int qcol, int kcol, int gcol, int vcol, int gatecol, int ocol,
                                          int j0, int j1, f32x16& S0, f32x16& S1) {
    constexpr bool GLA = (DK == 64);
    constexpr int NPAIR = DK / 2, NSEG = NTHREADS / NPAIR, SL = 128 / NSEG, QSTR = (DK + 8) * 2, NKS = DK / 16;
    int tid_ = threadIdx.x; asm volatile("" : "+v"(tid_));
    const int tid = tid_, lane = tid & 63, w = __builtin_amdgcn_readfirstlane(tid >> 6);
    const int r = lane & 31, h = lane >> 5;
    const int cp = tid % NPAIR, seg = tid / NPAIR, vp = tid & 63, vseg = tid >> 6;
    const int tb = w >> 1, dh = w & 1, dvb_s = w & 3, kq = w >> 2;
    unsigned g2[SL], q2[SL], k2[SL], v2[16];

#define ROWOF(j, i) (seqbase + (dir ? (T - 1 - ((j) * 128 + (i))) : ((j) * 128 + (i))))
    const char* Pg = (const char*)P + gcol * 2; const char* Pq = (const char*)P + qcol * 2; const char* Pk = (const char*)P + kcol * 2; const char* Pv = (const char*)P + vcol * 2;
    const int rstep = dir ? -(NP_ * 2) : (NP_ * 2);
#define LOAD_CHUNK(j) do { int jj_ = (j); asm volatile("" : "+s"(jj_)); \
        { const int p0_ = jj_ * 128 + seg * SL; const int off0_ = (seqbase + (dir ? (T - 1 - p0_) : p0_)) * (NP_ * 2) + 4 * cp; \
          _Pragma("unroll") for (int i_ = 0; i_ < SL; ++i_) { const unsigned o_ = (unsigned)(off0_ + i_ * rstep); \
            g2[i_] = *(const unsigned*)(Pg + o_); q2[i_] = *(const unsigned*)(Pq + o_); if (GLA) k2[i_] = *(const unsigned*)(Pk + o_); else k2[i_] = 0u; } } \
        { const int p0_ = jj_ * 128 + vseg * 16; const int off0_ = (seqbase + (dir ? (T - 1 - p0_) : p0_)) * (NP_ * 2) + 4 * vp; \
          _Pragma("unroll") for (int i_ = 0; i_ < 16; ++i_) { const unsigned o_ = (unsigned)(off0_ + i_ * rstep); v2[i_] = *(const unsigned*)(Pv + o_); } } \
    } while (0)

    if (second) { if (tid < 32) *(LAS f32x4*)(L + SC_END + tid * 16) = *(const f32x4*)(gain + tid * 4); }
    LOAD_CHUNK(j0);
    for (int j = j0; j < j1; ++j) {
        int rq = r * QSTR + 16 * h, rt = r * TSTR + 16 * h, rq8 = r * QSTR + 8 * h, rt8 = r * TSTR + 8 * h, h16 = 16 * h;
        asm volatile("" : "+v"(rq), "+v"(rt), "+v"(rq8), "+v"(rt8), "+v"(h16));
        f32x2 cs[SL];
        { f32x2 run = {0.f, 0.f};
#pragma unroll
          for (int i = 0; i < SL; ++i) { run = run + (f32x2){bflo(g2[i]), bfhi(g2[i])}; cs[i] = run; }
          *(LAS f32x2*)(L + SC_TOT + (seg * DK + 2 * cp) * 4) = run; }
        LDS_BARRIER();
        f32x2 off = {0.f, 0.f}, mm = {0.f, 0.f}, bl = {0.f, 0.f};
#pragma unroll
        for (int s = 0; s < NSEG; ++s) { const f32x2 t = *(const LAS f32x2*)(L + SC_TOT + (s * DK + 2 * cp) * 4);
            if (s < seg) off = off + t;
            if (s < NSEG / 2) mm = mm + t;
            bl = bl + t; }
        unsigned kk[SL];
        const f32x2 dd = off - mm;
#pragma unroll
        for (int i = 0; i < SL; ++i) {
            f32x2 ee = cs[i] + dd;
            ee.x = __builtin_amdgcn_fmed3f(ee.x, -115.f, 115.f); ee.y = __builtin_amdgcn_fmed3f(ee.y, -115.f, 115.f);
            const f32x2 xx = {__builtin_amdgcn_exp2f(ee.x), __builtin_amdgcn_exp2f(ee.y)}, yy = {__builtin_amdgcn_exp2f(-ee.x), __builtin_amdgcn_exp2f(-ee.y)};
            f32x2 kv;
            if (GLA) kv = (f32x2){bflo(k2[i]), bfhi(k2[i])};
            else kv = (f32x2){1.f, 1.f} - (f32x2){__builtin_amdgcn_exp2f(bflo(g2[i])), __builtin_amdgcn_exp2f(bfhi(g2[i]))};
            const f32x2 qv = (f32x2){bflo(q2[i]), bfhi(q2[i])} * xx, kw = kv * yy;
            const unsigned qq = pk2(qv.x, qv.y);
            kk[i] = pk2(kw.x, kw.y);
            *(LAS unsigned*)(L + SC_QT + (seg * SL + i) * QSTR + 4 * cp) = qq;
            *(LAS unsigned*)(L + SC_KT + (seg * SL + i) * QSTR + 4 * cp) = kk[i];
        }
        {
            u32x4 a0, a1, b0, b1;
            a0.x = (v2[0] & 0xffffu) | (v2[1] << 16); a0.y = (v2[2] & 0xffffu) | (v2[3] << 16); a0.z = (v2[4] & 0xffffu) | (v2[5] << 16); a0.w = (v2[6] & 0xffffu) | (v2[7] << 16);
            a1.x = (v2[8] & 0xffffu) | (v2[9] << 16); a1.y = (v2[10] & 0xffffu) | (v2[11] << 16); a1.z = (v2[12] & 0xffffu) | (v2[13] << 16); a1.w = (v2[14] & 0xffffu) | (v2[15] << 16);
            b0.x = (v2[0] >> 16) | (v2[1] & 0xffff0000u); b0.y = (v2[2] >> 16) | (v2[3] & 0xffff0000u); b0.z = (v2[4] >> 16) | (v2[5] & 0xffff0000u); b0.w = (v2[6] >> 16) | (v2[7] & 0xffff0000u);
            b1.x = (v2[8] >> 16) | (v2[9] & 0xffff0000u); b1.y = (v2[10] >> 16) | (v2[11] & 0xffff0000u); b1.z = (v2[12] >> 16) | (v2[13] & 0xffff0000u); b1.w = (v2[14] >> 16) | (v2[15] & 0xffff0000u);
            LAS unsigned char* pv = L + SC_VT + (2 * vp) * TSTR + vseg * 32;
            *(LAS u32x4*)(pv) = a0; *(LAS u32x4*)(pv + 16) = a1; *(LAS u32x4*)(pv + TSTR) = b0; *(LAS u32x4*)(pv + TSTR + 16) = b1;
        }
        if (seg == 0) {
            *(LAS f32x2*)(L + SC_VEC + (2 * cp) * 4) = (f32x2){__builtin_amdgcn_exp2f(mm.x), __builtin_amdgcn_exp2f(mm.y)};
            *(LAS f32x2*)(L + SC_VEC + 512 + (2 * cp) * 4) = (f32x2){__builtin_amdgcn_exp2f(bl.x), __builtin_amdgcn_exp2f(bl.y)};
            *(LAS f32x2*)(L + SC_VEC + 1024 + (2 * cp) * 4) = (f32x2){__builtin_amdgcn_exp2f(bl.x - mm.x), __builtin_amdgcn_exp2f(bl.y - mm.y)};
        }
        LDS_BARRIER();
        if (j + 1 < j1) LOAD_CHUNK(j + 1);
#pragma unroll
        for (int ti = 0; ti < (GLA ? 1 : 2); ++ti) {
            const int kb_ = GLA ? kq : 2 * kq + ti;
            const f32x16& Sx = ti == 0 ? S0 : S1;
#pragma unroll
            for (int gq = 0; gq < 4; ++gq) {
                const int k = 32 * kb_ + 8 * gq + 4 * h;
                const f32x4 em = *(const LAS f32x4*)(L + SC_VEC + (32 * kb_ + 8 * gq) * 4 + h16);
                u32x2 wv; wv.x = pk2(Sx[4 * gq] * em[0], Sx[4 * gq + 1] * em[1]); wv.y = pk2(Sx[4 * gq + 2] * em[2], Sx[4 * gq + 3] * em[3]);
                *(LAS u32x2*)(L + SC_ST + 32 * dvb_s * QSTR + rq8 + (32 * kb_ + 8 * gq) * 2) = wv;
            }
        }
        bf16x8 ps[4][2];
        {
            bf16x8 qf[NKS];
#pragma unroll
            for (int ks = 0; ks < NKS; ++ks) qf[ks] = *(const LAS bf16x8*)(L + SC_QT + 32 * tb * QSTR + rq + 32 * ks);
#pragma unroll
            for (int sb = 0; sb < 4; ++sb) {
                if (sb <= tb) {
                    bf16x8 af[NKS];
#pragma unroll
                    for (int ks = 0; ks < NKS; ++ks) af[ks] = *(const LAS bf16x8*)(L + SC_KT + 32 * sb * QSTR + rq + 32 * ks);
                    f32x16 x;
#pragma unroll
                    for (int i = 0; i < 16; ++i) x[i] = 0.f;
#pragma unroll
                    for (int ks = 0; ks < NKS; ++ks) x = MFMA32(af[ks], qf[ks], x);
                    if (sb == tb) {
#pragma unroll
                        for (int i = 0; i < 16; ++i) { const int cr = (i & 3) + 8 * (i >> 2) + 4 * h; x[i] = cr <= r ? x[i] : 0.f; }
                    }
#pragma unroll
                    for (int ss = 0; ss < 2; ++ss) { u32x4 pw; pw.x = pk2(x[8 * ss], x[8 * ss + 1]); pw.y = pk2(x[8 * ss + 2], x[8 * ss + 3]); pw.z = pk2(x[8 * ss + 4], x[8 * ss + 5]); pw.w = pk2(x[8 * ss + 6], x[8 * ss + 7]);
                        ps[sb][ss] = __builtin_bit_cast(bf16x8, pw); }
                } else { ps[sb][0] = (bf16x8){0, 0, 0, 0, 0, 0, 0, 0}; ps[sb][1] = (bf16x8){0, 0, 0, 0, 0, 0, 0, 0}; }
            }
        }
        LDS_BARRIER();
        {
            LAS unsigned char* pk_ = L + SC_KT + (2 * cp) * TSTR + seg * SL * 2;
            if (SL == 16) {
                u32x4 a0, a1, b0, b1;
                a0.x = (kk[0] & 0xffffu) | (kk[1] << 16); a0.y = (kk[2] & 0xffffu) | (kk[3] << 16); a0.z = (kk[4] & 0xffffu) | (kk[5] << 16); a0.w = (kk[6] & 0xffffu) | (kk[7] << 16);
                a1.x = (kk[8 % SL] & 0xffffu) | (kk[9 % SL] << 16); a1.y = (kk[10 % SL] & 0xffffu) | (kk[11 % SL] << 16); a1.z = (kk[12 % SL] & 0xffffu) | (kk[13 % SL] << 16); a1.w = (kk[14 % SL] & 0xffffu) | (kk[15 % SL] << 16);
                b0.x = (kk[0] >> 16) | (kk[1] & 0xffff0000u); b0.y = (kk[2] >> 16) | (kk[3] & 0xffff0000u); b0.z = (kk[4] >> 16) | (kk[5] & 0xffff0000u); b0.w = (kk[6] >> 16) | (kk[7] & 0xffff0000u);
                b1.x = (kk[8 % SL] >> 16) | (kk[9 % SL] & 0xffff0000u); b1.y = (kk[10 % SL] >> 16) | (kk[11 % SL] & 0xffff0000u); b1.z = (kk[12 % SL] >> 16) | (kk[13 % SL] & 0xffff0000u); b1.w = (kk[14 % SL] >> 16) | (kk[15 % SL] & 0xffff0000u);
                *(LAS u32x4*)(pk_) = a0; *(LAS u32x4*)(pk_ + 16) = a1; *(LAS u32x4*)(pk_ + TSTR) = b0; *(LAS u32x4*)(pk_ + TSTR + 16) = b1;
            } else {
                u32x4 a0, b0;
                a0.x = (kk[0] & 0xffffu) | (kk[1] << 16); a0.y = (kk[2] & 0xffffu) | (kk[3] << 16); a0.z = (kk[4] & 0xffffu) | (kk[5] << 16); a0.w = (kk[6] & 0xffffu) | (kk[7] << 16);
                b0.x = (kk[0] >> 16) | (kk[1] & 0xffff0000u); b0.y = (kk[2] >> 16) | (kk[3] & 0xffff0000u); b0.z = (kk[4] >> 16) | (kk[5] & 0xffff0000u); b0.w = (kk[6] >> 16) | (kk[7] & 0xffff0000u);
                *(LAS u32x4*)(pk_) = a0; *(LAS u32x4*)(pk_ + TSTR) = b0;
            }
        }
        const int orow = ROWOF(j, 32 * tb + r);
        f32x16 O[2];
        {
            bf16x8 qf[NKS];
#pragma unroll
            for (int ks = 0; ks < NKS; ++ks) qf[ks] = *(const LAS bf16x8*)(L + SC_QT + 32 * tb * QSTR + rq + 32 * ks);
#pragma unroll
            for (int dvi = 0; dvi < 2; ++dvi) {
                const int dvb = 2 * dh + dvi;
                bf16x8 sf[NKS];
#pragma unroll
                for (int ks = 0; ks < NKS; ++ks) sf[ks] = *(const LAS bf16x8*)(L + SC_ST + 32 * dvb * QSTR + rq + 32 * ks);
                f32x16 o;
#pragma unroll
                for (int i = 0; i < 16; ++i) o[i] = 0.f;
#pragma unroll
                for (int ks = 0; ks < NKS; ++ks) o = MFMA32(sf[ks], qf[ks], o);
                O[dvi] = o;
            }
        }
        u32x2 praw[2][4], gts[2][4];
        if (second) {
#pragma unroll
            for (int dvi = 0; dvi < 2; ++dvi)
#pragma unroll
                for (int gq = 0; gq < 4; ++gq) { praw[dvi][gq] = *(const u32x2*)(RAW + (size_t)orow * DM + ocol + 32 * (2 * dh + dvi) + 8 * gq + 4 * h);
                    gts[dvi][gq] = *(const u32x2*)(P + (size_t)orow * NP_ + gatecol + 32 * (2 * dh + dvi) + 8 * gq + 4 * h); }
        }
#pragma unroll
        for (int dvi = 0; dvi < 2; ++dvi) {
            const int dvb = 2 * dh + dvi;
            f32x16 o = O[dvi];
#pragma unroll
            for (int sb = 0; sb < 4; ++sb) {
                if (sb <= tb) {
                    const LAS unsigned char* pa = L + SC_VT + 32 * dvb * TSTR + rt8 + 64 * sb;
                    const s16x4 l0 = *(const LAS s16x4*)(pa), h0 = *(const LAS s16x4*)(pa + 16), l1 = *(const LAS s16x4*)(pa + 32), h1 = *(const LAS s16x4*)(pa + 48);
                    o = MFMA32(__builtin_shufflevector(l0, h0, 0, 1, 2, 3, 4, 5, 6, 7), ps[sb][0], o);
                    o = MFMA32(__builtin_shufflevector(l1, h1, 0, 1, 2, 3, 4, 5, 6, 7), ps[sb][1], o);
                }
            }
            O[dvi] = o;
        }
        if (!second) {
#pragma unroll
            for (int dvi = 0; dvi < 2; ++dvi)
#pragma unroll
                for (int gq = 0; gq < 4; ++gq) {
                    const int dv = 32 * (2 * dh + dvi) + 8 * gq + 4 * h;
                    u32x2 wv; wv.x = pk2(O[dvi][4 * gq], O[dvi][4 * gq + 1]); wv.y = pk2(O[dvi][4 * gq + 2], O[dvi][4 * gq + 3]);
                    *(u32x2*)(RAW + (size_t)orow * DM + ocol + dv) = wv;
                }
        } else {
            float ssum = 0.f;
#pragma unroll
            for (int dvi = 0; dvi < 2; ++dvi)
#pragma unroll
                for (int gq = 0; gq < 4; ++gq) {
                    const u32x2 pw_ = praw[dvi][gq]; const f32x4 pr = {bflo(pw_.x), bfhi(pw_.x), bflo(pw_.y), bfhi(pw_.y)};
#pragma unroll
                    for (int e = 0; e < 4; ++e) { const float t = O[dvi][4 * gq + e] + pr[e]; O[dvi][4 * gq + e] = t; ssum += t * t; }
                }
            ssum += bperm(ssum, (lane ^ 32) << 2);
            if (h == 0) *(LAS float*)(L + SC_RED + (w * 32 + r) * 4) = ssum;
        }
        LDS_BARRIER();
        if (second) {
            const float tot = *(const LAS float*)(L + SC_RED + ((w & ~1) * 32 + r) * 4) + *(const LAS float*)(L + SC_RED + ((w | 1) * 32 + r) * 4);
            const float rs = __builtin_amdgcn_rsqf(tot * (1.f / 128.f) + EPS);
#pragma unroll
            for (int dvi = 0; dvi < 2; ++dvi)
#pragma unroll
                for (int gq = 0; gq < 4; ++gq) {
                    const int dv = 32 * (2 * dh + dvi) + 8 * gq + 4 * h;
                    const f32x4 gn = *(const LAS f32x4*)(L + SC_END + dv * 4);
                    const u32x2 gt = gts[dvi][gq];
                    u32x2 wv; wv.x = pk2(O[dvi][4 * gq] * rs * gn[0] * bflo(gt.x), O[dvi][4 * gq + 1] * rs * gn[1] * bfhi(gt.x));
                    wv.y = pk2(O[dvi][4 * gq + 2] * rs * gn[2] * bflo(gt.y), O[dvi][4 * gq + 3] * rs * gn[3] * bfhi(gt.y));
                    *(u32x2*)(OBF + (size_t)orow * DM + ocol + dv) = wv;
                }
        }
        {
            bf16x8 vb[8];
#pragma unroll
            for (int ks = 0; ks < 8; ++ks) vb[ks] = *(const LAS bf16x8*)(L + SC_VT + 32 * dvb_s * TSTR + rt + 32 * ks);
#pragma unroll
            for (int ti = 0; ti < (GLA ? 1 : 2); ++ti) {
                const int kb_ = GLA ? kq : 2 * kq + ti;
                bf16x8 ka[8];
#pragma unroll
                for (int ks = 0; ks < 8; ++ks) ka[ks] = *(const LAS bf16x8*)(L + SC_KT + 32 * kb_ * TSTR + rt + 32 * ks);
                f32x16 pkv;
#pragma unroll
                for (int i = 0; i < 16; ++i) pkv[i] = 0.f;
#pragma unroll
                for (int ks = 0; ks < 8; ++ks) pkv = MFMA32(ka[ks], vb[ks], pkv);
                f32x16& Sx = ti == 0 ? S0 : S1;
#pragma unroll
                for (int gq = 0; gq < 4; ++gq) {
                    const int k = 32 * kb_ + 8 * gq + 4 * h;
                    const f32x4 eb = *(const LAS f32x4*)(L + SC_VEC + 512 + (32 * kb_ + 8 * gq) * 4 + h16), ebm = *(const LAS f32x4*)(L + SC_VEC + 1024 + (32 * kb_ + 8 * gq) * 4 + h16);
                    { const f32x2 s01 = (f32x2){eb[0], eb[1]} * (f32x2){Sx[4 * gq], Sx[4 * gq + 1]} + (f32x2){ebm[0], ebm[1]} * (f32x2){pkv[4 * gq], pkv[4 * gq + 1]};
                      const f32x2 s23 = (f32x2){eb[2], eb[3]} * (f32x2){Sx[4 * gq + 2], Sx[4 * gq + 3]} + (f32x2){ebm[2], ebm[3]} * (f32x2){pkv[4 * gq + 2], pkv[4 * gq + 3]};
                      Sx[4 * gq] = s01.x; Sx[4 * gq + 1] = s01.y; Sx[4 * gq + 2] = s23.x; Sx[4 * gq + 3] = s23.y; }
                }
            }
        }
    }
    __syncthreads();
#undef ROWOF
#undef LOAD_CHUNK
}


template <class T> __device__ __forceinline__ T* opaque_ptr(T* p) { __attribute__((address_space(1))) T* gp = (__attribute__((address_space(1))) T*)p; asm volatile("" : "+s"(gp)); return (T*)gp; }
__device__ __forceinline__ unsigned opaque_zero() { unsigned z; asm volatile("s_mov_b32 %0, 0" : "=s"(z)); return z; }
__device__ __forceinline__ void gbar(unsigned* ctr, unsigned target) {
    asm volatile("s_waitcnt vmcnt(0)" ::: "memory");
    __syncthreads();
    if (threadIdx.x == 0) {
        __builtin_amdgcn_fence(__ATOMIC_RELEASE, "agent");
        asm volatile("s_waitcnt vmcnt(0)" ::: "memory");
        __hip_atomic_fetch_add(ctr, 1u, __ATOMIC_RELAXED, __HIP_MEMORY_SCOPE_AGENT);
        while (__hip_atomic_load(ctr, __ATOMIC_RELAXED, __HIP_MEMORY_SCOPE_AGENT) < target) __builtin_amdgcn_s_sleep(2);
        __builtin_amdgcn_fence(__ATOMIC_ACQUIRE, "agent");
        asm volatile("s_waitcnt vmcnt(0)" ::: "memory");
    }
    __syncthreads();
}


#define XB_TMO      128
#define XB_XCNT(j)  (256  + 64 * (j))
#define XB_XSUB(j)  (1280 + 64 * (j))
#define XB_XGEN(j)  (2304 + 64 * (j))
#define XB_TOP      3328
#define XB_TOPGEN   3392
#define XCD_BAR_WORDS 3456
#define XB_SPIN_CAP (1u << 18)
__device__ __forceinline__ unsigned xb_ld(unsigned* p)              { return __hip_atomic_load(p, __ATOMIC_RELAXED, __HIP_MEMORY_SCOPE_AGENT); }
__device__ __forceinline__ unsigned xb_add(unsigned* p, unsigned v) { return __hip_atomic_fetch_add(p, v, __ATOMIC_RELAXED, __HIP_MEMORY_SCOPE_AGENT); }
__device__ __forceinline__ unsigned xb_xcc_id() { return (unsigned)__builtin_amdgcn_s_getreg((3 << 11) | 20) & 0xFu; }
#define XB_SPIN(cond, bar) do { unsigned _sp = 0; while (cond) { __builtin_amdgcn_s_sleep(1); \
    if ((++_sp & 255u) == 0u) { if (xb_ld(&(bar)[XB_TMO])) break; if (_sp > XB_SPIN_CAP) { atomicAdd(&(bar)[XB_TMO], 1u); break; } } } } while (0)
struct XcdBarrier { unsigned* bar; unsigned x; volatile LAS unsigned* st; };
__device__ __forceinline__ void xcd_barrier_post(unsigned* bar) { if (threadIdx.x == 0) (void)xb_add(&bar[XB_XCNT(xb_xcc_id())], 1u); }
__device__ __forceinline__ void xcd_barrier_complete(unsigned* bar, unsigned x, unsigned& nloc, unsigned& nx) {
    const unsigned G = gridDim.x * gridDim.y * gridDim.z;
    unsigned sum, cnt, mine, sp = 0u;
    for (;;) {
        sum = 0u; cnt = 0u; mine = 0u;
#pragma unroll
        for (unsigned j = 0; j < 16; ++j) { const unsigned c = xb_ld(&bar[XB_XCNT(j)]); sum += c; cnt += (c > 0u) ? 1u : 0u; mine = (j == x) ? c : mine; }
        if (sum == G) break;
        __builtin_amdgcn_s_sleep(1);
        if ((++sp & 255u) == 0u) { if (xb_ld(&bar[XB_TMO])) break; if (sp > XB_SPIN_CAP) { atomicAdd(&bar[XB_TMO], 1u); break; } }
    }
    nloc = mine > 0u ? mine : 1u; nx = cnt > 0u ? cnt : 1u;
}
__device__ __forceinline__ void xcd_barrier(const XcdBarrier& b) {
    asm volatile("s_waitcnt vmcnt(0)" ::: "memory");
    __syncthreads();
    if (threadIdx.x == 0) {
        unsigned* bar = b.bar;
        __builtin_amdgcn_s_waitcnt(0);
        unsigned nloc = b.st[0], nx = b.st[1];
        if (nloc == 0u) { xcd_barrier_complete(bar, b.x, nloc, nx); b.st[0] = nloc; b.st[1] = nx; }
        const unsigned old = xb_add(&bar[XB_XSUB(b.x)], 1u);
        const unsigned gen = old / nloc;
        if (old + 1u == (gen + 1u) * nloc) {
            __builtin_amdgcn_fence(__ATOMIC_RELEASE, "agent");
            asm volatile("s_waitcnt vmcnt(0)" ::: "memory");
            const unsigned og = xb_add(&bar[XB_TOP], 1u);
            const unsigned tg = og / nx;
            if (og + 1u == (tg + 1u) * nx) xb_add(&bar[XB_TOPGEN], 1u);
            else XB_SPIN(xb_ld(&bar[XB_TOPGEN]) == tg, bar);
            __builtin_amdgcn_fence(__ATOMIC_ACQUIRE, "agent");
            xb_add(&bar[XB_XGEN(b.x)], 1u);
            asm volatile("s_waitcnt vmcnt(0)" ::: "memory");
        } else {
            XB_SPIN(xb_ld(&bar[XB_XGEN(b.x)]) == gen, bar);
            __builtin_amdgcn_fence(__ATOMIC_ACQUIRE, "agent");
            asm volatile("s_waitcnt vmcnt(0)" ::: "memory");
        }
    }
    __syncthreads();
}
constexpr int XB_LDS_OFF = 163824;

__global__ void __launch_bounds__(NTHREADS) hymba_fwd(Args A) {
    extern __shared__ __attribute__((aligned(16))) unsigned char lds_raw[];
    cg::grid_group grid = cg::this_grid();
    unsigned nbar = 0; (void)nbar;
    if (threadIdx.x == 0) { volatile LAS unsigned* st0 = (volatile LAS unsigned*)((LAS unsigned char*)lds_raw + XB_LDS_OFF); st0[0] = 0u; st0[1] = 0u; }
    __syncthreads();
    xcd_barrier_post((unsigned*)(A.ws + OFF_BAR));
    unsigned long long tp_prev = 0, tp_acc = 0, tp_start = 0;
    if (TIMEPROBE >= 0) { tp_start = __builtin_amdgcn_s_memrealtime(); tp_prev = tp_start; }
#define TP_MARK(kind) do { if (TIMEPROBE >= 0) { const unsigned long long now_ = __builtin_amdgcn_s_memrealtime(); if ((kind) == TIMEPROBE) tp_acc += now_ - tp_prev; tp_prev = now_; } } while (0)
#define PH_BEGIN() const unsigned zs = opaque_zero(); LAS unsigned char* L = (LAS unsigned char*)lds_raw + zs; unsigned char* ws = opaque_ptr(A.ws); const int G = (int)(gridDim.x + zs), bid = (int)(blockIdx.x + zs); const float* xp = opaque_ptr(A.xp); const float* xs = opaque_ptr(A.xs); float* outp = opaque_ptr(A.out); (void)L; (void)ws; (void)G; (void)bid; (void)xp; (void)xs; (void)outp
#define GBAR() do { for (int rb_ = 0; rb_ < PROBE_BAR; ++rb_) { XcdBarrier xb_; xb_.bar = (unsigned*)(opaque_ptr(A.ws) + OFF_BAR); xb_.x = xb_xcc_id(); xb_.st = (volatile LAS unsigned*)((LAS unsigned char*)lds_raw + XB_LDS_OFF + opaque_zero()); xcd_barrier(xb_); } } while (0)

    for (int rep = 0; rep < PROBE_P0; ++rep) { PH_BEGIN(); p0_convert(A); }
    { PH_BEGIN(); g0_prologue(xp, xs, ws, 0); }
    grid.sync(); TP_MARK(0);

#pragma unroll 1
    for (int g = 0; g < NGRP; ++g) {
        const int MGg = g == 0 ? 65536 : 32768;
        if (g > 0) { { PH_BEGIN(); g0_prologue(xp, xs, ws, g); } GBAR(); TP_MARK(1); }
#pragma unroll 1
        for (int l = 0; l < 2; ++l) {
            const size_t wlo = OFF_W + (size_t)l * SZ_LAYER;
            const size_t sq = OFF_SSQ + (size_t)(3 * l) * SSQ_SITE * 4;
            for (int rep = 0; rep < PROBE_FFNIN; ++rep) { PH_BEGIN(); pg8::Gemm gm{(const bf16_t*)(ws + OFF_XB), (const bf16_t*)(ws + wlo), MGg, NFF, DM}; pg8::StaticOrder S; S.init(MGg, NFF, G, bid);
              precompute_rstd(L, (const float*)(ws + sq), S, g);
              EpiFfnIn E{(bf16_t*)(ws + OFF_PH), L, g}; pg8::gemm_phase(L, gm, S, E); }
            GBAR(); TP_MARK(2);
            for (int rep = 0; rep < PROBE_FFNOUT_NULL; ++rep) { PH_BEGIN(); pg8::Gemm gm{(const bf16_t*)(ws + OFF_PH), (const bf16_t*)(ws + wlo + SZ_W1I), MGg, DM, DFF}; pg8::StaticOrder S; S.init(MGg, DM, G, bid); EpiNull E{(float*)(ws + OFF_RAW)}; pg8::gemm_phase(L, gm, S, E); }
            for (int rep = PROBE_RES0; rep >= 0; --rep) { PH_BEGIN(); pg8::Gemm gm{(const bf16_t*)(ws + OFF_PH), (const bf16_t*)(ws + wlo + SZ_W1I), MGg, DM, DFF}; pg8::StaticOrder S; S.init(MGg, DM, G, bid);
              EpiRes E{(bf16_t*)(ws + OFF_XB), (float*)(ws + sq) + SSQ_SITE, rep ? 0.f : 0.5f, g}; pg8::gemm_phase(L, gm, S, E); }
            GBAR(); TP_MARK(3);
            for (int rep = 0; rep < PROBE_WIN; ++rep) { PH_BEGIN(); pg8::Gemm gm{(const bf16_t*)(ws + OFF_XB), (const bf16_t*)(ws + wlo + SZ_W1I + SZ_W1O), MGg, NP_, DM}; pg8::StaticOrder S; S.init(MGg, NP_, G, bid);
              const float* LBT = (const float*)(ws + OFF_LBT) + l * 2048;
              precompute_rstd(L, (const float*)(ws + sq) + SSQ_SITE, S, g);
              EpiWin E{(bf16_t*)(ws + OFF_PH), L, LBT, LBT + 1024, A.bg + l * 512, g}; pg8::gemm_phase(L, gm, S, E); }
            GBAR(); TP_MARK(4);
            for (int rep = 0; rep < PROBE_SCAN; ++rep) {
                f32x16 S0, S1;
#pragma unroll
                for (int i = 0; i < 16; ++i) { S0[i] = 0.f; S1[i] = 0.f; }
                { PH_BEGIN();
                  const bf16_t* PH = (const bf16_t*)(ws + OFF_PH); bf16_t* RAW = (bf16_t*)(ws + OFF_RAW); bf16_t* OBF = (bf16_t*)(ws + OFF_OBF);
                  const int dir = bid & 1, hh = (bid >> 1) & 7, sidx = (bid >> 4) & 15;
                  const int T = g == 0 ? TSAMPLE : TPROMPT, seqbase = sidx * T, N = T / 128;
                  if (hh < 4) { const int hd = hh;
                      scan_half<128, false>(L, PH, RAW, OBF, A.hgn + l * 512 + 128 * hd, seqbase, T, dir, 128 * hd, 0, (dir ? 1024 : 512) + 128 * hd, 1536 + 128 * hd, 2048 + 128 * hd, 128 * hd, 0, N / 2, S0, S1);
                  } else { const int hd = hh - 4;
                      scan_half<64, false>(L, PH, RAW, OBF, A.glan + l * 512 + 128 * hd, seqbase, T, dir, 2560 + 64 * hd, 2816 + 64 * hd, (dir ? 3840 : 3584) + 64 * hd, 3072 + 128 * hd, 4096 + 128 * hd, 512 + 128 * hd, 0, N / 2, S0, S1);
                  } }
                GBAR(); TP_MARK(5);
                { PH_BEGIN();
                  const bf16_t* PH = (const bf16_t*)(ws + OFF_PH); bf16_t* RAW = (bf16_t*)(ws + OFF_RAW); bf16_t* OBF = (bf16_t*)(ws + OFF_OBF);
                  const int dir = bid & 1, hh = (bid >> 1) & 7, sidx = (bid >> 4) & 15;
                  const int T = g == 0 ? TSAMPLE : TPROMPT, seqbase = sidx * T, N = T / 128;
                  if (hh < 4) { const int hd = hh;
                      scan_half<128, true>(L, PH, RAW, OBF, A.hgn + l * 512 + 128 * hd, seqbase, T, dir, 128 * hd, 0, (dir ? 1024 : 512) + 128 * hd, 1536 + 128 * hd, 2048 + 128 * hd, 128 * hd, N / 2, N, S0, S1);
                  } else { const int hd = hh - 4;
                      scan_half<64, true>(L, PH, RAW, OBF, A.glan + l * 512 + 128 * hd, seqbase, T, dir, 2560 + 64 * hd, 2816 + 64 * hd, (dir ? 3840 : 3584) + 64 * hd, 3072 + 128 * hd, 4096 + 128 * hd, 512 + 128 * hd, N / 2, N, S0, S1);
                  } }
                GBAR(); TP_MARK(5);
            }
            for (int rep = PROBE_RES0; rep >= 0; --rep) { PH_BEGIN(); pg8::Gemm gm{(const bf16_t*)(ws + OFF_OBF), (const bf16_t*)(ws + wlo + SZ_W1I + SZ_W1O + SZ_WIN), MGg, DM, DM}; pg8::StaticOrder S; S.init(MGg, DM, G, bid);
              EpiRes E{(bf16_t*)(ws + OFF_XB), (float*)(ws + sq) + 2 * SSQ_SITE, rep ? 0.f : 1.0f, g}; pg8::gemm_phase(L, gm, S, E); }
            GBAR(); TP_MARK(6);
            for (int rep = 0; rep < PROBE_FFNIN; ++rep) { PH_BEGIN(); pg8::Gemm gm{(const bf16_t*)(ws + OFF_XB), (const bf16_t*)(ws + wlo + SZ_W1I + SZ_W1O + SZ_WIN + SZ_WO), MGg, NFF, DM}; pg8::StaticOrder S; S.init(MGg, NFF, G, bid);
              precompute_rstd(L, (const float*)(ws + sq) + 2 * SSQ_SITE, S, g);
              EpiFfnIn E{(bf16_t*)(ws + OFF_PH), L, g}; pg8::gemm_phase(L, gm, S, E); }
            GBAR(); TP_MARK(2);
            for (int rep = 0; rep < PROBE_FFNOUT_NULL; ++rep) { PH_BEGIN(); pg8::Gemm gm{(const bf16_t*)(ws + OFF_PH), (const bf16_t*)(ws + wlo + 2 * SZ_W1I + SZ_W1O + SZ_WIN + SZ_WO), MGg, DM, DFF}; pg8::StaticOrder S; S.init(MGg, DM, G, bid); EpiNull E{(float*)(ws + OFF_RAW)}; pg8::gemm_phase(L, gm, S, E); }
            for (int rep = PROBE_RES0; rep >= 0; --rep) { PH_BEGIN(); pg8::Gemm gm{(const bf16_t*)(ws + OFF_PH), (const bf16_t*)(ws + wlo + 2 * SZ_W1I + SZ_W1O + SZ_WIN + SZ_WO), MGg, DM, DFF}; pg8::StaticOrder S; S.init(MGg, DM, G, bid);
              EpiRes E{(bf16_t*)(ws + OFF_XB), (float*)(ws + sq) + 3 * SSQ_SITE, rep ? 0.f : 0.5f, g}; pg8::gemm_phase(L, gm, S, E); }
            GBAR(); TP_MARK(3);
        }
        for (int rep = 0; rep < PROBE_G0F; ++rep) { PH_BEGIN(); final_norm(outp, opaque_ptr(A.nf), ws, g); }
        TP_MARK(7);
    }
    if (TIMEPROBE >= 0) { __syncthreads(); if (blockIdx.x == 0 && threadIdx.x == 0) { const float frac = (float)(double)tp_acc / (float)(double)(tp_prev - tp_start); A.out[0] += 5792.6f * sqrtf(frac); } }
#undef PH_BEGIN
#undef GBAR
}

constexpr int LDS_BYTES = 163840;
extern "C" void kernel_launch(void* const* d_in, const int* in_sizes, int n_in, void* d_out, int out_size, void* d_ws, size_t ws_size, hipStream_t stream) {
    static int ready = 0;
    if (!ready) {
        if (n_in != 17 || out_size != MTOT * DM || ws_size < WS_END) { fprintf(stderr, "kernel_launch: unexpected shapes (n_in %d out %d ws %zu need %zu)\n", n_in, out_size, ws_size, (size_t)WS_END); ready = -1; return; }
        if (hipFuncSetAttribute((const void*)hymba_fwd, hipFuncAttributeMaxDynamicSharedMemorySize, LDS_BYTES) != hipSuccess) { fprintf(stderr, "kernel_launch: hipFuncSetAttribute failed\n"); ready = -1; return; }
        int per_cu = 0; (void)hipOccupancyMaxActiveBlocksPerMultiprocessor(&per_cu, (const void*)hymba_fwd, NTHREADS, LDS_BYTES); (void)hipGetLastError();
        ready = 1;
    }
    if (ready < 0) return;
    if (hipMemsetAsync((char*)d_ws + OFF_BAR, 0, 16384, stream) != hipSuccess) { fprintf(stderr, "kernel_launch: memset failed\n"); return; }
    Args a{};
    a.xp = (const float*)d_in[0]; a.xs = (const float*)d_in[1]; a.lower_bounds = (const float*)d_in[2]; a.n1 = (const float*)d_in[3]; a.w1i = (const float*)d_in[4]; a.w1o = (const float*)d_in[5];
    a.nm = (const float*)d_in[6]; a.wi = (const float*)d_in[7]; a.wg = (const float*)d_in[8]; a.bg = (const float*)d_in[9]; a.hgn = (const float*)d_in[10]; a.glan = (const float*)d_in[11];
    a.wo = (const float*)d_in[12]; a.n2 = (const float*)d_in[13]; a.w2i = (const float*)d_in[14]; a.w2o = (const float*)d_in[15]; a.nf = (const float*)d_in[16];
    a.out = (float*)d_out; a.ws = (unsigned char*)d_ws;
    void* args[] = {&a};
    hipError_t e = hipLaunchCooperativeKernel((const void*)hymba_fwd, dim3(256), dim3(NTHREADS), args, LDS_BYTES, stream);
    if (e != hipSuccess) fprintf(stderr, "cooperative launch failed: %s\n", hipGetErrorString(e));
}
```

```cpp
#include <hip/hip_runtime.h>
#include <hip/hip_cooperative_groups.h>
#include <cstdio>
namespace cg = cooperative_groups;

#define LAS __attribute__((address_space(3)))
typedef unsigned short bf16_t;
typedef short bf16x8 __attribute__((ext_vector_type(8)));
typedef short s16x4 __attribute__((ext_vector_type(4)));
typedef float f32x2 __attribute__((ext_vector_type(2)));
typedef float f32x4 __attribute__((ext_vector_type(4)));
typedef float f32x16 __attribute__((ext_vector_type(16)));
typedef unsigned u32x2 __attribute__((ext_vector_type(2)));
typedef unsigned u32x4 __attribute__((ext_vector_type(4)));

constexpr int DM = 1024, DFF = 2816, NFF = 5632, DINSRC = 4128, NP_ = 4608;
constexpr int MTOT = 98304, MGMAX = 65536, NGRP = 2;
constexpr int TPROMPT = 2048, TSAMPLE = 4096;
constexpr float EPS = 1e-6f;
constexpr int NTHREADS = 512;
#ifndef PROBE_SCAN
#define PROBE_SCAN 1
#endif
#ifndef PROBE_FFNIN
#define PROBE_FFNIN 1
#endif
#ifndef PROBE_P0
#define PROBE_P0 1
#endif
#ifndef PROBE_WIN
#define PROBE_WIN 1
#endif
#ifndef PROBE_FFNOUT_NULL
#define PROBE_FFNOUT_NULL 0
#endif
#ifndef PROBE_G0F
#define PROBE_G0F 1
#endif
#ifndef TIMEPROBE
#define TIMEPROBE -1
#endif
#ifndef PROBE_RES0
#define PROBE_RES0 0
#endif
#ifndef PROBE_BAR
#define PROBE_BAR 1
#endif

constexpr size_t SZ_W1I = (size_t)NFF * DM * 2, SZ_W1O = (size_t)DM * DFF * 2, SZ_WIN = (size_t)NP_ * DM * 2, SZ_WO = (size_t)DM * DM * 2;
constexpr size_t SZ_LAYER = 2 * SZ_W1I + 2 * SZ_W1O + SZ_WIN + SZ_WO;
constexpr size_t OFF_W = 0;
constexpr size_t OFF_LBT = OFF_W + 2 * SZ_LAYER;
constexpr size_t OFF_SSQ = OFF_LBT + 2 * 2 * 1024 * 4;
constexpr size_t SSQ_SITE = (size_t)MTOT * 16;
constexpr size_t OFF_XB = OFF_SSQ + 7 * SSQ_SITE * 4;
constexpr size_t OFF_OBF = OFF_XB + (size_t)MGMAX * DM * 2;
constexpr size_t OFF_RAW = OFF_OBF;
constexpr size_t OFF_PH = OFF_OBF + (size_t)MGMAX * DM * 2;
constexpr size_t OFF_BAR = OFF_PH + (size_t)MGMAX * NP_ * 2;
constexpr size_t WS_END = OFF_BAR + 16384;

__device__ __forceinline__ unsigned pk2(float lo, float hi) {
    typedef __bf16 bf2 __attribute__((ext_vector_type(2)));
    f32x2 v = {lo, hi};
    return __builtin_bit_cast(unsigned, __builtin_convertvector(v, bf2));
}
__device__ __forceinline__ float bflo(unsigned u) { return __uint_as_float(u << 16); }
__device__ __forceinline__ float bfhi(unsigned u) { return __uint_as_float(u & 0xffff0000u); }
__device__ __forceinline__ int grow_tile(int g, int pm) { return (g == 0 ? 32768 : 0) + pm * 256; }
__device__ __forceinline__ int grow(int g, int r) { return (g == 0 ? 32768 : 0) + r; }
__device__ __forceinline__ float sigmoid_f(float x) { return __builtin_amdgcn_rcpf(1.f + __builtin_amdgcn_exp2f(x * -1.44269504f)); }
__device__ __forceinline__ float log2sig_f(float z) { return fminf(z, 0.f) * 1.44269504f - __builtin_amdgcn_logf(1.f + __builtin_amdgcn_exp2f(fabsf(z) * -1.44269504f)); }

__device__ __forceinline__ float bperm(float x, int byte_idx) { return __int_as_float(__builtin_amdgcn_ds_bpermute(byte_idx, __float_as_int(x))); }
__device__ __forceinline__ float row_rstd(const float* ssq16, int R, int fq, int i16, int i32) {
    const f32x4 v = *(const f32x4*)(ssq16 + (size_t)R * 16 + 4 * fq);
    float s = (v[0] + v[1]) + (v[2] + v[3]);
    s += bperm(s, i16); s += bperm(s, i32);
    return rsqrtf(s * (1.f / 1024.f) + EPS);
}

__device__ __forceinline__ void rows_rstd8(float (&rs)[8], const float* ssq16, int Rbase  , int fq, int i16, int i32) {
    f32x4 v[8];
#pragma unroll
    for (int q = 0; q < 8; ++q) v[q] = *(const f32x4*)(ssq16 + (size_t)(Rbase + (q >> 2) * 128 + (q & 3) * 16) * 16 + 4 * fq);
    float s1[8], t1[8];
#pragma unroll
    for (int q = 0; q < 8; ++q) s1[q] = (v[q][0] + v[q][1]) + (v[q][2] + v[q][3]);
#pragma unroll
    for (int q = 0; q < 8; ++q) t1[q] = bperm(s1[q], i16);
#pragma unroll
    for (int q = 0; q < 8; ++q) s1[q] += t1[q];
#pragma unroll
    for (int q = 0; q < 8; ++q) t1[q] = bperm(s1[q], i32);
#pragma unroll
    for (int q = 0; q < 8; ++q) rs[q] = __builtin_amdgcn_rsqf((s1[q] + t1[q]) * (1.f / 1024.f) + EPS);
}

namespace pg8 {
constexpr int BM = 256, BK = 64, HALF = 128, HTB = HALF * BK * 2, STAGE_BYTES = 8 * HTB, NXCD = 8, WGM = 8;
__device__ __forceinline__ int lds_byte(int r, int c) { const int st = (r >> 4) * 2 + (c >> 5), rr = r & 15, cc = c & 31, ob = rr * 64 + cc * 2; return st * 1024 + (ob ^ (((ob >> 9) & 1) << 5)); }
__device__ __forceinline__ void stage_rc(int b, int& R, int& C) { const int st = b / 1024, sb = b % 1024, swz = sb ^ (((sb >> 9) & 1) << 5); R = (st >> 1) * 16 + swz / 64; C = (st & 1) * 32 + (swz % 64) / 2; }
__device__ __forceinline__ int perm32(int rho) { const int n = rho >> 4, i = rho & 15; return 8 * (i >> 2) + 4 * n + (i & 3); }
struct Unit { int pm, pn, ord; };
struct Gemm { const bf16_t* A; const bf16_t* Bt; int M, N, K; };
struct StaticOrder {
    int nM, nN, nwg, G, c;
    __device__ void init(int M, int N, int G_, int c_) { nM = M / BM; nN = N / BM; nwg = nM * nN; G = G_; c = c_; }
    __device__ bool next(int i, Unit& u) const {
        const long L = (long)i * G + c; if (L >= nwg) return false;
        int wgid = (int)L; { const int q = nwg / NXCD, r = nwg % NXCD, xcd = wgid % NXCD, off = wgid / NXCD; wgid = (xcd < r ? xcd * (q + 1) : r * (q + 1) + (xcd - r) * q) + off; }
        const int nig = WGM * nN, gid = wgid / nig, fm = gid * WGM, gsz = (nM - fm) < WGM ? (nM - fm) : WGM;
        u.pm = fm + ((wgid % nig) % gsz); u.pn = (wgid % nig) / gsz; u.ord = i; return true;
    }
};

template <class Epi>
__device__ __forceinline__ void gemm_phase(LAS unsigned char* lds, const Gemm g, const StaticOrder& S, const Epi& E) {
    int tid_ = threadIdx.x; asm volatile("" : "+v"(tid_));
    const int tid = tid_, wid = __builtin_amdgcn_readfirstlane(tid >> 6), lane = tid & 63, wr = wid >> 2, wc = wid & 3, fr = lane & 15, fq = lane >> 4;
    const int K = g.K, nt = K / BK;
    unsigned voffA[2], voffB[2];
#pragma unroll
    for (int i = 0; i < 2; ++i) { int R, C; stage_rc(tid * 16 + i * 8192, R, C); const int Rb = Epi::PERM ? ((R & ~31) + perm32(R & 31)) : R;
        voffA[i] = (unsigned)(R * K + C) * 2u; voffB[i] = (unsigned)(Rb * K + C) * 2u; }
    const size_t kstep = (size_t)(BK * 2);
    const size_t hstep = (size_t)HALF * K * 2;
    const size_t tstep = 2 * hstep;
    const unsigned ldsw = (unsigned)wid * 1024u;
    const int aoff = lds_byte(wr * 64 + fr, fq * 8), boff = lds_byte(wc * 32 + fr, fq * 8);
#define PG8_SA(b, h) (((b) * 2 + (h)) * HTB)
#define PG8_SB(b, h) ((4 + (b) * 2 + (h)) * HTB)
#define PG8_STAGE(bufoff, gbase, voff) do { _Pragma("unroll") for (int _i = 0; _i < 2; ++_i) \
        __builtin_amdgcn_global_load_lds((const unsigned*)((const char*)(gbase) + (voff)[_i]), (LAS unsigned*)(lds + (bufoff) + ldsw + _i * 8192), 16, 0, 0); } while (0)
#define PG8_LDA(dst, b, h) do { _Pragma("unroll") for (int m = 0; m < 4; ++m) _Pragma("unroll") for (int k = 0; k < 2; ++k) dst[m][k] = *(const LAS bf16x8*)(lds + PG8_SA(b, h) + aoff + m * 2048 + k * 1024); } while (0)
#define PG8_LDB(dst, b, h) do { _Pragma("unroll") for (int n = 0; n < 2; ++n) _Pragma("unroll") for (int k = 0; k < 2; ++k) dst[n][k] = *(const LAS bf16x8*)(lds + PG8_SB(b, h) + boff + n * 2048 + k * 1024); } while (0)
#define PG8_MMA(ai, bj, At, Bt) do { __builtin_amdgcn_s_setprio(1); _Pragma("unroll") for (int m = 0; m < 4; ++m) _Pragma("unroll") for (int n = 0; n < 2; ++n) _Pragma("unroll") for (int k = 0; k < 2; ++k) \
        acc[ai][bj][m][n] = __builtin_amdgcn_mfma_f32_16x16x32_bf16(Bt[n][k], At[m][k], acc[ai][bj][m][n], 0, 0, 0); __builtin_amdgcn_s_setprio(0); } while (0)
#define PG8_WAIT_V(n) asm volatile("s_waitcnt vmcnt(" #n ")" ::: "memory")
#define PG8_WAIT_L(n) asm volatile("s_waitcnt lgkmcnt(" #n ")" ::: "memory")
#define PG8_BAR __builtin_amdgcn_s_barrier()
#define PG8_SCHED __builtin_amdgcn_sched_barrier(0)
    Unit cur, nxt; int ui = 0;
    if (!S.next(0, cur)) return;
    f32x4 acc[2][2][4][2];
#pragma unroll
    for (int a = 0; a < 2; ++a)
#pragma unroll
        for (int b = 0; b < 2; ++b)
#pragma unroll
            for (int m = 0; m < 4; ++m)
#pragma unroll
                for (int n = 0; n < 2; ++n) acc[a][b][m][n] = (f32x4){0.f, 0.f, 0.f, 0.f};
    bf16x8 At[4][2], B0[2][2], B1[2][2];
    const char* cA = (const char*)g.A + (size_t)cur.pm * tstep; const char* cB = (const char*)g.Bt + (size_t)cur.pn * tstep;
    PG8_STAGE(PG8_SB(0, 0), cB, voffB); PG8_STAGE(PG8_SA(0, 0), cA, voffA); PG8_STAGE(PG8_SB(0, 1), cB + hstep, voffB); PG8_STAGE(PG8_SA(0, 1), cA + hstep, voffA);
    if (wr == 1) PG8_BAR;
    PG8_WAIT_V(4); PG8_BAR;
    PG8_STAGE(PG8_SB(1, 0), cB + kstep, voffB); PG8_STAGE(PG8_SA(1, 0), cA + kstep, voffA); PG8_STAGE(PG8_SB(1, 1), cB + hstep + kstep, voffB);
    PG8_WAIT_V(6); PG8_BAR;
    for (;;) {
        const bool has_next = S.next(ui + 1, nxt);
        const char* nA = has_next ? (const char*)g.A + (size_t)nxt.pm * tstep : cA; const char* nB = has_next ? (const char*)g.Bt + (size_t)nxt.pn * tstep : cB;
        for (int t = 0; t < nt; t += 2) {
            const bool last = (t == nt - 2);
            const char* a1 = cA + (size_t)(t + 1) * kstep;
            const char* a2 = last ? nA : cA + (size_t)(t + 2) * kstep; const char* b2 = last ? nB : cB + (size_t)(t + 2) * kstep;
            const char* a3 = a2 + kstep; const char* b3 = b2 + kstep;
            PG8_LDB(B0, 0, 0); PG8_SCHED; PG8_LDA(At, 0, 0); PG8_STAGE(PG8_SA(1, 1), a1 + hstep, voffA);
            PG8_WAIT_L(8); PG8_BAR; PG8_WAIT_L(0); PG8_MMA(0, 0, At, B0); PG8_BAR; PG8_SCHED;
            PG8_LDB(B1, 0, 1); PG8_STAGE(PG8_SB(0, 0), b2, voffB);
            PG8_BAR; PG8_WAIT_L(0); PG8_MMA(0, 1, At, B1); PG8_BAR;
            PG8_LDA(At, 0, 1); PG8_STAGE(PG8_SA(0, 0), a2, voffA);
            PG8_BAR; PG8_WAIT_L(0); PG8_MMA(1, 0, At, B0); PG8_BAR; PG8_SCHED;
            PG8_STAGE(PG8_SB(0, 1), b2 + hstep, voffB);
            PG8_WAIT_V(6); PG8_BAR; PG8_MMA(1, 1, At, B1); PG8_BAR;
            PG8_LDB(B0, 1, 0); PG8_SCHED; PG8_LDA(At, 1, 0); PG8_STAGE(PG8_SA(0, 1), a2 + hstep, voffA);
            PG8_WAIT_L(8); PG8_BAR; PG8_WAIT_L(0); PG8_MMA(0, 0, At, B0); PG8_BAR; PG8_SCHED;
            PG8_LDB(B1, 1, 1); PG8_STAGE(PG8_SB(1, 0), b3, voffB);
            PG8_BAR; PG8_WAIT_L(0); PG8_MMA(0, 1, At, B1); PG8_BAR;
            PG8_LDA(At, 1, 1); PG8_STAGE(PG8_SA(1, 0), a3, voffA);
            PG8_BAR; PG8_WAIT_L(0); PG8_MMA(1, 0, At, B0); PG8_BAR; PG8_SCHED;
            PG8_STAGE(PG8_SB(1, 1), b3 + hstep, voffB);
            PG8_WAIT_V(6); PG8_BAR; PG8_MMA(1, 1, At, B1); PG8_BAR;
        }
        E(acc, cur, wr, wc, fr, fq);
        if (!has_next) break;
#pragma unroll
        for (int a = 0; a < 2; ++a)
#pragma unroll
            for (int b = 0; b < 2; ++b)
#pragma unroll
                for (int m = 0; m < 4; ++m)
#pragma unroll
                    for (int n = 0; n < 2; ++n) acc[a][b][m][n] = (f32x4){0.f, 0.f, 0.f, 0.f};
        cur = nxt; cA = nA; cB = nB; ++ui;
    }
    PG8_WAIT_V(0);
    if (wr == 0) PG8_BAR;
    PG8_BAR;
#undef PG8_SA
#undef PG8_SB
#undef PG8_STAGE
#undef PG8_LDA
#undef PG8_LDB
#undef PG8_MMA
#undef PG8_WAIT_V
#undef PG8_WAIT_L
#undef PG8_BAR
#undef PG8_SCHED
}
}

constexpr int RSTD_OFF = 131072;
__device__ __forceinline__ void precompute_rstd(LAS unsigned char* L, const float* ssq16, const pg8::StaticOrder& S, int g) {
    int tid_ = threadIdx.x; asm volatile("" : "+v"(tid_));
    const int row = tid_ >> 1, hf = tid_ & 1, ix1 = ((tid_ & 63) ^ 1) << 2;
    const int nunits = (S.nwg - S.c + S.G - 1) / S.G;
    for (int i0 = 0; i0 < nunits; i0 += 8) {
        f32x4 a[8], b[8];
#pragma unroll
        for (int k = 0; k < 8; ++k) {
            pg8::Unit u; const int ii = (i0 + k < nunits) ? i0 + k : nunits - 1; S.next(ii, u);
            const float* p = ssq16 + (size_t)(grow_tile(g, u.pm) + row) * 16 + hf * 8;
            a[k] = *(const f32x4*)p; b[k] = *(const f32x4*)(p + 4);
        }
#pragma unroll
        for (int k = 0; k < 8; ++k) {
            float s = ((a[k][0] + a[k][1]) + (a[k][2] + a[k][3])) + ((b[k][0] + b[k][1]) + (b[k][2] + b[k][3]));
            s += bperm(s, ix1);
            if (hf == 0 && i0 + k < nunits) *(LAS float*)(L + RSTD_OFF + ((i0 + k) * 256 + row) * 4) = __builtin_amdgcn_rsqf(s * (1.f / 1024.f) + EPS);
        }
    }
    __syncthreads();
}

struct EpiFfnIn {
    static constexpr bool PERM = true;
    bf16_t* H; LAS unsigned char* L; int g;
    __device__ __forceinline__ void operator()(const f32x4 (&acc)[2][2][4][2], const pg8::Unit& u, int wr, int wc, int fr_in, int fq) const {
        int fr = fr_in; asm volatile("" : "+v"(fr));
        const int lane_ = fr | (fq << 4), i16 = (lane_ ^ 16) << 2, i32 = (lane_ ^ 32) << 2; (void)i16; (void)i32;
        const int R0 = grow_tile(g, u.pm);
        const int col0 = u.pn * 128 + wc * 32 + 8 * fq;
        float rs8[8];
#pragma unroll
        for (int q = 0; q < 8; ++q) rs8[q] = *(const LAS float*)(L + RSTD_OFF + (u.ord * 256 + wr * 64 + fr + (q >> 2) * 128 + (q & 3) * 16) * 4);
#pragma unroll
        for (int ai = 0; ai < 2; ++ai)
#pragma unroll
            for (int m = 0; m < 4; ++m) {
                const int rt = ai * 128 + wr * 64 + m * 16 + fr;
                const float rs = rs8[ai * 4 + m];
                float hv[8];
                const float nrs = rs * -1.44269504f;
#pragma unroll
                for (int n = 0; n < 2; ++n)
#pragma unroll
                    for (int jp = 0; jp < 2; ++jp) {
                        const f32x2 ra = {acc[ai][0][m][n][2 * jp], acc[ai][0][m][n][2 * jp + 1]}, rb = {acc[ai][1][m][n][2 * jp], acc[ai][1][m][n][2 * jp + 1]};
                        f32x2 na = ra * nrs; na.x = fminf(na.x, 60.f); na.y = fminf(na.y, 60.f);
                        f32x2 d; d.x = __builtin_amdgcn_exp2f(na.x); d.y = __builtin_amdgcn_exp2f(na.y); d = d + 1.0f;
                        const float rinv = __builtin_amdgcn_rcpf(d.x * d.y);
                        const f32x2 ab = (ra * rs) * (rb * rs);
                        const f32x2 sg = {rinv * d.y, rinv * d.x};
                        const f32x2 hh = ab * sg;
                        hv[n * 4 + 2 * jp] = hh.x; hv[n * 4 + 2 * jp + 1] = hh.y;
                    }
                u32x4 w; w.x = pk2(hv[0], hv[1]); w.y = pk2(hv[2], hv[3]); w.z = pk2(hv[4], hv[5]); w.w = pk2(hv[6], hv[7]);
                *(u32x4*)(H + (size_t)(u.pm * 256 + rt) * DFF + col0) = w;
            }
    }
};
struct EpiNull { static constexpr bool PERM = true; float* sink; __device__ __forceinline__ void operator()(const f32x4 (&acc)[2][2][4][2], const pg8::Unit& u, int wr, int wc, int fr, int fq) const {
    float s = 0.f;
#pragma unroll
    for (int a = 0; a < 2; ++a)
#pragma unroll
        for (int b = 0; b < 2; ++b)
#pragma unroll
            for (int m = 0; m < 4; ++m)
#pragma unroll
                for (int n = 0; n < 2; ++n) s += (acc[a][b][m][n][0] + acc[a][b][m][n][1]) + (acc[a][b][m][n][2] + acc[a][b][m][n][3]);
    if (s == 123.456f) sink[0] = 1.f; } };
struct EpiRes {
    static constexpr bool PERM = true;
    bf16_t* XB; float* ssq; float scale; int g;
    __device__ __forceinline__ void operator()(const f32x4 (&acc)[2][2][4][2], const pg8::Unit& u, int wr, int wc, int fr_in, int fq) const {
        int fr = fr_in; asm volatile("" : "+v"(fr));
        const int lane_ = fr | (fq << 4), i16 = (lane_ ^ 16) << 2, i32 = (lane_ ^ 32) << 2; (void)i16; (void)i32;
        const int R0 = grow_tile(g, u.pm);
        u32x4 old[2][4][2];
#pragma unroll
        for (int ai = 0; ai < 2; ++ai)
#pragma unroll
            for (int m = 0; m < 4; ++m)
#pragma unroll
                for (int bj = 0; bj < 2; ++bj)
                    old[ai][m][bj] = *(const u32x4*)(XB + (size_t)(u.pm * 256 + ai * 128 + wr * 64 + m * 16 + fr) * DM + u.pn * 256 + bj * 128 + wc * 32 + 8 * fq);
#pragma unroll
        for (int ai = 0; ai < 2; ++ai) {
#pragma unroll
            for (int m = 0; m < 4; ++m) {
                const int rt = ai * 128 + wr * 64 + m * 16 + fr;
                bf16_t* xb = XB + (size_t)(u.pm * 256 + rt) * DM;
                float part = 0.f;
#pragma unroll
                for (int bj = 0; bj < 2; ++bj) {
                    const int c0 = u.pn * 256 + bj * 128 + wc * 32 + 8 * fq;
                    const u32x4 o = old[ai][m][bj];
                    const f32x4 a0 = acc[ai][bj][m][0], a1 = acc[ai][bj][m][1];
                    float n[8];
                    n[0] = bflo(o.x) + a0[0] * scale; n[1] = bfhi(o.x) + a0[1] * scale; n[2] = bflo(o.y) + a0[2] * scale; n[3] = bfhi(o.y) + a0[3] * scale;
                    n[4] = bflo(o.z) + a1[0] * scale; n[5] = bfhi(o.z) + a1[1] * scale; n[6] = bflo(o.w) + a1[2] * scale; n[7] = bfhi(o.w) + a1[3] * scale;
                    u32x4 w; w.x = pk2(n[0], n[1]); w.y = pk2(n[2], n[3]); w.z = pk2(n[4], n[5]); w.w = pk2(n[6], n[7]);
                    *(u32x4*)(xb + c0) = w;
                    part += (n[0] * n[0] + n[1] * n[1]) + (n[2] * n[2] + n[3] * n[3]) + (n[4] * n[4] + n[5] * n[5]) + (n[6] * n[6] + n[7] * n[7]);
                }
                part += bperm(part, i16); part += bperm(part, i32);
                if (fq == 0) ssq[(size_t)(R0 + rt) * 16 + u.pn * 4 + wc] = part;
            }
        }
    }
};
struct EpiWin {
    static constexpr bool PERM = true;
    bf16_t* P; LAS unsigned char* L; const float* lbA; const float* lbB; const float* bg; int g;
    template <int MODE>
    __device__ __forceinline__ void body(const f32x4 (&acc)[2][2][4][2], const pg8::Unit& u, int wr, int wc, int fr, int fq, const float* tab) const {
        const int pn = u.pn;
        float rs8[8];
#pragma unroll
        for (int q = 0; q < 8; ++q) rs8[q] = *(const LAS float*)(L + RSTD_OFF + (u.ord * 256 + wr * 64 + fr + (q >> 2) * 128 + (q & 3) * 16) * 4);
        f32x4 ta[2][2], tb[2][2];
        if (MODE == 1 || MODE == 4) {
#pragma unroll
            for (int bj = 0; bj < 2; ++bj) { const int lc = bj * 128 + wc * 32 + 8 * fq;
                ta[bj][0] = *(const f32x4*)(tab + lc); ta[bj][1] = *(const f32x4*)(tab + lc + 4);
                if (MODE == 1) { tb[bj][0] = *(const f32x4*)(tab + 1024 + lc); tb[bj][1] = *(const f32x4*)(tab + 1024 + lc + 4); } }
        }
#pragma unroll
        for (int bj = 0; bj < 2; ++bj) {
            const int cin = bj * 128 + wc * 32 + 8 * fq;
#pragma unroll
            for (int ai = 0; ai < 2; ++ai)
#pragma unroll
                for (int m = 0; m < 4; ++m) {
                    const int rt = ai * 128 + wr * 64 + m * 16 + fr;
                    const float rs = rs8[ai * 4 + m];
                    float v[8];
#pragma unroll
                    for (int n = 0; n < 2; ++n)
#pragma unroll
                        for (int j = 0; j < 4; ++j) v[n * 4 + j] = acc[ai][bj][m][n][j] * rs;
                    if (MODE == 1) {
#pragma unroll
                        for (int j = 0; j < 8; ++j) v[j] = __builtin_amdgcn_logf(ta[bj][j >> 2][j & 3] + tb[bj][j >> 2][j & 3] * sigmoid_f(v[j]));
                    } else if (MODE == 2) {
#pragma unroll
                        for (int j = 0; j < 8; ++j) v[j] = sigmoid_f(v[j]);
                    } else if (MODE == 4) {
#pragma unroll
                        for (int j = 0; j < 8; ++j) v[j] = log2sig_f(v[j] + ta[bj][j >> 2][j & 3]) * (1.f / 16.f);
                    } else if (MODE == 5) {
#pragma unroll
                        for (int j = 0; j < 8; ++j) v[j] = v[j] * sigmoid_f(v[j]);
                    }
                    u32x4 w; w.x = pk2(v[0], v[1]); w.y = pk2(v[2], v[3]); w.z = pk2(v[4], v[5]); w.w = pk2(v[6], v[7]);
                    *(u32x4*)(P + (size_t)(u.pm * 256 + rt) * NP_ + pn * 256 + cin) = w;
                }
        }
    }
    __device__ __forceinline__ void operator()(const f32x4 (&acc)[2][2][4][2], const pg8::Unit& u, int wr, int wc, int fr_in, int fq) const {
        int fr = fr_in; asm volatile("" : "+v"(fr));
        const int pn = u.pn;
        if (pn >= 2 && pn <= 5) body<1>(acc, u, wr, wc, fr, fq, lbA + 256 * (pn - 2));
        else if (pn == 8 || pn == 9) body<2>(acc, u, wr, wc, fr, fq, nullptr);
        else if (pn == 14 || pn == 15) body<4>(acc, u, wr, wc, fr, fq, bg + 256 * (pn - 14));
        else if (pn >= 16) body<5>(acc, u, wr, wc, fr, fq, nullptr);
        else body<0>(acc, u, wr, wc, fr, fq, nullptr);
    }
};

struct Args {
    const float* xp; const float* xs; const float* lower_bounds; const float* n1; const float* w1i; const float* w1o; const float* nm; const float* wi;
    const float* wg; const float* bg; const float* hgn; const float* glan; const float* wo; const float* n2; const float* w2i; const float* w2o; const float* nf;
    float* out; unsigned char* ws;
};

__device__ __forceinline__ void p0_convert(const Args& A) {
    const long nth = (long)gridDim.x * NTHREADS, gt = (long)blockIdx.x * NTHREADS + threadIdx.x;
    unsigned char* ws = A.ws;
    const long cnt[6] = {(long)NFF * 128, (long)DM * 352, (long)NP_ * 128, (long)DM * 128, (long)NFF * 128, (long)DM * 352};
    const long per_layer = cnt[0] + cnt[1] + cnt[2] + cnt[3] + cnt[4] + cnt[5];
    for (long it = gt; it < 2 * per_layer; it += nth) {
        const int l = it >= per_layer ? 1 : 0; long i = it - (long)l * per_layer;
        int job = 0;
#pragma unroll
        for (int j = 0; j < 5; ++j) if (job == j && i >= cnt[j]) { i -= cnt[j]; job = j + 1; }
        unsigned char* wl = ws + OFF_W + (size_t)l * SZ_LAYER;
        float v[8];
        bf16_t* dst;
        if (job == 0 || job == 4) {
            const int np = (int)(i % NFF), k0 = (int)(i / NFF) * 8;
            const float* W = (job == 0 ? A.w1i : A.w2i) + (size_t)l * DM * NFF; const float* gn = (job == 0 ? A.n1 : A.n2) + l * DM;
            const int n = ((np & 128) ? DFF : 0) + (np >> 8) * 128 + (np & 127);
#pragma unroll
            for (int e = 0; e < 8; ++e) v[e] = W[(size_t)(k0 + e) * NFF + n] * gn[k0 + e];
            dst = (bf16_t*)(wl + (job == 0 ? 0 : SZ_W1I + SZ_W1O + SZ_WIN + SZ_WO)) + (size_t)np * DM + k0;
        } else if (job == 1 || job == 5) {
            const int np = (int)(i % DM), k0 = (int)(i / DM) * 8;
            const float* W = (job == 1 ? A.w1o : A.w2o) + (size_t)l * DFF * DM;
#pragma unroll
            for (int e = 0; e < 8; ++e) v[e] = W[(size_t)(k0 + e) * DM + np];
            dst = (bf16_t*)(wl + (job == 1 ? SZ_W1I : 2 * SZ_W1I + SZ_W1O + SZ_WIN + SZ_WO)) + (size_t)np * DFF + k0;
        } else if (job == 3) {
            const int np = (int)(i % DM), k0 = (int)(i / DM) * 8;
            const float* W = A.wo + (size_t)l * DM * DM;
#pragma unroll
            for (int e = 0; e < 8; ++e) v[e] = W[(size_t)(k0 + e) * DM + np];
            dst = (bf16_t*)(wl + SZ_W1I + SZ_W1O + SZ_WIN) + (size_t)np * DM + k0;
        } else {
            const int np = (int)(i % NP_), k0 = (int)(i / NP_) * 8;
            const float* W = A.wi + (size_t)l * DM * DINSRC; const float* gn = A.nm + l * DM;
            if (np >= 3584 && np < 4096) {
                const int d = np >= 3840 ? 1 : 0, c = np - 3584 - 256 * d;
                const float* G = A.wg + ((size_t)l * 2 + d) * 16 * 256;
                float gc[16];
#pragma unroll
                for (int r = 0; r < 16; ++r) gc[r] = G[r * 256 + c];
#pragma unroll
                for (int e = 0; e < 8; ++e) { const float* wr_ = W + (size_t)(k0 + e) * DINSRC + 3584 + 16 * d; float s = 0.f;
#pragma unroll
                    for (int r = 0; r < 16; ++r) s += wr_[r] * gc[r];
                    v[e] = s * gn[k0 + e]; }
            } else {
                const int n = np < 3584 ? np : 3616 + (np - 4096);
                const float sc = (np >= 2560 && np < 2816) ? 0.125f : 1.f;
#pragma unroll
                for (int e = 0; e < 8; ++e) v[e] = W[(size_t)(k0 + e) * DINSRC + n] * gn[k0 + e] * sc;
            }
            dst = (bf16_t*)(wl + SZ_W1I + SZ_W1O) + (size_t)np * DM + k0;
        }
        u32x4 w; w.x = pk2(v[0], v[1]); w.y = pk2(v[2], v[3]); w.z = pk2(v[4], v[5]); w.w = pk2(v[6], v[7]);
        *(u32x4*)dst = w;
    }
    float* lbt = (float*)(ws + OFF_LBT);
    for (long i = gt; i < 2048; i += nth) {
        const int l = (int)(i >> 10), c = (int)(i & 1023);
        const float a = A.lower_bounds[c], b = A.lower_bounds[1024 + c], mx = fmaxf(a, b);
        const float ea = __expf(a - mx), eb = __expf(b - mx);
        const float lb = l == 0 ? 0.f : eb / (ea + eb);
        lbt[l * 2048 + c] = fmaxf(lb, 1e-30f);
        lbt[l * 2048 + 1024 + c] = 1.f - lb;
    }
}

__device__ __forceinline__ void g0_prologue(const float* xp, const float* xs, unsigned char* ws, int g) {
    int tid_ = threadIdx.x; asm volatile("" : "+v"(tid_));
    const int lane = tid_ & 63, wv = blockIdx.x * 8 + (tid_ >> 6), nwv = gridDim.x * 8;
    bf16_t* XB = (bf16_t*)(ws + OFF_XB); float* ssq = (float*)(ws + OFF_SSQ);
    const int nrows = g == 0 ? 65536 : 32768;
    for (int r0 = wv; r0 < nrows; r0 += 4 * nwv) {
        f32x4 v[4][4];
#pragma unroll
        for (int k = 0; k < 4; ++k) { const int R = grow(g, r0 + k * nwv);
            const float* x = R < 32768 ? xp + (size_t)R * DM : xs + (size_t)(R - 32768) * DM;
#pragma unroll
            for (int i = 0; i < 4; ++i) v[k][i] = *(const f32x4*)(x + i * 256 + lane * 4); }
#pragma unroll
        for (int k = 0; k < 4; ++k) { const int r = r0 + k * nwv, R = grow(g, r);
            float s = 0.f;
#pragma unroll
            for (int i = 0; i < 4; ++i) { const f32x4 q = v[k][i];
                s += (q[0] * q[0] + q[1] * q[1]) + (q[2] * q[2] + q[3] * q[3]);
                u32x2 w; w.x = pk2(q[0], q[1]); w.y = pk2(q[2], q[3]); *(u32x2*)(XB + (size_t)r * DM + i * 256 + lane * 4) = w; }
#pragma unroll
            for (int o = 32; o >= 1; o >>= 1) s += bperm(s, (lane ^ o) << 2);
            if (lane < 4) *(f32x4*)(ssq + (size_t)R * 16 + 4 * lane) = (f32x4){lane == 0 ? s : 0.f, 0.f, 0.f, 0.f};
        }
    }
}
__device__ __forceinline__ void final_norm(float* outp, const float* nf, unsigned char* ws, int g) {
    int tid_ = threadIdx.x; asm volatile("" : "+v"(tid_));
    const int lane = tid_ & 63, wv = blockIdx.x * 8 + (tid_ >> 6), nwv = gridDim.x * 8;
    const float* ssq = (const float*)(ws + OFF_SSQ) + 6 * SSQ_SITE; const bf16_t* XB = (const bf16_t*)(ws + OFF_XB);
    const int nrows = g == 0 ? 65536 : 32768;
    f32x4 gn[4];
#pragma unroll
    for (int i = 0; i < 4; ++i) gn[i] = *(const f32x4*)(nf + i * 256 + lane * 4);
    for (int r0 = wv; r0 < nrows; r0 += 4 * nwv) {
        f32x4 q[4][4]; u32x2 xv[4][4];
#pragma unroll
        for (int k = 0; k < 4; ++k) { const int r = r0 + k * nwv, R = grow(g, r);
#pragma unroll
            for (int i = 0; i < 4; ++i) { q[k][i] = *(const f32x4*)(ssq + (size_t)R * 16 + 4 * i); xv[k][i] = *(const u32x2*)(XB + (size_t)r * DM + i * 256 + lane * 4); } }
#pragma unroll
        for (int k = 0; k < 4; ++k) { const int R = grow(g, r0 + k * nwv);
            float* x = outp + (size_t)R * DM;
            const f32x4 q0 = q[k][0], q1 = q[k][1], q2 = q[k][2], q3 = q[k][3];
            const float rs = __builtin_amdgcn_rsqf((((q0[0] + q0[1]) + (q0[2] + q0[3])) + ((q1[0] + q1[1]) + (q1[2] + q1[3])) + (((q2[0] + q2[1]) + (q2[2] + q2[3])) + ((q3[0] + q3[1]) + (q3[2] + q3[3])))) * (1.f / 1024.f) + EPS);
#pragma unroll
            for (int i = 0; i < 4; ++i) { const u32x2 t = xv[k][i];
                f32x4 o = {bflo(t.x) * rs * gn[i][0], bfhi(t.x) * rs * gn[i][1], bflo(t.y) * rs * gn[i][2], bfhi(t.y) * rs * gn[i][3]}; *(f32x4*)(x + i * 256 + lane * 4) = o; }
        }
    }
}

#define MFMA32(a, b, c) __builtin_amdgcn_mfma_f32_32x32x16_bf16((a), (b), (c), 0, 0, 0)
constexpr int SC_QT = 0, SC_KT = 34816, SC_VT = 69632, SC_ST = 104448, SC_TOT = 139264, SC_VEC = 143360, SC_RED = 144896, SC_END = 145920;
constexpr int TSTR = 272;

#define LDS_BARRIER() do { asm volatile("s_waitcnt lgkmcnt(0)" ::: "memory"); __builtin_amdgcn_s_barrier(); asm volatile("" ::: "memory"); } while (0)
template <int DK, bool second>
__device__ __forceinline__ void scan_half(LAS unsigned char* L, const bf16_t* __restrict__ P, bf16_t* RAW, bf16_t* OBF, const float* __restrict__ gain,
                                          int seqbase, int T, int dir, int qcol, int kcol, int gcol, int vcol, int gatecol, int ocol,
                                          int j0, int j1, f32x16& S0, f32x16& S1) {
    constexpr bool GLA = (DK == 64);
    constexpr int NPAIR = DK / 2, NSEG = NTHREADS / NPAIR, SL = 128 / NSEG, QSTR = (DK + 8) * 2, NKS = DK / 16;
    int tid_ = threadIdx.x; asm volatile("" : "+v"(tid_));
    const int tid = tid_, lane = tid & 63, w = __builtin_amdgcn_readfirstlane(tid >> 6);
    const int r = lane & 31, h = lane >> 5;
    const int cp = tid % NPAIR, seg = tid / NPAIR, vp = tid & 63, vseg = tid >> 6;
    const int tb = w >> 1, dh = w & 1, dvb_s = w & 3, kq = w >> 2;
    unsigned g2[SL], q2[SL], k2[SL], v2[16];

#define ROWOF(j, i) (seqbase + (dir ? (T - 1 - ((j) * 128 + (i))) : ((j) * 128 + (i))))
    const char* Pg = (const char*)P + gcol * 2; const char* Pq = (const char*)P + qcol * 2; const char* Pk = (const char*)P + kcol * 2; const char* Pv = (const char*)P + vcol * 2;
    const int rstep = dir ? -(NP_ * 2) : (NP_ * 2);
#define LOAD_CHUNK(j) do { int jj_ = (j); asm volatile("" : "+s"(jj_)); \
        { const int p0_ = jj_ * 128 + seg * SL; const int off0_ = (seqbase + (dir ? (T - 1 - p0_) : p0_)) * (NP_ * 2) + 4 * cp; \
          _Pragma("unroll") for (int i_ = 0; i_ < SL; ++i_) { const unsigned o_ = (unsigned)(off0_ + i_ * rstep); \
            g2[i_] = __builtin_nontemporal_load((const unsigned*)(Pg + o_)); q2[i_] = __builtin_nontemporal_load((const unsigned*)(Pq + o_)); if (GLA) k2[i_] = __builtin_nontemporal_load((const unsigned*)(Pk + o_)); else k2[i_] = 0u; } } \
        { const int p0_ = jj_ * 128 + vseg * 16; const int off0_ = (seqbase + (dir ? (T - 1 - p0_) : p0_)) * (NP_ * 2) + 4 * vp; \
          _Pragma("unroll") for (int i_ = 0; i_ < 16; ++i_) { const unsigned o_ = (unsigned)(off0_ + i_ * rstep); v2[i_] = __builtin_nontemporal_load((const unsigned*)(Pv + o_)); } } \
    } while (0)

    if (second) { if (tid < 32) *(LAS f32x4*)(L + SC_END + tid * 16) = *(const f32x4*)(gain + tid * 4); }
    LOAD_CHUNK(j0);
    for (int j = j0; j < j1; ++j) {
        int rq = r * QSTR + 16 * h, rt = r * TSTR + 16 * h, rq8 = r * QSTR + 8 * h, rt8 = r * TSTR + 8 * h, h16 = 16 * h;
        asm volatile("" : "+v"(rq), "+v"(rt), "+v"(rq8), "+v"(rt8), "+v"(h16));
        f32x2 cs[SL];
        { f32x2 run = {0.f, 0.f};
#pragma unroll
          for (int i = 0; i < SL; ++i) { run = run + (f32x2){bflo(g2[i]), bfhi(g2[i])}; cs[i] = run; }
          *(LAS f32x2*)(L + SC_TOT + (seg * DK + 2 * cp) * 4) = run; }
        LDS_BARRIER();
        f32x2 off = {0.f, 0.f}, mm = {0.f, 0.f}, bl = {0.f, 0.f};
#pragma unroll
        for (int s = 0; s < NSEG; ++s) { const f32x2 t = *(const LAS f32x2*)(L + SC_TOT + (s * DK + 2 * cp) * 4);
            if (s < seg) off = off + t;
            if (s < NSEG / 2) mm = mm + t;
            bl = bl + t; }
        unsigned kk[SL];
        const f32x2 dd = off - mm;
#pragma unroll
        for (int i = 0; i < SL; ++i) {
            f32x2 ee = cs[i] + dd;
            ee.x = __builtin_amdgcn_fmed3f(ee.x, -115.f, 115.f); ee.y = __builtin_amdgcn_fmed3f(ee.y, -115.f, 115.f);
            const f32x2 xx = {__builtin_amdgcn_exp2f(ee.x), __builtin_amdgcn_exp2f(ee.y)}, yy = {__builtin_amdgcn_exp2f(-ee.x), __builtin_amdgcn_exp2f(-ee.y)};
            f32x2 kv;
            if (GLA) kv = (f32x2){bflo(k2[i]), bfhi(k2[i])};
            else kv = (f32x2){1.f, 1.f} - (f32x2){__builtin_amdgcn_exp2f(bflo(g2[i])), __builtin_amdgcn_exp2f(bfhi(g2[i]))};
            const f32x2 qv = (f32x2){bflo(q2[i]), bfhi(q2[i])} * xx, kw = kv * yy;
            const unsigned qq = pk2(qv.x, qv.y);
            kk[i] = pk2(kw.x, kw.y);
            *(LAS unsigned*)(L + SC_QT + (seg * SL + i) * QSTR + 4 * cp) = qq;
            *(LAS unsigned*)(L + SC_KT + (seg * SL + i) * QSTR + 4 * cp) = kk[i];
        }
        {
            u32x4 a0, a1, b0, b1;
            a0.x = (v2[0] & 0xffffu) | (v2[1] << 16); a0.y = (v2[2] & 0xffffu) | (v2[3] << 16); a0.z = (v2[4] & 0xffffu) | (v2[5] << 16); a0.w = (v2[6] & 0xffffu) | (v2[7] << 16);
            a1.x = (v2[8] & 0xffffu) | (v2[9] << 16); a1.y = (v2[10] & 0xffffu) | (v2[11] << 16); a1.z = (v2[12] & 0xffffu) | (v2[13] << 16); a1.w = (v2[14] & 0xffffu) | (v2[15] << 16);
            b0.x = (v2[0] >> 16) | (v2[1] & 0xffff0000u); b0.y = (v2[2] >> 16) | (v2[3] & 0xffff0000u); b0.z = (v2[4] >> 16) | (v2[5] & 0xffff0000u); b0.w = (v2[6] >> 16) | (v2[7] & 0xffff0000u);
            b1.x = (v2[8] >> 16) | (v2[9] & 0xffff0000u); b1.y = (v2[10] >> 16) | (v2[11] & 0xffff0000u); b1.z = (v2[12] >> 16) | (v2[13] & 0xffff0000u); b1.w = (v2[14] >> 16) | (v2[15] & 0xffff0000u);
            LAS unsigned char* pv = L + SC_VT + (2 * vp) * TSTR + vseg * 32;
            *(LAS u32x4*)(pv) = a0; *(LAS u32x4*)(pv + 16) = a1; *(LAS u32x4*)(pv + TSTR) = b0; *(LAS u32x4*)(pv + TSTR + 16) = b1;
        }
        if (seg == 0) {
            *(LAS f32x2*)(L + SC_VEC + (2 * cp) * 4) = (f32x2){__builtin_amdgcn_exp2f(mm.x), __builtin_amdgcn_exp2f(mm.y)};
            *(LAS f32x2*)(L + SC_VEC + 512 + (2 * cp) * 4) = (f32x2){__builtin_amdgcn_exp2f(bl.x), __builtin_amdgcn_exp2f(bl.y)};
            *(LAS f32x2*)(L + SC_VEC + 1024 + (2 * cp) * 4) = (f32x2){__builtin_amdgcn_exp2f(bl.x - mm.x), __builtin_amdgcn_exp2f(bl.y - mm.y)};
        }
        LDS_BARRIER();
        if (j + 1 < j1) LOAD_CHUNK(j + 1);
#pragma unroll
        for (int ti = 0; ti < (GLA ? 1 : 2); ++ti) {
            const int kb_ = GLA ? kq : 2 * kq + ti;
            const f32x16& Sx = ti == 0 ? S0 : S1;
#pragma unroll
            for (int gq = 0; gq < 4; ++gq) {
                const int k = 32 * kb_ + 8 * gq + 4 * h;
                const f32x4 em = *(const LAS f32x4*)(L + SC_VEC + (32 * kb_ + 8 * gq) * 4 + h16);
                u32x2 wv; wv.x = pk2(Sx[4 * gq] * em[0], Sx[4 * gq + 1] * em[1]); wv.y = pk2(Sx[4 * gq + 2] * em[2], Sx[4 * gq + 3] * em[3]);
                *(LAS u32x2*)(L + SC_ST + 32 * dvb_s * QSTR + rq8 + (32 * kb_ + 8 * gq) * 2) = wv;
            }
        }
        bf16x8 ps[4][2];
        {
            bf16x8 qf[NKS];
#pragma unroll
            for (int ks = 0; ks < NKS; ++ks) qf[ks] = *(const LAS bf16x8*)(L + SC_QT + 32 * tb * QSTR + rq + 32 * ks);
#pragma unroll
            for (int sb = 0; sb < 4; ++sb) {
                if (sb <= tb) {
                    bf16x8 af[NKS];
#pragma unroll
                    for (int ks = 0; ks < NKS; ++ks) af[ks] = *(const LAS bf16x8*)(L + SC_KT + 32 * sb * QSTR + rq + 32 * ks);
                    f32x16 x;
#pragma unroll
                    for (int i = 0; i < 16; ++i) x[i] = 0.f;
#pragma unroll
                    for (int ks = 0; ks < NKS; ++ks) x = MFMA32(af[ks], qf[ks], x);
                    if (sb == tb) {
#pragma unroll
                        for (int i = 0; i < 16; ++i) { const int cr = (i & 3) + 8 * (i >> 2) + 4 * h; x[i] = cr <= r ? x[i] : 0.f; }
                    }
#pragma unroll
                    for (int ss = 0; ss < 2; ++ss) { u32x4 pw; pw.x = pk2(x[8 * ss], x[8 * ss + 1]); pw.y = pk2(x[8 * ss + 2], x[8 * ss + 3]); pw.z = pk2(x[8 * ss + 4], x[8 * ss + 5]); pw.w = pk2(x[8 * ss + 6], x[8 * ss + 7]);
                        ps[sb][ss] = __builtin_bit_cast(bf16x8, pw); }
                } else { ps[sb][0] = (bf16x8){0, 0, 0, 0, 0, 0, 0, 0}; ps[sb][1] = (bf16x8){0, 0, 0, 0, 0, 0, 0, 0}; }
            }
        }
        LDS_BARRIER();
        {
            LAS unsigned char* pk_ = L + SC_KT + (2 * cp) * TSTR + seg * SL * 2;
            if (SL == 16) {
                u32x4 a0, a1, b0, b1;
                a0.x = (kk[0] & 0xffffu) | (kk[1] << 16); a0.y = (kk[2] & 0xffffu) | (kk[3] << 16); a0.z = (kk[4] & 0xffffu) | (kk[5] << 16); a0.w = (kk[6] & 0xffffu) | (kk[7] << 16);
                a1.x = (kk[8 % SL] & 0xffffu) | (kk[9 % SL] << 16); a1.y = (kk[10 % SL] & 0xffffu) | (kk[11 % SL] << 16); a1.z = (kk[12 % SL] & 0xffffu) | (kk[13 % SL] << 16); a1.w = (kk[14 % SL] & 0xffffu) | (kk[15 % SL] << 16);
                b0.x = (kk[0] >> 16) | (kk[1] & 0xffff0000u); b0.y = (kk[2] >> 16) | (kk[3] & 0xffff0000u); b0.z = (kk[4] >> 16) | (kk[5] & 0xffff0000u); b0.w = (kk[6] >> 16) | (kk[7] & 0xffff0000u);
                b1.x = (kk[8 % SL] >> 16) | (kk[9 % SL] & 0xffff0000u); b1.y = (kk[10 % SL] >> 16) | (kk[11 % SL] & 0xffff0000u); b1.z = (kk[12 % SL] >> 16) | (kk[13 % SL] & 0xffff0000u); b1.w = (kk[14 % SL] >> 16) | (kk[15 % SL] & 0xffff0000u);
                *(LAS u32x4*)(pk_) = a0; *(LAS u32x4*)(pk_ + 16) = a1; *(LAS u32x4*)(pk_ + TSTR) = b0; *(LAS u32x4*)(pk_ + TSTR + 16) = b1;
            } else {
                u32x4 a0, b0;
                a0.x = (kk[0] & 0xffffu) | (kk[1] << 16); a0.y = (kk[2] & 0xffffu) | (kk[3] << 16); a0.z = (kk[4] & 0xffffu) | (kk[5] << 16); a0.w = (kk[6] & 0xffffu) | (kk[7] << 16);
                b0.x = (kk[0] >> 16) | (kk[1] & 0xffff0000u); b0.y = (kk[2] >> 16) | (kk[3] & 0xffff0000u); b0.z = (kk[4] >> 16) | (kk[5] & 0xffff0000u); b0.w = (kk[6] >> 16) | (kk[7] & 0xffff0000u);
                *(LAS u32x4*)(pk_) = a0; *(LAS u32x4*)(pk_ + TSTR) = b0;
            }
        }
        const int orow = ROWOF(j, 32 * tb + r);
        f32x16 O[2];
        {
            bf16x8 qf[NKS];
#pragma unroll
            for (int ks = 0; ks < NKS; ++ks) qf[ks] = *(const LAS bf16x8*)(L + SC_QT + 32 * tb * QSTR + rq + 32 * ks);
#pragma unroll
            for (int dvi = 0; dvi < 2; ++dvi) {
                const int dvb = 2 * dh + dvi;
                bf16x8 sf[NKS];
#pragma unroll
                for (int ks = 0; ks < NKS; ++ks) sf[ks] = *(const LAS bf16x8*)(L + SC_ST + 32 * dvb * QSTR + rq + 32 * ks);
                f32x16 o;
#pragma unroll
                for (int i = 0; i < 16; ++i) o[i] = 0.f;
#pragma unroll
                for (int ks = 0; ks < NKS; ++ks) o = MFMA32(sf[ks], qf[ks], o);
                O[dvi] = o;
            }
        }
        u32x2 praw[2][4], gts[2][4];
        if (second) {
#pragma unroll
            for (int dvi = 0; dvi < 2; ++dvi)
#pragma unroll
                for (int gq = 0; gq < 4; ++gq) { praw[dvi][gq] = *(const u32x2*)(RAW + (size_t)orow * DM + ocol + 32 * (2 * dh + dvi) + 8 * gq + 4 * h);
                    gts[dvi][gq] = *(const u32x2*)(P + (size_t)orow * NP_ + gatecol + 32 * (2 * dh + dvi) + 8 * gq + 4 * h); }
        }
#pragma unroll
        for (int dvi = 0; dvi < 2; ++dvi) {
            const int dvb = 2 * dh + dvi;
            f32x16 o = O[dvi];
#pragma unroll
            for (int sb = 0; sb < 4; ++sb) {
                if (sb <= tb) {
                    const LAS unsigned char* pa = L + SC_VT + 32 * dvb * TSTR + rt8 + 64 * sb;
                    const s16x4 l0 = *(const LAS s16x4*)(pa), h0 = *(const LAS s16x4*)(pa + 16), l1 = *(const LAS s16x4*)(pa + 32), h1 = *(const LAS s16x4*)(pa + 48);
                    o = MFMA32(__builtin_shufflevector(l0, h0, 0, 1, 2, 3, 4, 5, 6, 7), ps[sb][0], o);
                    o = MFMA32(__builtin_shufflevector(l1, h1, 0, 1, 2, 3, 4, 5, 6, 7), ps[sb][1], o);
                }
            }
            O[dvi] = o;
        }
        if (!second) {
#pragma unroll
            for (int dvi = 0; dvi < 2; ++dvi)
#pragma unroll
                for (int gq = 0; gq < 4; ++gq) {
                    const int dv = 32 * (2 * dh + dvi) + 8 * gq + 4 * h;
                    u32x2 wv; wv.x = pk2(O[dvi][4 * gq], O[dvi][4 * gq + 1]); wv.y = pk2(O[dvi][4 * gq + 2], O[dvi][4 * gq + 3]);
                    *(u32x2*)(RAW + (size_t)orow * DM + ocol + dv) = wv;
                }
        } else {
            float ssum = 0.f;
#pragma unroll
            for (int dvi = 0; dvi < 2; ++dvi)
#pragma unroll
                for (int gq = 0; gq < 4; ++gq) {
                    const u32x2 pw_ = praw[dvi][gq]; const f32x4 pr = {bflo(pw_.x), bfhi(pw_.x), bflo(pw_.y), bfhi(pw_.y)};
#pragma unroll
                    for (int e = 0; e < 4; ++e) { const float t = O[dvi][4 * gq + e] + pr[e]; O[dvi][4 * gq + e] = t; ssum += t * t; }
                }
            ssum += bperm(ssum, (lane ^ 32) << 2);
            if (h == 0) *(LAS float*)(L + SC_RED + (w * 32 + r) * 4) = ssum;
        }
        LDS_BARRIER();
        if (second) {
            const float tot = *(const LAS float*)(L + SC_RED + ((w & ~1) * 32 + r) * 4) + *(const LAS float*)(L + SC_RED + ((w | 1) * 32 + r) * 4);
            const float rs = __builtin_amdgcn_rsqf(tot * (1.f / 128.f) + EPS);
#pragma unroll
            for (int dvi = 0; dvi < 2; ++dvi)
#pragma unroll
                for (int gq = 0; gq < 4; ++gq) {
                    const int dv = 32 * (2 * dh + dvi) + 8 * gq + 4 * h;
                    const f32x4 gn = *(const LAS f32x4*)(L + SC_END + dv * 4);
                    const u32x2 gt = gts[dvi][gq];
                    u32x2 wv; wv.x = pk2(O[dvi][4 * gq] * rs * gn[0] * bflo(gt.x), O[dvi][4 * gq + 1] * rs * gn[1] * bfhi(gt.x));
                    wv.y = pk2(O[dvi][4 * gq + 2] * rs * gn[2] * bflo(gt.y), O[dvi][4 * gq + 3] * rs * gn[3] * bfhi(gt.y));
                    *(u32x2*)(OBF + (size_t)orow * DM + ocol + dv) = wv;
                }
        }
        {
            bf16x8 vb[8];
#pragma unroll
            for (int ks = 0; ks < 8; ++ks) vb[ks] = *(const LAS bf16x8*)(L + SC_VT + 32 * dvb_s * TSTR + rt + 32 * ks);
#pragma unroll
            for (int ti = 0; ti < (GLA ? 1 : 2); ++ti) {
                const int kb_ = GLA ? kq : 2 * kq + ti;
                bf16x8 ka[8];
#pragma unroll
                for (int ks = 0; ks < 8; ++ks) ka[ks] = *(const LAS bf16x8*)(L + SC_KT + 32 * kb_ * TSTR + rt + 32 * ks);
                f32x16 pkv;
#pragma unroll
                for (int i = 0; i < 16; ++i) pkv[i] = 0.f;
#pragma unroll
                for (int ks = 0; ks < 8; ++ks) pkv = MFMA32(ka[ks], vb[ks], pkv);
                f32x16& Sx = ti == 0 ? S0 : S1;
#pragma unroll
                for (int gq = 0; gq < 4; ++gq) {
                    const int k = 32 * kb_ + 8 * gq + 4 * h;
                    const f32x4 eb = *(const LAS f32x4*)(L + SC_VEC + 512 + (32 * kb_ + 8 * gq) * 4 + h16), ebm = *(const LAS f32x4*)(L + SC_VEC + 1024 + (32 * kb_ + 8 * gq) * 4 + h16);
                    { const f32x2 s01 = (f32x2){eb[0], eb[1]} * (f32x2){Sx[4 * gq], Sx[4 * gq + 1]} + (f32x2){ebm[0], ebm[1]} * (f32x2){pkv[4 * gq], pkv[4 * gq + 1]};
                      const f32x2 s23 = (f32x2){eb[2], eb[3]} * (f32x2){Sx[4 * gq + 2], Sx[4 * gq + 3]} + (f32x2){ebm[2], ebm[3]} * (f32x2){pkv[4 * gq + 2], pkv[4 * gq + 3]};
                      Sx[4 * gq] = s01.x; Sx[4 * gq + 1] = s01.y; Sx[4 * gq + 2] = s23.x; Sx[4 * gq + 3] = s23.y; }
                }
            }
        }
    }
    __syncthreads();
#undef ROWOF
#undef LOAD_CHUNK
}


template <class T> __device__ __forceinline__ T* opaque_ptr(T* p) { __attribute__((address_space(1))) T* gp = (__attribute__((address_space(1))) T*)p; asm volatile("" : "+s"(gp)); return (T*)gp; }
__device__ __forceinline__ unsigned opaque_zero() { unsigned z; asm volatile("s_mov_b32 %0, 0" : "=s"(z)); return z; }
__device__ __forceinline__ void gbar(unsigned* ctr, unsigned target) {
    asm volatile("s_waitcnt vmcnt(0)" ::: "memory");
    __syncthreads();
    if (threadIdx.x == 0) {
        __builtin_amdgcn_fence(__ATOMIC_RELEASE, "agent");
        asm volatile("s_waitcnt vmcnt(0)" ::: "memory");
        __hip_atomic_fetch_add(ctr, 1u, __ATOMIC_RELAXED, __HIP_MEMORY_SCOPE_AGENT);
        while (__hip_atomic_load(ctr, __ATOMIC_RELAXED, __HIP_MEMORY_SCOPE_AGENT) < target) __builtin_amdgcn_s_sleep(2);
        __builtin_amdgcn_fence(__ATOMIC_ACQUIRE, "agent");
        asm volatile("s_waitcnt vmcnt(0)" ::: "memory");
    }
    __syncthreads();
}


#define XB_TMO      128
#define XB_XCNT(j)  (256  + 64 * (j))
#define XB_XSUB(j)  (1280 + 64 * (j))
#define XB_XGEN(j)  (2304 + 64 * (j))
#define XB_TOP      3328
#define XB_TOPGEN   3392
#define XCD_BAR_WORDS 3456
#define XB_SPIN_CAP (1u << 18)
__device__ __forceinline__ unsigned xb_ld(unsigned* p)              { return __hip_atomic_load(p, __ATOMIC_RELAXED, __HIP_MEMORY_SCOPE_AGENT); }
__device__ __forceinline__ unsigned xb_add(unsigned* p, unsigned v) { return __hip_atomic_fetch_add(p, v, __ATOMIC_RELAXED, __HIP_MEMORY_SCOPE_AGENT); }
__device__ __forceinline__ unsigned xb_xcc_id() { return (unsigned)__builtin_amdgcn_s_getreg((3 << 11) | 20) & 0xFu; }
#define XB_SPIN(cond, bar) do { unsigned _sp = 0; while (cond) { __builtin_amdgcn_s_sleep(1); \
    if ((++_sp & 255u) == 0u) { if (xb_ld(&(bar)[XB_TMO])) break; if (_sp > XB_SPIN_CAP) { atomicAdd(&(bar)[XB_TMO], 1u); break; } } } } while (0)
struct XcdBarrier { unsigned* bar; unsigned x; volatile LAS unsigned* st; };
__device__ __forceinline__ void xcd_barrier_post(unsigned* bar) { if (threadIdx.x == 0) (void)xb_add(&bar[XB_XCNT(xb_xcc_id())], 1u); }
__device__ __forceinline__ void xcd_barrier_complete(unsigned* bar, unsigned x, unsigned& nloc, unsigned& nx) {
    const unsigned G = gridDim.x * gridDim.y * gridDim.z;
    unsigned sum, cnt, mine, sp = 0u;
    for (;;) {
        sum = 0u; cnt = 0u; mine = 0u;
#pragma unroll
        for (unsigned j = 0; j < 16; ++j) { const unsigned c = xb_ld(&bar[XB_XCNT(j)]); sum += c; cnt += (c > 0u) ? 1u : 0u; mine = (j == x) ? c : mine; }
        if (sum == G) break;
        __builtin_amdgcn_s_sleep(1);
        if ((++sp & 255u) == 0u) { if (xb_ld(&bar[XB_TMO])) break; if (sp > XB_SPIN_CAP) { atomicAdd(&bar[XB_TMO], 1u); break; } }
    }
    nloc = mine > 0u ? mine : 1u; nx = cnt > 0u ? cnt : 1u;
}
__device__ __forceinline__ void xcd_barrier(const XcdBarrier& b) {
    asm volatile("s_waitcnt vmcnt(0)" ::: "memory");
    __syncthreads();
    if (threadIdx.x == 0) {
        unsigned* bar = b.bar;
        __builtin_amdgcn_s_waitcnt(0);
        unsigned nloc = b.st[0], nx = b.st[1];
        if (nloc == 0u) { xcd_barrier_complete(bar, b.x, nloc, nx); b.st[0] = nloc; b.st[1] = nx; }
        const unsigned old = xb_add(&bar[XB_XSUB(b.x)], 1u);
        const unsigned gen = old / nloc;
        if (old + 1u == (gen + 1u) * nloc) {
            __builtin_amdgcn_fence(__ATOMIC_RELEASE, "agent");
            asm volatile("s_waitcnt vmcnt(0)" ::: "memory");
            const unsigned og = xb_add(&bar[XB_TOP], 1u);
            const unsigned tg = og / nx;
            if (og + 1u == (tg + 1u) * nx) xb_add(&bar[XB_TOPGEN], 1u);
            else XB_SPIN(xb_ld(&bar[XB_TOPGEN]) == tg, bar);
            __builtin_amdgcn_fence(__ATOMIC_ACQUIRE, "agent");
            xb_add(&bar[XB_XGEN(b.x)], 1u);
            asm volatile("s_waitcnt vmcnt(0)" ::: "memory");
        } else {
            XB_SPIN(xb_ld(&bar[XB_XGEN(b.x)]) == gen, bar);
            __builtin_amdgcn_fence(__ATOMIC_ACQUIRE, "agent");
            asm volatile("s_waitcnt vmcnt(0)" ::: "memory");
        }
    }
    __syncthreads();
}
constexpr int XB_LDS_OFF = 163824;

__global__ void __launch_bounds__(NTHREADS) hymba_fwd(Args A) {
    extern __shared__ __attribute__((aligned(16))) unsigned char lds_raw[];
    cg::grid_group grid = cg::this_grid();
    unsigned nbar = 0; (void)nbar;
    if (threadIdx.x == 0) { volatile LAS unsigned* st0 = (volatile LAS unsigned*)((LAS unsigned char*)lds_raw + XB_LDS_OFF); st0[0] = 0u; st0[1] = 0u; }
    __syncthreads();
    xcd_barrier_post((unsigned*)(A.ws + OFF_BAR));
    unsigned long long tp_prev = 0, tp_acc = 0, tp_start = 0;
    if (TIMEPROBE >= 0) { tp_start = __builtin_amdgcn_s_memrealtime(); tp_prev = tp_start; }
#define TP_MARK(kind) do { if (TIMEPROBE >= 0) { const unsigned long long now_ = __builtin_amdgcn_s_memrealtime(); if ((kind) == TIMEPROBE) tp_acc += now_ - tp_prev; tp_prev = now_; } } while (0)
#define PH_BEGIN() const unsigned zs = opaque_zero(); LAS unsigned char* L = (LAS unsigned char*)lds_raw + zs; unsigned char* ws = opaque_ptr(A.ws); const int G = (int)(gridDim.x + zs), bid = (int)(blockIdx.x + zs); const float* xp = opaque_ptr(A.xp); const float* xs = opaque_ptr(A.xs); float* outp = opaque_ptr(A.out); (void)L; (void)ws; (void)G; (void)bid; (void)xp; (void)xs; (void)outp
#define GBAR() do { for (int rb_ = 0; rb_ < PROBE_BAR; ++rb_) { XcdBarrier xb_; xb_.bar = (unsigned*)(opaque_ptr(A.ws) + OFF_BAR); xb_.x = xb_xcc_id(); xb_.st = (volatile LAS unsigned*)((LAS unsigned char*)lds_raw + XB_LDS_OFF + opaque_zero()); xcd_barrier(xb_); } } while (0)

    for (int rep = 0; rep < PROBE_P0; ++rep) { PH_BEGIN(); p0_convert(A); }
    { PH_BEGIN(); g0_prologue(xp, xs, ws, 0); }
    grid.sync(); TP_MARK(0);

#pragma unroll 1
    for (int g = 0; g < NGRP; ++g) {
        const int MGg = g == 0 ? 65536 : 32768;
        if (g > 0) { { PH_BEGIN(); g0_prologue(xp, xs, ws, g); } GBAR(); TP_MARK(1); }
#pragma unroll 1
        for (int l = 0; l < 2; ++l) {
            const size_t wlo = OFF_W + (size_t)l * SZ_LAYER;
            const size_t sq = OFF_SSQ + (size_t)(3 * l) * SSQ_SITE * 4;
            for (int rep = 0; rep < PROBE_FFNIN; ++rep) { PH_BEGIN(); pg8::Gemm gm{(const bf16_t*)(ws + OFF_XB), (const bf16_t*)(ws + wlo), MGg, NFF, DM}; pg8::StaticOrder S; S.init(MGg, NFF, G, bid);
              precompute_rstd(L, (const float*)(ws + sq), S, g);
              EpiFfnIn E{(bf16_t*)(ws + OFF_PH), L, g}; pg8::gemm_phase(L, gm, S, E); }
            GBAR(); TP_MARK(2);
            for (int rep = 0; rep < PROBE_FFNOUT_NULL; ++rep) { PH_BEGIN(); pg8::Gemm gm{(const bf16_t*)(ws + OFF_PH), (const bf16_t*)(ws + wlo + SZ_W1I), MGg, DM, DFF}; pg8::StaticOrder S; S.init(MGg, DM, G, bid); EpiNull E{(float*)(ws + OFF_RAW)}; pg8::gemm_phase(L, gm, S, E); }
            for (int rep = PROBE_RES0; rep >= 0; --rep) { PH_BEGIN(); pg8::Gemm gm{(const bf16_t*)(ws + OFF_PH), (const bf16_t*)(ws + wlo + SZ_W1I), MGg, DM, DFF}; pg8::StaticOrder S; S.init(MGg, DM, G, bid);
              EpiRes E{(bf16_t*)(ws + OFF_XB), (float*)(ws + sq) + SSQ_SITE, rep ? 0.f : 0.5f, g}; pg8::gemm_phase(L, gm, S, E); }
            GBAR(); TP_MARK(3);
            for (int rep = 0; rep < PROBE_WIN; ++rep) { PH_BEGIN(); pg8::Gemm gm{(const bf16_t*)(ws + OFF_XB), (const bf16_t*)(ws + wlo + SZ_W1I + SZ_W1O), MGg, NP_, DM}; pg8::StaticOrder S; S.init(MGg, NP_, G, bid);
              const float* LBT = (const float*)(ws + OFF_LBT) + l * 2048;
              precompute_rstd(L, (const float*)(ws + sq) + SSQ_SITE, S, g);
              EpiWin E{(bf16_t*)(ws + OFF_PH), L, LBT, LBT + 1024, A.bg + l * 512, g}; pg8::gemm_phase(L, gm, S, E); }
            GBAR(); TP_MARK(4);
            for (int rep = 0; rep < PROBE_SCAN; ++rep) {
                f32x16 S0, S1;
#pragma unroll
                for (int i = 0; i < 16; ++i) { S0[i] = 0.f; S1[i] = 0.f; }
                { PH_BEGIN();
                  const bf16_t* PH = (const bf16_t*)(ws + OFF_PH); bf16_t* RAW = (bf16_t*)(ws + OFF_RAW); bf16_t* OBF = (bf16_t*)(ws + OFF_OBF);
                  const int dir = bid & 1, hh = (bid >> 1) & 7, sidx = (bid >> 4) & 15;
                  const int T = g == 0 ? TSAMPLE : TPROMPT, seqbase = sidx * T, N = T / 128;
                  if (hh < 4) { const int hd = hh;
                      scan_half<128, false>(L, PH, RAW, OBF, A.hgn + l * 512 + 128 * hd, seqbase, T, dir, 128 * hd, 0, (dir ? 1024 : 512) + 128 * hd, 1536 + 128 * hd, 2048 + 128 * hd, 128 * hd, 0, N / 2, S0, S1);
                  } else { const int hd = hh - 4;
                      scan_half<64, false>(L, PH, RAW, OBF, A.glan + l * 512 + 128 * hd, seqbase, T, dir, 2560 + 64 * hd, 2816 + 64 * hd, (dir ? 3840 : 3584) + 64 * hd, 3072 + 128 * hd, 4096 + 128 * hd, 512 + 128 * hd, 0, N / 2, S0, S1);
                  } }
                GBAR(); TP_MARK(5);
                { PH_BEGIN();
                  const bf16_t* PH = (const bf16_t*)(ws + OFF_PH); bf16_t* RAW = (bf16_t*)(ws + OFF_RAW); bf16_t* OBF = (bf16_t*)(ws + OFF_OBF);
                  const int dir = bid & 1, hh = (bid >> 1) & 7, sidx = (bid >> 4) & 15;
                  const int T = g == 0 ? TSAMPLE : TPROMPT, seqbase = sidx * T, N = T / 128;
                  if (hh < 4) { const int hd = hh;
                      scan_half<128, true>(L, PH, RAW, OBF, A.hgn + l * 512 + 128 * hd, seqbase, T, dir, 128 * hd, 0, (dir ? 1024 : 512) + 128 * hd, 1536 + 128 * hd, 2048 + 128 * hd, 128 * hd, N / 2, N, S0, S1);
                  } else { const int hd = hh - 4;
                      scan_half<64, true>(L, PH, RAW, OBF, A.glan + l * 512 + 128 * hd, seqbase, T, dir, 2560 + 64 * hd, 2816 + 64 * hd, (dir ? 3840 : 3584) + 64 * hd, 3072 + 128 * hd, 4096 + 128 * hd, 512 + 128 * hd, N / 2, N, S0, S1);
                  } }
                GBAR(); TP_MARK(5);
            }
            for (int rep = PROBE_RES0; rep >= 0; --rep) { PH_BEGIN(); pg8::Gemm gm{(const bf16_t*)(ws + OFF_OBF), (const bf16_t*)(ws + wlo + SZ_W1I + SZ_W1O + SZ_WIN), MGg, DM, DM}; pg8::StaticOrder S; S.init(MGg, DM, G, bid);
              EpiRes E{(bf16_t*)(ws + OFF_XB), (float*)(ws + sq) + 2 * SSQ_SITE, rep ? 0.f : 1.0f, g}; pg8::gemm_phase(L, gm, S, E); }
            GBAR(); TP_MARK(6);
            for (int rep = 0; rep < PROBE_FFNIN; ++rep) { PH_BEGIN(); pg8::Gemm gm{(const bf16_t*)(ws + OFF_XB), (const bf16_t*)(ws + wlo + SZ_W1I + SZ_W1O + SZ_WIN + SZ_WO), MGg, NFF, DM}; pg8::StaticOrder S; S.init(MGg, NFF, G, bid);
              precompute_rstd(L, (const float*)(ws + sq) + 2 * SSQ_SITE, S, g);
              EpiFfnIn E{(bf16_t*)(ws + OFF_PH), L, g}; pg8::gemm_phase(L, gm, S, E); }
            GBAR(); TP_MARK(2);
            for (int rep = 0; rep < PROBE_FFNOUT_NULL; ++rep) { PH_BEGIN(); pg8::Gemm gm{(const bf16_t*)(ws + OFF_PH), (const bf16_t*)(ws + wlo + 2 * SZ_W1I + SZ_W1O + SZ_WIN + SZ_WO), MGg, DM, DFF}; pg8::StaticOrder S; S.init(MGg, DM, G, bid); EpiNull E{(float*)(ws + OFF_RAW)}; pg8::gemm_phase(L, gm, S, E); }
            for (int rep = PROBE_RES0; rep >= 0; --rep) { PH_BEGIN(); pg8::Gemm gm{(const bf16_t*)(ws + OFF_PH), (const bf16_t*)(ws + wlo + 2 * SZ_W1I + SZ_W1O + SZ_WIN + SZ_WO), MGg, DM, DFF}; pg8::StaticOrder S; S.init(MGg, DM, G, bid);
              EpiRes E{(bf16_t*)(ws + OFF_XB), (float*)(ws + sq) + 3 * SSQ_SITE, rep ? 0.f : 0.5f, g}; pg8::gemm_phase(L, gm, S, E); }
            GBAR(); TP_MARK(3);
        }
        for (int rep = 0; rep < PROBE_G0F; ++rep) { PH_BEGIN(); final_norm(outp, opaque_ptr(A.nf), ws, g); }
        TP_MARK(7);
    }
    if (TIMEPROBE >= 0) { __syncthreads(); if (blockIdx.x == 0 && threadIdx.x == 0) { const float frac = (float)(double)tp_acc / (float)(double)(tp_prev - tp_start); A.out[0] += 5792.6f * sqrtf(frac); } }
#undef PH_BEGIN
#undef GBAR
}

constexpr int LDS_BYTES = 163840;
extern "C" void kernel_launch(void* const* d_in, const int* in_sizes, int n_in, void* d_out, int out_size, void* d_ws, size_t ws_size, hipStream_t stream) {
    static int ready = 0;
    if (!ready) {
        if (n_in != 17 || out_size != MTOT * DM || ws_size < WS_END) { fprintf(stderr, "kernel_launch: unexpected shapes (n_in %d out %d ws %zu need %zu)\n", n_in, out_size, ws_size, (size_t)WS_END); ready = -1; return; }
        if (hipFuncSetAttribute((const void*)hymba_fwd, hipFuncAttributeMaxDynamicSharedMemorySize, LDS_BYTES) != hipSuccess) { fprintf(stderr, "kernel_launch: hipFuncSetAttribute failed\n"); ready = -1; return; }
        int per_cu = 0; (void)hipOccupancyMaxActiveBlocksPerMultiprocessor(&per_cu, (const void*)hymba_fwd, NTHREADS, LDS_BYTES); (void)hipGetLastError();
        ready = 1;
    }
    if (ready < 0) return;
    if (hipMemsetAsync((char*)d_ws + OFF_BAR, 0, 16384, stream) != hipSuccess) { fprintf(stderr, "kernel_launch: memset failed\n"); return; }
    Args a{};
    a.xp = (const float*)d_in[0]; a.xs = (const float*)d_in[1]; a.lower_bounds = (const float*)d_in[2]; a.n1 = (const float*)d_in[3]; a.w1i = (const float*)d_in[4]; a.w1o = (const float*)d_in[5];
    a.nm = (const float*)d_in[6]; a.wi = (const float*)d_in[7]; a.wg = (const float*)d_in[8]; a.bg = (const float*)d_in[9]; a.hgn = (const float*)d_in[10]; a.glan = (const float*)d_in[11];
    a.wo = (const float*)d_in[12]; a.n2 = (const float*)d_in[13]; a.w2i = (const float*)d_in[14]; a.w2o = (const float*)d_in[15]; a.nf = (const float*)d_in[16];
    a.out = (float*)d_out; a.ws = (unsigned char*)d_ws;
    void* args[] = {&a};
    hipError_t e = hipLaunchCooperativeKernel((const void*)hymba_fwd, dim3(256), dim3(NTHREADS), args, LDS_BYTES, stream);
    if (e != hipSuccess) fprintf(stderr, "cooperative launch failed: %s\n", hipGetErrorString(e));
}
```
